# Optimizing an MI355X kernel written in HIP

```python
import jax, jax.numpy as jnp
from jax import lax
import numpy as np

D_MODEL = 2048
BATCH = 4
SEQ = 4096
DEPTH = 2

N_MIXERS = 2
N_HEADS = 16
HEAD_DIM = D_MODEL // N_HEADS
DILATED_GROUPS = ((128, 1), (512, 4), (2048, 16))
N_ATT_GROUPS = len(DILATED_GROUPS)
ATT_BLOCK = 128
ROPE_THETA = 10000.0
POOL_WINDOWS = (2, 4, 8, 16)
N_POOL_GROUPS = len(POOL_WINDOWS)
POOL_DIM = D_MODEL // N_POOL_GROUPS
D_FF = 256 * ((8 * D_MODEL // 3 + 255) // 256)
N_EXPERTS = 8
TOP_K = 2
PLE_DIM = 256
DN_ALPHA = (2 * DEPTH) ** 0.25
DN_BETA = (8 * DEPTH) ** -0.25
LN_EPS = 1e-5
NEG_INF = -1e30
N_EVEN = (DEPTH + 1) // 2
N_ODD = DEPTH // 2

kernel_name = "dilated_attn_pool_moe_hybrid"


def layer_norm(x, g, b):
    xf = x.astype(jnp.float32)
    mu = jnp.mean(xf, axis=-1, keepdims=True)
    xc = xf - mu
    var = jnp.mean(xc * xc, axis=-1, keepdims=True)
    return (xc * lax.rsqrt(var + LN_EPS) * g + b).astype(x.dtype)


def rope(t, pos):
    half = HEAD_DIM // 2
    inv = ROPE_THETA ** (-jnp.arange(half, dtype=jnp.float32) / half)
    ang = pos.astype(jnp.float32)[:, None] * inv[None, :]
    cos = jnp.cos(ang)[None, :, None, :].astype(t.dtype)
    sin = jnp.sin(ang)[None, :, None, :].astype(t.dtype)
    t1, t2 = t[..., :half], t[..., half:]
    return jnp.concatenate([t1 * cos - t2 * sin, t2 * cos + t1 * sin], axis=-1)


def dilated_window_attention(q, k, v, window, dilation):
    B, S, H, Dh = q.shape
    span = dilation * ATT_BLOCK
    Sp = -(-S // span) * span
    pad = Sp - S
    n_sub = Sp // dilation
    nb = n_sub // ATT_BLOCK
    n_back = window // dilation

    def to_blocks(t):
        t = jnp.pad(t, ((0, 0), (0, pad), (0, 0), (0, 0)))
        t = t.reshape(B, n_sub, dilation, H, Dh).transpose(0, 2, 1, 3, 4)
        return t.reshape(B, dilation, nb, ATT_BLOCK, H, Dh)

    def with_prev(t):
        prev = jnp.pad(t, ((0, 0), (0, 0), (1, 0), (0, 0), (0, 0), (0, 0)))[:, :, :-1]
        return jnp.concatenate([prev, t], axis=3)

    qb = to_blocks(q)
    kw = with_prev(to_blocks(k))
    vw = with_prev(to_blocks(v))
    scores = jnp.einsum('brnqhd,brnkhd->brnhqk', qb, kw).astype(jnp.float32) * (Dh ** -0.5)
    qi = jnp.arange(ATT_BLOCK)[:, None] + ATT_BLOCK
    ki = jnp.arange(2 * ATT_BLOCK)[None, :]
    dist = qi - ki
    band = (dist >= 0) & (dist <= n_back)
    has_prev = (jnp.arange(nb)[:, None, None] > 0) | (ki[None] >= ATT_BLOCK)
    mask = band[None] & has_prev
    scores = jnp.where(mask[None, None, :, None], scores, NEG_INF)
    m = jnp.max(scores, axis=-1, keepdims=True)
    e = jnp.exp(scores - m)
    l = jnp.sum(e, axis=-1, keepdims=True)
    o = jnp.einsum('brnhqk,brnkhd->brnqhd', (e / l).astype(v.dtype), vw)
    lse = (m + jnp.log(l))[..., 0]
    o = o.reshape(B, dilation, n_sub, H, Dh).transpose(0, 2, 1, 3, 4).reshape(B, Sp, H, Dh)[:, :S]
    lse = lse.transpose(0, 1, 2, 4, 3).reshape(B, dilation, n_sub, H)
    lse = lse.transpose(0, 2, 1, 3).reshape(B, Sp, H)[:, :S]
    return o.astype(jnp.float32), lse


def dilated_attention_mixer(x, w_qkv, w_o):
    B, S, _ = x.shape
    qkv = (x @ w_qkv).reshape(B, S, N_ATT_GROUPS, 3, N_HEADS, HEAD_DIM)
    pos = jnp.arange(S)
    outs, lses = [], []
    for g, (win, dil) in enumerate(DILATED_GROUPS):
        q = rope(qkv[:, :, g, 0], pos)
        k = rope(qkv[:, :, g, 1], pos)
        o, lse = dilated_window_attention(q, k, qkv[:, :, g, 2], win, dil)
        outs.append(o)
        lses.append(lse)
    wts = jax.nn.softmax(jnp.stack(lses, axis=0), axis=0)
    o = jnp.einsum('gbsh,gbshd->bshd', wts, jnp.stack(outs, axis=0)).astype(x.dtype)
    return o.reshape(B, S, N_HEADS * HEAD_DIM) @ w_o


def multiscale_pool_mixer(x, w_in, w_group, scale, w_o):
    B, S, _ = x.shape
    u = (x @ w_in).reshape(B, S, N_POOL_GROUPS, POOL_DIM)
    c = jnp.cumsum(u.astype(jnp.float32), axis=1)
    t = jnp.arange(S)
    pooled = []
    for g, w in enumerate(POOL_WINDOWS):
        cg = jnp.pad(c[:, :, g], ((0, 0), (w, 0), (0, 0)))
        s = cg[:, w:] - cg[:, :S]
        cnt = jnp.minimum(t + 1, w).astype(jnp.float32)
        pooled.append(s / cnt[None, :, None])
    pooled = jnp.stack(pooled, axis=2)
    mixed = (pooled - u.astype(jnp.float32)).astype(x.dtype)
    y = jnp.einsum('bsgc,gcd->bsgd', mixed, w_group) * scale
    return y.reshape(B, S, D_MODEL) @ w_o


def swiglu(x, w1, w3, w2):
    return (jax.nn.silu(x @ w1) * (x @ w3)) @ w2


def moe_swiglu(x, w_router, w1, w3, w2):
    logits = (x @ w_router).astype(jnp.float32)
    top_v, top_i = lax.top_k(logits, TOP_K)
    gates = jax.nn.softmax(top_v, axis=-1)
    dense_gate = jnp.sum(jax.nn.one_hot(top_i, N_EXPERTS, dtype=jnp.float32) * gates[..., None], axis=-2)
    dense_gate = dense_gate.astype(x.dtype)
    y = jnp.zeros_like(x)
    for e in range(N_EXPERTS):
        y = y + dense_gate[..., e:e + 1] * swiglu(x, w1[e], w3[e], w2[e])
    return y


def setup_inputs(seed: int = 0) -> dict:
    key = jax.random.key(seed)
    ks = jax.random.split(key, 24)
    f32 = jnp.float32
    nrm = lambda k, shape, s: jax.random.normal(k, shape, f32) * s
    att_w = N_HEADS * HEAD_DIM
    return {
        "x": nrm(ks[0], (BATCH, SEQ, D_MODEL), 1.0),
        "p": nrm(ks[1], (DEPTH, BATCH, SEQ, PLE_DIM), 1.0),
        "attn_w_qkv": nrm(ks[2], (N_EVEN, D_MODEL, N_ATT_GROUPS * 3 * att_w), D_MODEL ** -0.5),
        "attn_w_o": nrm(ks[3], (N_EVEN, att_w, D_MODEL), DN_BETA * att_w ** -0.5),
        "pool_w_in": nrm(ks[4], (N_ODD, D_MODEL, D_MODEL), D_MODEL ** -0.5),
        "pool_w_group": nrm(ks[5], (N_ODD, N_POOL_GROUPS, POOL_DIM, POOL_DIM), POOL_DIM ** -0.5),
        "pool_scale": 1.0 + nrm(ks[6], (N_ODD, N_POOL_GROUPS, POOL_DIM), 0.02),
        "pool_w_o": nrm(ks[7], (N_ODD, D_MODEL, D_MODEL), DN_BETA * D_MODEL ** -0.5),
        "ln_mix_g": 1.0 + nrm(ks[8], (DEPTH, D_MODEL), 0.02),
        "ln_mix_b": nrm(ks[9], (DEPTH, D_MODEL), 0.02),
        "ln_ffn_g": 1.0 + nrm(ks[10], (DEPTH, D_MODEL), 0.02),
        "ln_ffn_b": nrm(ks[11], (DEPTH, D_MODEL), 0.02),
        "ffn_w1": nrm(ks[12], (N_EVEN, D_MODEL, D_FF), D_MODEL ** -0.5),
        "ffn_w3": nrm(ks[13], (N_EVEN, D_MODEL, D_FF), D_MODEL ** -0.5),
        "ffn_w2": nrm(ks[14], (N_EVEN, D_FF, D_MODEL), DN_BETA * D_FF ** -0.5),
        "moe_router": nrm(ks[15], (N_ODD, D_MODEL, N_EXPERTS), D_MODEL ** -0.5),
        "moe_w1": nrm(ks[16], (N_ODD, N_EXPERTS, D_MODEL, D_FF), D_MODEL ** -0.5),
        "moe_w3": nrm(ks[17], (N_ODD, N_EXPERTS, D_MODEL, D_FF), D_MODEL ** -0.5),
        "moe_w2": nrm(ks[18], (N_ODD, N_EXPERTS, D_FF, D_MODEL), DN_BETA * D_FF ** -0.5),
        "ple_w_proj": nrm(ks[19], (DEPTH, PLE_DIM, D_MODEL), PLE_DIM ** -0.5),
        "ple_w_gate": nrm(ks[20], (DEPTH, D_MODEL, D_MODEL), D_MODEL ** -0.5),
        "ple_b_gate": nrm(ks[21], (DEPTH, D_MODEL), 0.01),
    }


def reference(x, p, attn_w_qkv, attn_w_o, pool_w_in, pool_w_group, pool_scale, pool_w_o,
              ln_mix_g, ln_mix_b, ln_ffn_g, ln_ffn_b, ffn_w1, ffn_w3, ffn_w2,
              moe_router, moe_w1, moe_w3, moe_w2, ple_w_proj, ple_w_gate, ple_b_gate):
    for i in range(DEPTH):
        j = i // N_MIXERS
        if i % N_MIXERS == 0:
            h = dilated_attention_mixer(x, attn_w_qkv[j], attn_w_o[j])
        else:
            h = multiscale_pool_mixer(x, pool_w_in[j], pool_w_group[j], pool_scale[j], pool_w_o[j])
        x = layer_norm(DN_ALPHA * x + h, ln_mix_g[i], ln_mix_b[i])
        if i % 2 == 0:
            f = swiglu(x, ffn_w1[j], ffn_w3[j], ffn_w2[j])
        else:
            f = moe_swiglu(x, moe_router[j], moe_w1[j], moe_w3[j], moe_w2[j])
        x = layer_norm(DN_ALPHA * x + f, ln_ffn_g[i], ln_ffn_b[i])
        gate = jax.nn.sigmoid((x @ ple_w_gate[i]).astype(jnp.float32) + ple_b_gate[i]).astype(x.dtype)
        x = x + gate * (p[i] @ ple_w_proj[i])
    return x
```

```cpp
#include <hip/hip_runtime.h>
#include <cstdio>
#include <cstdint>

#ifndef MK_PER_PHASE
#define MK_PER_PHASE 1
#endif

#define LAS __attribute__((address_space(3)))
#define GAS __attribute__((address_space(1)))
typedef unsigned short bf16;
typedef short bf16x8 __attribute__((ext_vector_type(8)));
typedef short s16x4 __attribute__((ext_vector_type(4)));
typedef float f32x4 __attribute__((ext_vector_type(4)));
typedef float f32x2 __attribute__((ext_vector_type(2)));
typedef unsigned u32x4 __attribute__((ext_vector_type(4)));
typedef unsigned u32x2 __attribute__((ext_vector_type(2)));
typedef GAS unsigned gu32;

constexpr int D = 2048, BATCH = 4, SEQ = 4096, MTOK = BATCH * SEQ;
constexpr int NH = 16, HD = 128, NQKV = 3 * 3 * D;
constexpr int FF = 5632, FF2 = 2 * FF;
constexpr int NE = 8, PLE = 256;
constexpr float LN_EPS = 1e-5f;
constexpr float DN_ALPHA = 1.41421356237309515f;
constexpr int MOE_ROWS = 2 * MTOK + NE * 256;

constexpr size_t MiB = 1u << 20;
constexpr size_t WS_CTL = 0, CTL_ZERO_BYTES = 1 * MiB;
constexpr size_t WS_LIST = 1 * MiB;
constexpr size_t WS_TOK = 2 * MiB;
constexpr size_t WS_LSE = 3 * MiB;
constexpr size_t WS_ROPE = 6 * MiB;
constexpr size_t WS_WGATE = 8 * MiB;
constexpr size_t WS_WPROJ = 24 * MiB;
constexpr size_t WS_WIN = 26 * MiB;
constexpr size_t WS_WCOMB = 34 * MiB;
constexpr size_t WS_WO2 = 42 * MiB;
constexpr size_t WS_WGS = 50 * MiB;
constexpr size_t WS_PB = 52 * MiB;
constexpr size_t WS_PPROJ = 68 * MiB;
constexpr size_t WS_XB0 = 196 * MiB;
constexpr size_t WS_XFA = 260 * MiB;
constexpr size_t WS_XFB = 388 * MiB;
constexpr size_t WS_WQKV = 516 * MiB;
constexpr size_t WS_WO = 588 * MiB;
constexpr size_t WS_W13 = 596 * MiB;
constexpr size_t WS_W2 = 640 * MiB;
constexpr size_t WS_QKV = 662 * MiB;
constexpr size_t WS_OG = 1238 * MiB;
constexpr size_t WS_ATT = 1430 * MiB;
constexpr size_t WS_MW13 = 662 * MiB;
constexpr size_t WS_MW2 = 1014 * MiB;
constexpr size_t WS_H = 1238 * MiB;
constexpr size_t WS_XB1 = 1430 * MiB;
constexpr size_t WS_U = 1190 * MiB;
constexpr size_t WS_MIX = 1254 * MiB;
constexpr size_t WS_HM = 1190 * MiB;
constexpr size_t WS_XG = 516 * MiB;
constexpr size_t WS_END = 1564 * MiB;
static_assert(WS_MW2 + (size_t)NE * D * FF * 2 <= WS_U && WS_HM + (size_t)MOE_ROWS * FF * 2 <= WS_END && WS_XG + (size_t)MOE_ROWS * D * 2 <= WS_QKV, "ws map");

constexpr int CW_CNT = 64;
constexpr int CW_BAR = 4096;

constexpr int RING_BYTES = 131072;
constexpr int LDSCTL_OFF = RING_BYTES, MISC_OFF = LDSCTL_OFF + 320;
constexpr int LDS_BYTES = 147456;

#define VM_WAIT() asm volatile("s_waitcnt vmcnt(0)" ::: "memory")
__device__ __forceinline__ unsigned cvt_pk_bf16(float lo, float hi) { unsigned r; asm volatile("v_cvt_pk_bf16_f32 %0, %1, %2" : "=v"(r) : "v"(lo), "v"(hi)); return r; }
__device__ __forceinline__ float bf_lo(unsigned w) { return __uint_as_float(w << 16); }
__device__ __forceinline__ float bf_hi(unsigned w) { return __uint_as_float(w & 0xffff0000u); }
__device__ __forceinline__ float wave_sum(float v) {
#pragma unroll
    for (int o = 1; o < 64; o <<= 1) v += __shfl_xor(v, o);
    return v;
}

namespace pg8 {
#define PG8_LAS __attribute__((address_space(3)))
typedef unsigned short bf16_t;
constexpr int BM = 256, BK = 64, HALF = 128, HTB = HALF * BK * 2, STAGE_BYTES = 8 * HTB, NXCD = 8, WGM = 8;

__host__ __device__ __forceinline__ int lds_byte(int r, int c) { const int st = (r >> 4) * 2 + (c >> 5), rr = r & 15, cc = c & 31, ob = rr * 64 + cc * 2; return st * 1024 + (ob ^ (((ob >> 9) & 1) << 5)); }
__host__ __device__ __forceinline__ void stage_rc(int b, int& R, int& C) { const int st = b / 1024, sb = b % 1024, swz = sb ^ (((sb >> 9) & 1) << 5); R = (st >> 1) * 16 + swz / 64; C = (st & 1) * 32 + (swz % 64) / 2; }
__host__ __device__ __forceinline__ int perm32(int rho) { const int n = rho >> 4, i = rho & 15; return 8 * (i >> 2) + 4 * n + (i & 3); }

struct Unit { int pm, pn, e; };
struct Gemm { const bf16_t* A; const bf16_t* Bt; int K, lda, ldb; };

__device__ __forceinline__ void tile_of(int wgid, int nM, int nN, int& pm, int& pn) {
    const int nwg = nM * nN;
    { const int q = nwg / NXCD, r = nwg % NXCD, xcd = wgid % NXCD, off = wgid / NXCD; wgid = (xcd < r ? xcd * (q + 1) : r * (q + 1) + (xcd - r) * q) + off; }
    const int nig = WGM * nN, gid = wgid / nig, fm = gid * WGM, gsz = (nM - fm) < WGM ? (nM - fm) : WGM;
    pm = fm + ((wgid % nig) % gsz); pn = (wgid % nig) / gsz;
}
struct StaticOrder {
    int nM, nN, nwg, G, c;
    __device__ __forceinline__ void init(int M, int N, int G_, int c_) { nM = M / BM; nN = N / BM; nwg = nM * nN; G = G_; c = c_; }
    __device__ __forceinline__ bool next(int i, Unit& u) const {
        const long L = (long)i * G + c; if (L >= nwg) return false;
        tile_of((int)L, nM, nN, u.pm, u.pn); u.e = 0; return true;
    }
    __device__ __forceinline__ const char* a_ptr(const Gemm& g, const Unit& u) const { return (const char*)g.A + (size_t)u.pm * BM * g.lda * 2; }
    __device__ __forceinline__ const char* b_ptr(const Gemm& g, const Unit& u) const { return (const char*)g.Bt + (size_t)u.pn * BM * g.ldb * 2; }
};
struct BatchOrder {
    int nM, nN, nwg, nb, G, c; size_t sA, sB;
    __device__ __forceinline__ void init(int M, int N, int nb_, size_t sA_, size_t sB_, int G_, int c_) { nM = M / BM; nN = N / BM; nwg = nM * nN; nb = nb_; sA = sA_; sB = sB_; G = G_; c = c_; }
    __device__ __forceinline__ bool next(int i, Unit& u) const {
        const long L = (long)i * G + c; if (L >= (long)nwg * nb) return false;
        u.e = (int)(L / nwg); tile_of((int)(L % nwg), nM, nN, u.pm, u.pn); return true;
    }
    __device__ __forceinline__ const char* a_ptr(const Gemm& g, const Unit& u) const { return (const char*)(g.A + (size_t)u.e * sA) + (size_t)u.pm * BM * g.lda * 2; }
    __device__ __forceinline__ const char* b_ptr(const Gemm& g, const Unit& u) const { return (const char*)(g.Bt + (size_t)u.e * sB) + (size_t)u.pn * BM * g.ldb * 2; }
};
struct MoeOrder {
    int nM, nN, nwg, G, c; size_t sB; int tb[9];
    __device__ __forceinline__ bool next(int i, Unit& u) const {
        const long L = (long)i * G + c; if (L >= nwg) return false;
        tile_of((int)L, nM, nN, u.pm, u.pn);
        int e = 0;
#pragma unroll
        for (int j = 1; j < 8; ++j) e += (u.pm >= tb[j]) ? 1 : 0;
        u.e = e; return true;
    }
    __device__ __forceinline__ const char* a_ptr(const Gemm& g, const Unit& u) const { return (const char*)g.A + (size_t)u.pm * BM * g.lda * 2; }
    __device__ __forceinline__ const char* b_ptr(const Gemm& g, const Unit& u) const { return (const char*)(g.Bt + (size_t)u.e * sB) + (size_t)u.pn * BM * g.ldb * 2; }
};


struct EpiBf16 {
    static constexpr bool PERM = true;
    bf16_t* O; int ldc; size_t estride; int ecol;
    __device__ __forceinline__ void operator()(const f32x4 (&acc)[2][2][4][2], const Unit& u, int wr, int wc, int fr, int fq) const {
        const int row0 = u.pm * BM + wr * 64 + fr; const int col0 = u.pn * BM + wc * 32 + 8 * fq + u.e * ecol;
        bf16_t* base = O + (size_t)u.e * estride;
#pragma unroll
        for (int ai = 0; ai < 2; ++ai)
#pragma unroll
            for (int m = 0; m < 4; ++m) { bf16_t* rowp = base + (size_t)(row0 + ai * HALF + m * 16) * ldc + col0;
#pragma unroll
                for (int bj = 0; bj < 2; ++bj) { const f32x4 v0 = acc[ai][bj][m][0], v1 = acc[ai][bj][m][1];
                    u32x4 w; w.x = cvt_pk_bf16(v0[0], v0[1]); w.y = cvt_pk_bf16(v0[2], v0[3]); w.z = cvt_pk_bf16(v1[0], v1[1]); w.w = cvt_pk_bf16(v1[2], v1[3]);
                    *(u32x4*)(rowp + bj * HALF) = w; } }
    }
};
struct EpiQKV {
    static constexpr bool PERM = true;
    bf16_t* O; const float* rope;
    __device__ __forceinline__ void operator()(const f32x4 (&acc)[2][2][4][2], const Unit& u, int wr, int wc, int fr, int fq) const {
        const int gt = u.pn >> 3, t = gt % 3, head = 2 * (u.pn & 7) + (wc >> 1), idx0 = 32 * (wc & 1) + 8 * fq;
        const int row0 = u.pm * BM + wr * 64 + fr; const int col0 = gt * 2048 + head * 128 + idx0;
#pragma unroll
        for (int ai = 0; ai < 2; ++ai)
#pragma unroll
            for (int m = 0; m < 4; ++m) { const int row = row0 + ai * HALF + m * 16; bf16_t* rowp = O + (size_t)row * NQKV + col0;
                f32x4 l0 = acc[ai][0][m][0], l1 = acc[ai][0][m][1], h0 = acc[ai][1][m][0], h1 = acc[ai][1][m][1];
                if (t < 2) { const float* cp = rope + (size_t)(row & (SEQ - 1)) * 64 + idx0; const float* sp = cp + SEQ * 64;
                    const f32x4 c0 = *(const f32x4*)cp, c1 = *(const f32x4*)(cp + 4), s0 = *(const f32x4*)sp, s1 = *(const f32x4*)(sp + 4);
                    const f32x4 a0 = l0 * c0 - h0 * s0, a1 = l1 * c1 - h1 * s1, b0 = h0 * c0 + l0 * s0, b1 = h1 * c1 + l1 * s1;
                    l0 = a0; l1 = a1; h0 = b0; h1 = b1; }
                u32x4 w; w.x = cvt_pk_bf16(l0[0], l0[1]); w.y = cvt_pk_bf16(l0[2], l0[3]); w.z = cvt_pk_bf16(l1[0], l1[1]); w.w = cvt_pk_bf16(l1[2], l1[3]);
                *(u32x4*)rowp = w;
                w.x = cvt_pk_bf16(h0[0], h0[1]); w.y = cvt_pk_bf16(h0[2], h0[3]); w.z = cvt_pk_bf16(h1[0], h1[1]); w.w = cvt_pk_bf16(h1[2], h1[3]);
                *(u32x4*)(rowp + 64) = w; }
    }
};
struct EpiSwiGLU {
    static constexpr bool PERM = true;
    bf16_t* O; int ldc;
    __device__ __forceinline__ void operator()(const f32x4 (&acc)[2][2][4][2], const Unit& u, int wr, int wc, int fr, int fq) const {
        const int row0 = u.pm * BM + wr * 64 + fr; const int col0 = u.pn * HALF + wc * 32 + 8 * fq;
#pragma unroll
        for (int ai = 0; ai < 2; ++ai)
#pragma unroll
            for (int m = 0; m < 4; ++m) { bf16_t* rowp = O + (size_t)(row0 + ai * HALF + m * 16) * ldc + col0;
                float r[8];
#pragma unroll
                for (int n = 0; n < 2; ++n)
#pragma unroll
                    for (int j = 0; j < 4; ++j) { const float a = acc[ai][0][m][n][j], b = acc[ai][1][m][n][j];
                        const float sg = __builtin_amdgcn_rcpf(1.0f + __builtin_amdgcn_exp2f(-1.4426950408889634f * a)); r[n * 4 + j] = a * sg * b; }
                u32x4 w; w.x = cvt_pk_bf16(r[0], r[1]); w.y = cvt_pk_bf16(r[2], r[3]); w.z = cvt_pk_bf16(r[4], r[5]); w.w = cvt_pk_bf16(r[6], r[7]);
                *(u32x4*)rowp = w; }
    }
};
struct EpiRes {
    static constexpr bool PERM = false;
    const float* res; float* Y; int ldc; float alpha;
    __device__ __forceinline__ void operator()(const f32x4 (&acc)[2][2][4][2], const Unit& u, int wr, int wc, int fr, int fq) const {
        const int row0 = u.pm * BM + wr * 64 + fr, col0 = u.pn * BM + wc * 32 + 4 * fq;
#pragma unroll
        for (int ai = 0; ai < 2; ++ai)
#pragma unroll
            for (int m = 0; m < 4; ++m) { const size_t off = (size_t)(row0 + ai * HALF + m * 16) * ldc + col0;
#pragma unroll
                for (int bj = 0; bj < 2; ++bj)
#pragma unroll
                    for (int n = 0; n < 2; ++n) { const f32x4 r = *(const f32x4*)(res + off + bj * HALF + n * 16);
                        *(f32x4*)(Y + off + bj * HALF + n * 16) = r * alpha + acc[ai][bj][m][n]; }
                asm volatile("" ::: "memory"); }
    }
};
struct EpiPle {
    static constexpr bool PERM = false;
    const float* x; const bf16_t* pp; const float* bias; float* outF; bf16_t* outB; int ldc;
    __device__ __forceinline__ void operator()(const f32x4 (&acc)[2][2][4][2], const Unit& u, int wr, int wc, int fr, int fq) const {
        const int row0 = u.pm * BM + wr * 64 + fr, col0 = u.pn * BM + wc * 32 + 4 * fq;
        f32x4 bv[2][2];
#pragma unroll
        for (int bj = 0; bj < 2; ++bj)
#pragma unroll
            for (int n = 0; n < 2; ++n) bv[bj][n] = *(const f32x4*)(bias + col0 + bj * HALF + n * 16);
#pragma unroll
        for (int ai = 0; ai < 2; ++ai)
#pragma unroll
            for (int m = 0; m < 4; ++m) { const size_t off = (size_t)(row0 + ai * HALF + m * 16) * ldc + col0;
#pragma unroll
                for (int bj = 0; bj < 2; ++bj)
#pragma unroll
                    for (int n = 0; n < 2; ++n) { const size_t o2 = off + bj * HALF + n * 16;
                        const f32x4 xv = *(const f32x4*)(x + o2); const u32x2 pw = *(const u32x2*)(pp + o2);
                        const f32x4 v = acc[ai][bj][m][n] + bv[bj][n]; f32x4 o;
                        const float p0 = bf_lo(pw.x), p1 = bf_hi(pw.x), p2 = bf_lo(pw.y), p3 = bf_hi(pw.y);
                        o[0] = xv[0] + p0 * __builtin_amdgcn_rcpf(1.0f + __builtin_amdgcn_exp2f(-1.4426950408889634f * v[0]));
                        o[1] = xv[1] + p1 * __builtin_amdgcn_rcpf(1.0f + __builtin_amdgcn_exp2f(-1.4426950408889634f * v[1]));
                        o[2] = xv[2] + p2 * __builtin_amdgcn_rcpf(1.0f + __builtin_amdgcn_exp2f(-1.4426950408889634f * v[2]));
                        o[3] = xv[3] + p3 * __builtin_amdgcn_rcpf(1.0f + __builtin_amdgcn_exp2f(-1.4426950408889634f * v[3]));
                        *(f32x4*)(outF + o2) = o;
                        if (outB) { u32x2 w; w.x = cvt_pk_bf16(o[0], o[1]); w.y = cvt_pk_bf16(o[2], o[3]); *(u32x2*)(outB + o2) = w; } }
                asm volatile("" ::: "memory"); }
    }
};

template <class Epi, class Sched, bool ALIGN_EPI = true, bool SP2 = true>
__device__ __forceinline__ void gemm_phase(PG8_LAS unsigned char* lds, const Gemm g, const Sched& S, const Epi& E) {
    const int tid = threadIdx.x, wid = __builtin_amdgcn_readfirstlane(tid >> 6), lane = tid & 63, wr = wid >> 2, wc = wid & 3, fr = lane & 15, fq = lane >> 4;
    const int K = g.K, nt = K / BK;
    unsigned voffA[2], voffB[2];
#pragma unroll
    for (int i = 0; i < 2; ++i) { int R, C; stage_rc(tid * 16 + i * 8192, R, C); const int Rb = Epi::PERM ? ((R & ~31) + perm32(R & 31)) : R;
        voffA[i] = (unsigned)(R * g.lda + C) * 2u; voffB[i] = (unsigned)(Rb * g.ldb + C) * 2u; }
    const size_t kstep = (size_t)(BK * 2);
    const size_t hstepA = (size_t)HALF * g.lda * 2, hstepB = (size_t)HALF * g.ldb * 2;
    const unsigned ldsw = (unsigned)wid * 1024u;
    const int aoff = lds_byte(wr * 64 + fr, fq * 8), boff = lds_byte(wc * 32 + fr, fq * 8);
#define PG8_SA(b, h) (((b) * 2 + (h)) * HTB)
#define PG8_SB(b, h) ((4 + (b) * 2 + (h)) * HTB)
#define PG8_STAGE(bufoff, gbase, voff) do { _Pragma("unroll") for (int _i = 0; _i < 2; ++_i) \
        __builtin_amdgcn_global_load_lds((const unsigned*)((const char*)(gbase) + (voff)[_i]), (PG8_LAS unsigned*)(lds + (bufoff) + ldsw + _i * 8192), 16, 0, 0); } while (0)
#define PG8_LDA(dst, b, h) do { _Pragma("unroll") for (int m = 0; m < 4; ++m) _Pragma("unroll") for (int k = 0; k < 2; ++k) dst[m][k] = *(const PG8_LAS bf16x8*)(lds + PG8_SA(b, h) + aoff + m * 2048 + k * 1024); } while (0)
#define PG8_LDB(dst, b, h) do { _Pragma("unroll") for (int n = 0; n < 2; ++n) _Pragma("unroll") for (int k = 0; k < 2; ++k) dst[n][k] = *(const PG8_LAS bf16x8*)(lds + PG8_SB(b, h) + boff + n * 2048 + k * 1024); } while (0)
#define PG8_MMA(ai, bj, At, Bt) do { __builtin_amdgcn_s_setprio(1); _Pragma("unroll") for (int m = 0; m < 4; ++m) _Pragma("unroll") for (int n = 0; n < 2; ++n) _Pragma("unroll") for (int k = 0; k < 2; ++k) \
        acc[ai][bj][m][n] = __builtin_amdgcn_mfma_f32_16x16x32_bf16(Bt[n][k], At[m][k], acc[ai][bj][m][n], 0, 0, 0); __builtin_amdgcn_s_setprio(0); } while (0)
#define PG8_WAIT_V(n) asm volatile("s_waitcnt vmcnt(" #n ")" ::: "memory")
#define PG8_WAIT_L(n) asm volatile("s_waitcnt lgkmcnt(" #n ")" ::: "memory")
#define PG8_BAR __builtin_amdgcn_s_barrier()
#define PG8_SCHED __builtin_amdgcn_sched_barrier(0)
    Unit cur, nxt; int ui = 0;
    if (!S.next(0, cur)) return;
    f32x4 acc[2][2][4][2];
#pragma unroll
    for (int a = 0; a < 2; ++a)
#pragma unroll
        for (int b = 0; b < 2; ++b)
#pragma unroll
            for (int m = 0; m < 4; ++m)
#pragma unroll
                for (int n = 0; n < 2; ++n) acc[a][b][m][n] = (f32x4){0.f, 0.f, 0.f, 0.f};
    bf16x8 At[4][2], B0[2][2], B1[2][2];
    const char* cA = S.a_ptr(g, cur); const char* cB = S.b_ptr(g, cur);
    if constexpr (SP2) {
        PG8_STAGE(PG8_SB(0, 0), cB, voffB); PG8_STAGE(PG8_SB(0, 1), cB + hstepB, voffB); PG8_STAGE(PG8_SA(0, 0), cA, voffA); PG8_STAGE(PG8_SA(0, 1), cA + hstepA, voffA);
        if (wr == 1) PG8_BAR;
        PG8_WAIT_V(2); PG8_BAR;
        PG8_STAGE(PG8_SB(1, 0), cB + kstep, voffB); PG8_STAGE(PG8_SA(1, 0), cA + kstep, voffA); PG8_STAGE(PG8_SB(1, 1), cB + hstepB + kstep, voffB);
        PG8_WAIT_V(6); PG8_BAR;
    } else {
        PG8_STAGE(PG8_SB(0, 0), cB, voffB); PG8_STAGE(PG8_SA(0, 0), cA, voffA); PG8_STAGE(PG8_SB(0, 1), cB + hstepB, voffB); PG8_STAGE(PG8_SA(0, 1), cA + hstepA, voffA);
        if (wr == 1) PG8_BAR;
        PG8_WAIT_V(4); PG8_BAR;
        PG8_STAGE(PG8_SB(1, 0), cB + kstep, voffB); PG8_STAGE(PG8_SA(1, 0), cA + kstep, voffA); PG8_STAGE(PG8_SB(1, 1), cB + hstepB + kstep, voffB);
        PG8_WAIT_V(6); PG8_BAR;
    }
    for (;;) {
        const bool has_next = S.next(ui + 1, nxt);
        const char* nA = has_next ? S.a_ptr(g, nxt) : cA; const char* nB = has_next ? S.b_ptr(g, nxt) : cB;
        for (int t = 0; t < nt; t += 2) {
            const bool last = (t == nt - 2);
            const char* a1 = cA + (size_t)(t + 1) * kstep;
            const char* a2 = last ? nA : cA + (size_t)(t + 2) * kstep; const char* b2 = last ? nB : cB + (size_t)(t + 2) * kstep;
            const char* a3 = a2 + kstep; const char* b3 = b2 + kstep;
            if constexpr (SP2) {
            PG8_LDB(B0, 0, 0); PG8_LDB(B1, 0, 1); PG8_SCHED; PG8_LDA(At, 0, 0); PG8_STAGE(PG8_SA(1, 1), a1 + hstepA, voffA);
            PG8_WAIT_V(8); PG8_WAIT_L(0); PG8_BAR; PG8_MMA(0, 0, At, B0); PG8_MMA(0, 1, At, B1); PG8_BAR; PG8_SCHED;
            PG8_LDA(At, 0, 1); PG8_STAGE(PG8_SB(0, 0), b2, voffB); PG8_STAGE(PG8_SB(0, 1), b2 + hstepB, voffB); PG8_STAGE(PG8_SA(0, 0), a2, voffA);
            PG8_WAIT_V(8); PG8_WAIT_L(0); PG8_BAR; PG8_MMA(1, 0, At, B0); PG8_MMA(1, 1, At, B1); PG8_BAR; PG8_SCHED;
            PG8_LDB(B0, 1, 0); PG8_LDB(B1, 1, 1); PG8_SCHED; PG8_LDA(At, 1, 0); PG8_STAGE(PG8_SA(0, 1), a2 + hstepA, voffA);
            PG8_WAIT_V(8); PG8_WAIT_L(0); PG8_BAR; PG8_MMA(0, 0, At, B0); PG8_MMA(0, 1, At, B1); PG8_BAR; PG8_SCHED;
            PG8_LDA(At, 1, 1); PG8_STAGE(PG8_SB(1, 0), b3, voffB); PG8_STAGE(PG8_SB(1, 1), b3 + hstepB, voffB); PG8_STAGE(PG8_SA(1, 0), a3, voffA);
            PG8_WAIT_V(8); PG8_WAIT_L(0); PG8_BAR; PG8_MMA(1, 0, At, B0); PG8_MMA(1, 1, At, B1); PG8_BAR; PG8_SCHED;
            } else {
            PG8_LDB(B0, 0, 0); PG8_SCHED; PG8_LDA(At, 0, 0); PG8_STAGE(PG8_SA(1, 1), a1 + hstepA, voffA);
            PG8_WAIT_L(8); PG8_BAR; PG8_WAIT_L(0); PG8_MMA(0, 0, At, B0); PG8_BAR; PG8_SCHED;
            PG8_LDB(B1, 0, 1); PG8_STAGE(PG8_SB(0, 0), b2, voffB);
            PG8_BAR; PG8_WAIT_L(0); PG8_MMA(0, 1, At, B1); PG8_BAR;
            PG8_LDA(At, 0, 1); PG8_STAGE(PG8_SA(0, 0), a2, voffA);
            PG8_BAR; PG8_WAIT_L(0); PG8_MMA(1, 0, At, B0); PG8_BAR; PG8_SCHED;
            PG8_STAGE(PG8_SB(0, 1), b2 + hstepB, voffB);
            PG8_WAIT_V(6); PG8_BAR; PG8_MMA(1, 1, At, B1); PG8_BAR;
            PG8_LDB(B0, 1, 0); PG8_SCHED; PG8_LDA(At, 1, 0); PG8_STAGE(PG8_SA(0, 1), a2 + hstepA, voffA);
            PG8_WAIT_L(8); PG8_BAR; PG8_WAIT_L(0); PG8_MMA(0, 0, At, B0); PG8_BAR; PG8_SCHED;
            PG8_LDB(B1, 1, 1); PG8_STAGE(PG8_SB(1, 0), b3, voffB);
            PG8_BAR; PG8_WAIT_L(0); PG8_MMA(0, 1, At, B1); PG8_BAR;
            PG8_LDA(At, 1, 1); PG8_STAGE(PG8_SA(1, 0), a3, voffA);
            PG8_BAR; PG8_WAIT_L(0); PG8_MMA(1, 0, At, B0); PG8_BAR; PG8_SCHED;
            PG8_STAGE(PG8_SB(1, 1), b3 + hstepB, voffB);
            PG8_WAIT_V(6); PG8_BAR; PG8_MMA(1, 1, At, B1); PG8_BAR;
            }
        }
        if constexpr (ALIGN_EPI) { if (wr == 0) PG8_BAR; }
        E(acc, cur, wr, wc, fr, fq);
        if (!has_next) break;
#pragma unroll
        for (int a = 0; a < 2; ++a)
#pragma unroll
            for (int b = 0; b < 2; ++b)
#pragma unroll
                for (int m = 0; m < 4; ++m)
#pragma unroll
                    for (int n = 0; n < 2; ++n) acc[a][b][m][n] = (f32x4){0.f, 0.f, 0.f, 0.f};
        cur = nxt; cA = nA; cB = nB; ++ui;
        if constexpr (ALIGN_EPI) { if (wr == 1) PG8_BAR; }
    }
    PG8_WAIT_V(0);
    if constexpr (!ALIGN_EPI) { if (wr == 0) PG8_BAR; }
    PG8_BAR;
#undef PG8_SA
#undef PG8_SB
#undef PG8_STAGE
#undef PG8_LDA
#undef PG8_LDB
#undef PG8_MMA
#undef PG8_WAIT_V
#undef PG8_WAIT_L
#undef PG8_BAR
#undef PG8_SCHED
}
}

#define XB_TMO      128
#define XB_XCNT(j)  (256  + 64 * (j))
#define XB_XSUB(j)  (1280 + 64 * (j))
#define XB_XGEN(j)  (2304 + 64 * (j))
#define XB_TOP      3328
#define XB_TOPGEN   3392
#define XCD_BAR_WORDS 3456
#define XB_SPIN_CAP (1u << 18)

__device__ __forceinline__ unsigned xb_ld(unsigned* p)              { return __hip_atomic_load(p, __ATOMIC_RELAXED, __HIP_MEMORY_SCOPE_AGENT); }
__device__ __forceinline__ unsigned xb_add(unsigned* p, unsigned v) { return __hip_atomic_fetch_add(p, v, __ATOMIC_RELAXED, __HIP_MEMORY_SCOPE_AGENT); }
__device__ __forceinline__ unsigned xb_xcc_id() { return (unsigned)__builtin_amdgcn_s_getreg((3 << 11) | 20) & 0xFu; }
#define XB_SPIN(cond, bar) do { unsigned _sp = 0; while (cond) { __builtin_amdgcn_s_sleep(1); \
    if ((++_sp & 255u) == 0u) { if (xb_ld(&(bar)[XB_TMO])) break; if (_sp > XB_SPIN_CAP) { atomicAdd(&(bar)[XB_TMO], 1u); break; } } } } while (0)

struct XcdBarrier { unsigned* bar; unsigned x; volatile LAS unsigned* st; };

__device__ __forceinline__ XcdBarrier xcd_barrier_post(unsigned* bar, volatile LAS unsigned* st) {
    XcdBarrier b; b.bar = bar; b.x = xb_xcc_id(); b.st = st;
    if (threadIdx.x == 0) (void)xb_add(&bar[XB_XCNT(b.x)], 1u);
    return b;
}
__device__ __forceinline__ void xcd_barrier_complete(unsigned* bar, unsigned x, unsigned& nloc, unsigned& nx) {
    const unsigned G = gridDim.x * gridDim.y * gridDim.z;
    unsigned sum, cnt, mine, sp = 0u;
    for (;;) {
        sum = 0u; cnt = 0u; mine = 0u;
#pragma unroll
        for (unsigned j = 0; j < 16; ++j) { const unsigned c = xb_ld(&bar[XB_XCNT(j)]); sum += c; cnt += (c > 0u) ? 1u : 0u; mine = (j == x) ? c : mine; }
        if (sum == G) break;
        __builtin_amdgcn_s_sleep(1);
        if ((++sp & 255u) == 0u) { if (xb_ld(&bar[XB_TMO])) break; if (sp > XB_SPIN_CAP) { atomicAdd(&bar[XB_TMO], 1u); break; } }
    }
    nloc = mine > 0u ? mine : 1u; nx = cnt > 0u ? cnt : 1u;
}
__device__ __forceinline__ void xcd_barrier(const XcdBarrier& b) {
    asm volatile("s_waitcnt vmcnt(0)" ::: "memory");
    __syncthreads();
    if (threadIdx.x == 0) {
        unsigned* bar = b.bar;
        __builtin_amdgcn_s_waitcnt(0);
        unsigned nloc = b.st[0], nx = b.st[1];
        if (nloc == 0u) { xcd_barrier_complete(bar, b.x, nloc, nx); b.st[0] = nloc; b.st[1] = nx; }
        const unsigned old = xb_add(&bar[XB_XSUB(b.x)], 1u);
        const unsigned gen = old / nloc;
        if (old + 1u == (gen + 1u) * nloc) {
            __builtin_amdgcn_fence(__ATOMIC_RELEASE, "agent");
            asm volatile("s_waitcnt vmcnt(0)" ::: "memory");
            const unsigned og = xb_add(&bar[XB_TOP], 1u);
            const unsigned tg = og / nx;
            if (og + 1u == (tg + 1u) * nx) xb_add(&bar[XB_TOPGEN], 1u);
            else XB_SPIN(xb_ld(&bar[XB_TOPGEN]) == tg, bar);
            __builtin_amdgcn_fence(__ATOMIC_ACQUIRE, "agent");
            xb_add(&bar[XB_XGEN(b.x)], 1u);
            asm volatile("s_waitcnt vmcnt(0)" ::: "memory");
        } else {
            XB_SPIN(xb_ld(&bar[XB_XGEN(b.x)]) == gen, bar);
            __builtin_amdgcn_fence(__ATOMIC_ACQUIRE, "agent");
            asm volatile("s_waitcnt vmcnt(0)" ::: "memory");
        }
    }
    __syncthreads();
}

struct Frame {
    LAS unsigned char* lds;
    int tid, lane, wave, vcu, G;
    unsigned char* ws;
};
struct Args { const float* in[22]; float* out; unsigned char* ws; int ph_lo, ph_hi; };

__device__ __forceinline__ void cvt_tile(const float* W, size_t ldw, int k0, int n0, bf16* WT, size_t ldt, int dst_row0, int lane) {
    const int kb = lane >> 3, nb = lane & 7;
    const float* src = W + (size_t)(k0 + 8 * kb) * ldw + n0 + 4 * nb;
    f32x4 v[8];
#pragma unroll
    for (int j = 0; j < 8; ++j) v[j] = *(const f32x4*)(src + (size_t)j * ldw);
#pragma unroll
    for (int jn = 0; jn < 4; ++jn) { u32x4 o; o.x = cvt_pk_bf16(v[0][jn], v[1][jn]); o.y = cvt_pk_bf16(v[2][jn], v[3][jn]); o.z = cvt_pk_bf16(v[4][jn], v[5][jn]); o.w = cvt_pk_bf16(v[6][jn], v[7][jn]);
        *(u32x4*)(WT + (size_t)(dst_row0 + 4 * nb + jn) * ldt + k0 + 8 * kb) = o; }
}
struct MapId { __device__ __forceinline__ int operator()(int n) const { return n; } };
struct MapQKV { __device__ __forceinline__ int operator()(int n) const { const int gt = n >> 11, head = (n >> 7) & 15, d = n & 127; return (gt * 8 + (head >> 1)) * 256 + 128 * (d >> 6) + 64 * (head & 1) + (d & 63); } };
struct MapGU { int which; __device__ __forceinline__ int operator()(int n) const { return 256 * (n >> 7) + 128 * which + (n & 127); } };
template <class Map> __device__ __forceinline__ void cvt_matrix(const float* W, int K, int N, bf16* WT, size_t ldt, Map map, int& it0, int gw, int NGW, int lane) {
    const int nblk = N / 32, items = (K / 64) * nblk;
    int it = gw - it0; if (it < 0) it += ((-it + NGW - 1) / NGW) * NGW;
    for (; it < items; it += NGW) { const int kb = it / nblk, nb = it - kb * nblk; cvt_tile(W, (size_t)N, 64 * kb, 32 * nb, WT, ldt, map(32 * nb), lane); }
    it0 = (it0 + items) % NGW;
}
__device__ __forceinline__ void cvt_flat(const float* s, bf16* d, size_t n, int gw, int NGW, int lane) {
    for (size_t i = ((size_t)gw * 64 + lane) * 8; i < n; i += (size_t)NGW * 64 * 8) { const f32x4 a = *(const f32x4*)(s + i), b = *(const f32x4*)(s + i + 4);
        u32x4 o; o.x = cvt_pk_bf16(a[0], a[1]); o.y = cvt_pk_bf16(a[2], a[3]); o.z = cvt_pk_bf16(b[0], b[1]); o.w = cvt_pk_bf16(b[2], b[3]); *(u32x4*)(d + i) = o; }
}

__device__ __forceinline__ void p0_prologue(Frame& F, const Args& a) {
    const int gw = F.vcu * 8 + F.wave, NGW = F.G * 8, lane = F.lane; unsigned char* ws = F.ws; int it0 = 0;
    cvt_matrix(a.in[2], D, NQKV, (bf16*)(ws + WS_WQKV), D, MapQKV{}, it0, gw, NGW, lane);
    cvt_matrix(a.in[3], D, D, (bf16*)(ws + WS_WO), D, MapId{}, it0, gw, NGW, lane);
    cvt_matrix(a.in[12], D, FF, (bf16*)(ws + WS_W13), D, MapGU{0}, it0, gw, NGW, lane);
    cvt_matrix(a.in[13], D, FF, (bf16*)(ws + WS_W13), D, MapGU{1}, it0, gw, NGW, lane);
    cvt_matrix(a.in[14], FF, D, (bf16*)(ws + WS_W2), FF, MapId{}, it0, gw, NGW, lane);
    cvt_matrix(a.in[20], D, D, (bf16*)(ws + WS_WGATE), D, MapId{}, it0, gw, NGW, lane);
    cvt_matrix(a.in[20] + (size_t)D * D, D, D, (bf16*)(ws + WS_WGATE) + (size_t)D * D, D, MapId{}, it0, gw, NGW, lane);
    cvt_matrix(a.in[19], PLE, D, (bf16*)(ws + WS_WPROJ), PLE, MapId{}, it0, gw, NGW, lane);
    cvt_matrix(a.in[19] + (size_t)PLE * D, PLE, D, (bf16*)(ws + WS_WPROJ) + (size_t)D * PLE, PLE, MapId{}, it0, gw, NGW, lane);
    cvt_matrix(a.in[4], D, D, (bf16*)(ws + WS_WIN), D, MapId{}, it0, gw, NGW, lane);
    cvt_matrix(a.in[7], D, D, (bf16*)(ws + WS_WO2), D, MapId{}, it0, gw, NGW, lane);
    { const float* wg = a.in[5]; const float* sc = a.in[6]; bf16* o = (bf16*)(ws + WS_WGS);
      for (size_t i = ((size_t)gw * 64 + lane) * 8; i < (size_t)4 * 512 * 512; i += (size_t)NGW * 64 * 8) { const int g = (int)(i >> 18), d = (int)(i & 511);
          const f32x4 x0 = *(const f32x4*)(wg + i), x1 = *(const f32x4*)(wg + i + 4), s0 = *(const f32x4*)(sc + g * 512 + d), s1 = *(const f32x4*)(sc + g * 512 + d + 4);
          const f32x4 y0 = x0 * s0, y1 = x1 * s1; u32x4 w; w.x = cvt_pk_bf16(y0[0], y0[1]); w.y = cvt_pk_bf16(y0[2], y0[3]); w.z = cvt_pk_bf16(y1[0], y1[1]); w.w = cvt_pk_bf16(y1[2], y1[3]); *(u32x4*)(o + i) = w; } }
    cvt_flat(a.in[0], (bf16*)(ws + WS_XB0), (size_t)MTOK * D, gw, NGW, lane);
    cvt_flat(a.in[1], (bf16*)(ws + WS_PB), (size_t)2 * MTOK * PLE, gw, NGW, lane);
    { float* ct = (float*)(ws + WS_ROPE); float* st = ct + SEQ * 64;
      for (int i = gw * 64 + lane; i < SEQ * 64; i += NGW * 64) { const int pos = i >> 6, j = i & 63;
          const double inv = exp2(-(double)j * (13.287712379549449 / 64.0));
          const double ang = (double)pos * inv; ct[i] = (float)cos(ang); st[i] = (float)sin(ang); } }
}

__device__ __forceinline__ void attn_phase(Frame& F) {
    const bf16* QKV = (const bf16*)(F.ws + WS_QKV); bf16* OG = (bf16*)(F.ws + WS_OG); float* LSE = (float*)(F.ws + WS_LSE);
    LAS unsigned char* Kl = F.lds; LAS unsigned char* Vl = F.lds + 65536;
    const int w = F.wave, lane = F.lane, q16 = lane & 15, g4 = lane >> 4, sw = ((g4 & 1) << 1) | (g4 >> 1);
    const int pi16 = (q16 & 3) | ((q16 & 4) << 1) | ((q16 & 8) >> 1);
    constexpr int UPW = 6144 / 256;
    const int total = 6144; const int per = (total + F.G - 1) / F.G;
    for (int k = 0; k < per; ++k) {
        const int idx = F.vcu * per + k; if (idx >= total) break;
        const int g = idx >> 11, rem = idx & 2047; const int dsh = 2 * g, dil = 1 << dsh, nbsh = 5 - dsh, nb = 1 << nbsh;
        const int n = rem & (nb - 1), rem2 = rem >> nbsh, r = rem2 & (dil - 1), bh = rem2 >> dsh, b = bh >> 4, h = bh & 15;
        const size_t tok0 = (size_t)b * SEQ + r;
        const int colQ = (g * 3 + 0) * 2048 + h * 128, colK = colQ + 2048, colV = colQ + 4096;
        __syncthreads();
#pragma unroll
        for (int i = 0; i < 8; ++i) {
            const int row = (i * 8 + w) * 4 + (lane >> 4), cs = lane & 15;
            int j = 128 * (n - 1) + row; if (n == 0 && row < 128) j += 128;
            const bf16* rp = QKV + (tok0 + (size_t)j * dil) * NQKV;
            const int ck = cs ^ (row & 7), cv = cs ^ (((row & 3) << 2) | ((row >> 2) & 3));
            __builtin_amdgcn_global_load_lds((const unsigned*)(rp + colK + ck * 8), (LAS unsigned*)(Kl + (i * 8 + w) * 1024), 16, 0, 0);
            __builtin_amdgcn_global_load_lds((const unsigned*)(rp + colV + cv * 8), (LAS unsigned*)(Vl + (i * 8 + w) * 1024), 16, 0, 0);
        }
        const size_t qtok = tok0 + (size_t)(128 * n + 16 * w + q16) * dil;
        bf16x8 bq[4];
#pragma unroll
        for (int ks = 0; ks < 4; ++ks) bq[ks] = *(const bf16x8*)(QKV + qtok * NQKV + colQ + 32 * ks + 8 * g4);
        VM_WAIT();
        __syncthreads();
        f32x4 s[9];
#pragma unroll
        for (int ti = 0; ti < 9; ++ti) {
            const int kt = w + ti; f32x4 acc = (f32x4){0.f, 0.f, 0.f, 0.f};
            if (n > 0 || kt >= 8) {
                const int row = 16 * kt + pi16;
#pragma unroll
                for (int ks = 0; ks < 4; ++ks) { const int c = 4 * ks + g4;
                    const bf16x8 av = *(const LAS bf16x8*)(Kl + row * 256 + ((c ^ (row & 7)) << 4));
                    acc = __builtin_amdgcn_mfma_f32_16x16x32_bf16(av, bq[ks], acc, 0, 0, 0); }
            }
            s[ti] = acc;
        }
        const float C2 = 0.08838834764831845f * 1.4426950408889634f; const float NEG = -__builtin_inff();
        float mx = NEG;
#pragma unroll
        for (int ti = 0; ti < 9; ++ti) {
            const bool tile_ok = (n > 0 || w + ti >= 8);
#pragma unroll
            for (int i = 0; i < 4; ++i) { const int kk = 4 * sw + i; bool ok = tile_ok;
                if (ti == 0) ok = ok && (kk >= q16);
                if (ti == 8) ok = ok && (kk <= q16);
                const float v = ok ? s[ti][i] * C2 : NEG; s[ti][i] = v; mx = fmaxf(mx, v); }
        }
        mx = fmaxf(mx, __shfl_xor(mx, 16)); mx = fmaxf(mx, __shfl_xor(mx, 32));
        float l = 0.f;
#pragma unroll
        for (int ti = 0; ti < 9; ++ti)
#pragma unroll
            for (int i = 0; i < 4; ++i) { const float p = __builtin_amdgcn_exp2f(s[ti][i] - mx); s[ti][i] = p; l += p; }
        l += __shfl_xor(l, 16); l += __shfl_xor(l, 32);
        bf16x8 pf[5];
#pragma unroll
        for (int u = 0; u < 5; ++u) { u32x4 wv; wv.x = cvt_pk_bf16(s[2 * u][0], s[2 * u][1]); wv.y = cvt_pk_bf16(s[2 * u][2], s[2 * u][3]);
            if (u < 4) { wv.z = cvt_pk_bf16(s[2 * u + 1][0], s[2 * u + 1][1]); wv.w = cvt_pk_bf16(s[2 * u + 1][2], s[2 * u + 1][3]); } else { wv.z = 0u; wv.w = 0u; }
            pf[u] = __builtin_bit_cast(bf16x8, wv); }
        const int qq = q16 >> 2, pp = q16 & 3;
        const float rl = 1.0f / l;
        const size_t orow = (size_t)g * MTOK * D + qtok * D + h * 128;
#pragma unroll
        for (int dt = 0; dt < 8; ++dt) {
            f32x4 o = (f32x4){0.f, 0.f, 0.f, 0.f};
#pragma unroll
            for (int u = 0; u < 5; ++u) {
                const int r0 = 16 * (w + 2 * u) + 4 * sw + qq, ch = 2 * dt + (pp >> 1);
                const s16x4 lo = __builtin_bit_cast(s16x4, __builtin_amdgcn_ds_read_tr16_b64_v4i16((LAS s16x4*)(Vl + 256 * r0 + 16 * (ch ^ (((r0 & 3) << 2) | ((r0 >> 2) & 3))) + 8 * (pp & 1))));
                s16x4 hi = (s16x4){0, 0, 0, 0};
                if (u < 4) { const int r1 = r0 + 16;
                    hi = __builtin_bit_cast(s16x4, __builtin_amdgcn_ds_read_tr16_b64_v4i16((LAS s16x4*)(Vl + 256 * r1 + 16 * (ch ^ (((r1 & 3) << 2) | ((r1 >> 2) & 3))) + 8 * (pp & 1)))); }
                bf16x8 av; av[0] = lo[0]; av[1] = lo[1]; av[2] = lo[2]; av[3] = lo[3]; av[4] = hi[0]; av[5] = hi[1]; av[6] = hi[2]; av[7] = hi[3];
                o = __builtin_amdgcn_mfma_f32_16x16x32_bf16(av, pf[u], o, 0, 0, 0);
            }
            o = o * rl;
            u32x2 wv; wv.x = cvt_pk_bf16(o[0], o[1]); wv.y = cvt_pk_bf16(o[2], o[3]);
            *(u32x2*)(OG + orow + 16 * dt + 4 * g4) = wv;
        }
        if (g4 == 0) LSE[((size_t)g * MTOK + qtok) * NH + h] = mx * 0.6931471805599453f + __logf(l);
    }
    (void)UPW;
    __syncthreads();
}

__device__ __forceinline__ void combine_phase(Frame& F) {
    const bf16* OG = (const bf16*)(F.ws + WS_OG); const float* LSE = (const float*)(F.ws + WS_LSE); bf16* ATT = (bf16*)(F.ws + WS_ATT);
    const int gw = F.vcu * 8 + F.wave, NGW = F.G * 8, lane = F.lane;
    for (int m = gw; m < MTOK; m += NGW) {
#pragma unroll
        for (int j = 0; j < 4; ++j) { const int c = lane + 64 * j, h = c >> 4;
            const float l0 = LSE[(size_t)m * NH + h], l1 = LSE[((size_t)MTOK + m) * NH + h], l2 = LSE[((size_t)2 * MTOK + m) * NH + h];
            const float mx = fmaxf(l0, fmaxf(l1, l2)); float w0 = __expf(l0 - mx), w1 = __expf(l1 - mx), w2 = __expf(l2 - mx); const float rs = 1.0f / (w0 + w1 + w2); w0 *= rs; w1 *= rs; w2 *= rs;
            const u32x4 a = *(const u32x4*)(OG + (size_t)m * D + c * 8), b = *(const u32x4*)(OG + ((size_t)MTOK + m) * D + c * 8), d = *(const u32x4*)(OG + ((size_t)2 * MTOK + m) * D + c * 8);
            u32x4 o;
#pragma unroll
            for (int e = 0; e < 4; ++e) { const float lo = w0 * bf_lo(a[e]) + w1 * bf_lo(b[e]) + w2 * bf_lo(d[e]), hi = w0 * bf_hi(a[e]) + w1 * bf_hi(b[e]) + w2 * bf_hi(d[e]); o[e] = cvt_pk_bf16(lo, hi); }
            *(u32x4*)(ATT + (size_t)m * D + c * 8) = o; }
    }
}
__device__ __forceinline__ void moe_convert_phase(Frame& F, const Args& a) {
    const int gw = F.vcu * 8 + F.wave, NGW = F.G * 8, lane = F.lane; int it0 = 0;
    bf16* W13 = (bf16*)(F.ws + WS_MW13); bf16* W2 = (bf16*)(F.ws + WS_MW2);
    for (int e = 0; e < NE; ++e) {
        cvt_matrix(a.in[16] + (size_t)e * D * FF, D, FF, W13 + (size_t)e * FF2 * D, D, MapGU{0}, it0, gw, NGW, lane);
        cvt_matrix(a.in[17] + (size_t)e * D * FF, D, FF, W13 + (size_t)e * FF2 * D, D, MapGU{1}, it0, gw, NGW, lane);
        cvt_matrix(a.in[18] + (size_t)e * FF * D, FF, D, W2 + (size_t)e * D * FF, FF, MapId{}, it0, gw, NGW, lane);
    }
}

__device__ __forceinline__ void ln_core(f32x4 (&v)[8], const f32x4 (&gg)[8], const f32x4 (&bb)[8]) {
    float s = 0.f;
#pragma unroll
    for (int j = 0; j < 8; ++j) s += (v[j][0] + v[j][1]) + (v[j][2] + v[j][3]);
    const float mean = wave_sum(s) * (1.f / D); float s2 = 0.f;
#pragma unroll
    for (int j = 0; j < 8; ++j) { v[j] = v[j] - mean; s2 += (v[j][0] * v[j][0] + v[j][1] * v[j][1]) + (v[j][2] * v[j][2] + v[j][3] * v[j][3]); }
    const float rstd = 1.0f / sqrtf(wave_sum(s2) * (1.f / D) + LN_EPS);
#pragma unroll
    for (int j = 0; j < 8; ++j) v[j] = v[j] * rstd * gg[j] + bb[j];
}
__device__ __forceinline__ void ln_store(const f32x4 (&v)[8], float* xf, bf16* xb, int lane) {
#pragma unroll
    for (int j = 0; j < 8; ++j) { *(f32x4*)(xf + 4 * lane + 256 * j) = v[j]; u32x2 w; w.x = cvt_pk_bf16(v[j][0], v[j][1]); w.y = cvt_pk_bf16(v[j][2], v[j][3]); *(u32x2*)(xb + 4 * lane + 256 * j) = w; }
}
__device__ __forceinline__ void ln_phase(Frame& F, const float* Y, const float* gam, const float* bet, float* XF, bf16* XB) {
    const int gw = F.vcu * 8 + F.wave, NGW = F.G * 8, lane = F.lane;
    f32x4 gg[8], bb[8];
#pragma unroll
    for (int j = 0; j < 8; ++j) { gg[j] = *(const f32x4*)(gam + 4 * lane + 256 * j); bb[j] = *(const f32x4*)(bet + 4 * lane + 256 * j); }
    for (int m = gw; m < MTOK; m += NGW) {
        f32x4 v[8];
#pragma unroll
        for (int j = 0; j < 8; ++j) v[j] = *(const f32x4*)(Y + (size_t)m * D + 4 * lane + 256 * j);
        ln_core(v, gg, bb); ln_store(v, XF + (size_t)m * D, XB + (size_t)m * D, lane);
    }
}
__device__ __forceinline__ void pool_phase(Frame& F) {
    const bf16* U = (const bf16*)(F.ws + WS_U); bf16* MIX = (bf16*)(F.ws + WS_MIX);
    const int gw = F.vcu * 8 + F.wave, NGW = F.G * 8, lane = F.lane;
    for (int m = gw; m < MTOK; m += NGW) { const int t = m & (SEQ - 1);
#pragma unroll
        for (int j = 0; j < 4; ++j) { const int c = lane + 64 * j, wlen = 2 << (c >> 6);
            const int cnt = (t + 1 < wlen) ? t + 1 : wlen; float acc[8];
#pragma unroll
            for (int e = 0; e < 8; ++e) acc[e] = 0.f;
            u32x4 self = (u32x4){0u, 0u, 0u, 0u};
            for (int i = 0; i < cnt; ++i) { const u32x4 x = *(const u32x4*)(U + (size_t)(m - i) * D + c * 8); if (i == 0) self = x;
#pragma unroll
                for (int e = 0; e < 4; ++e) { acc[2 * e] += bf_lo(x[e]); acc[2 * e + 1] += bf_hi(x[e]); } }
            const float rc = 1.0f / (float)cnt; u32x4 o;
#pragma unroll
            for (int e = 0; e < 4; ++e) o[e] = cvt_pk_bf16(acc[2 * e] * rc - bf_lo(self[e]), acc[2 * e + 1] * rc - bf_hi(self[e]));
            *(u32x4*)(MIX + (size_t)m * D + c * 8) = o; }
    }
}
__device__ __forceinline__ void ln_router_phase(Frame& F, const float* Y, const float* gam, const float* bet, const float* wrt, float* XF, bf16* XB) {
    const int gw = F.vcu * 8 + F.wave, NGW = F.G * 8, lane = F.lane, tid = F.tid;
    LAS float* WR = (LAS float*)F.lds;
    LAS int* cntl = (LAS int*)(F.lds + 65536);
    LAS int* info = (LAS int*)(F.lds + 65536 + 64);
    int* LIST = (int*)(F.ws + WS_LIST); int* TOK = (int*)(F.ws + WS_TOK); unsigned* gcnt = (unsigned*)(F.ws + WS_CTL) + CW_CNT;
    __syncthreads();
    for (int i = tid; i < D * NE; i += 512) { const int c = i >> 3, e = i & 7; WR[e * D + c] = wrt[i]; }
    if (tid < 16) cntl[tid] = 0;
    __syncthreads();
    f32x4 gg[8], bb[8];
#pragma unroll
    for (int j = 0; j < 8; ++j) { gg[j] = *(const f32x4*)(gam + 4 * lane + 256 * j); bb[j] = *(const f32x4*)(bet + 4 * lane + 256 * j); }
    int k = 0;
    for (int m = gw; m < MTOK; m += NGW, ++k) {
        f32x4 v[8];
#pragma unroll
        for (int j = 0; j < 8; ++j) v[j] = *(const f32x4*)(Y + (size_t)m * D + 4 * lane + 256 * j);
        ln_core(v, gg, bb); ln_store(v, XF + (size_t)m * D, XB + (size_t)m * D, lane);
        float lg[8];
#pragma unroll
        for (int e = 0; e < 8; ++e) { float s = 0.f;
#pragma unroll
            for (int j = 0; j < 8; ++j) { const f32x4 wv = *(const LAS f32x4*)(WR + e * D + 4 * lane + 256 * j); s += (v[j][0] * wv[0] + v[j][1] * wv[1]) + (v[j][2] * wv[2] + v[j][3] * wv[3]); }
            lg[e] = wave_sum(s); }
        int e1 = 0; float v1 = lg[0];
#pragma unroll
        for (int e = 1; e < 8; ++e) if (lg[e] > v1) { v1 = lg[e]; e1 = e; }
        int e2 = -1; float v2 = -__builtin_inff();
#pragma unroll
        for (int e = 0; e < 8; ++e) if (e != e1 && lg[e] > v2) { v2 = lg[e]; e2 = e; }
        if (lane == 0 && k < 8) { const float ex = __expf(v2 - v1), g1 = 1.0f / (1.0f + ex), g2 = ex * g1;
            const int ls1 = atomicAdd((int*)&cntl[e1], 1), ls2 = atomicAdd((int*)&cntl[e2], 1);
            LAS int* q = info + (F.wave * 8 + k) * 8; q[0] = m; q[1] = e1; q[2] = e2; q[3] = ls1; q[4] = ls2; q[5] = __float_as_int(g1); q[6] = __float_as_int(g2); }
    }
    const int nrows = k < 8 ? k : 8;
    if (lane == 0) info[512 + F.wave] = nrows;
    __syncthreads();
    if (tid < 8) cntl[8 + tid] = (int)__hip_atomic_fetch_add(gcnt + 64 * tid, (unsigned)cntl[tid], __ATOMIC_RELAXED, __HIP_MEMORY_SCOPE_AGENT);
    __syncthreads();
    if (tid < 64) { const int wv = tid >> 3, kk = tid & 7;
        if (kk < info[512 + wv]) { const LAS int* q = info + tid * 8; const int m = q[0], e1 = q[1], e2 = q[2], s1 = cntl[8 + e1] + q[3], s2 = cntl[8 + e2] + q[4];
            LIST[e1 * MTOK + s1] = m; LIST[e2 * MTOK + s2] = m;
            int* t = TOK + (size_t)m * 8; t[0] = e1; t[1] = s1; t[2] = q[5]; t[3] = e2; t[4] = s2; t[5] = q[6]; } }
    __syncthreads();
}
__device__ __forceinline__ void moe_prefix(Frame& F, int (&tb)[9], int (&cnt)[8]) {
    const unsigned* gcnt = (const unsigned*)(F.ws + WS_CTL) + CW_CNT; tb[0] = 0;
#pragma unroll
    for (int e = 0; e < 8; ++e) { cnt[e] = (int)__builtin_amdgcn_readfirstlane(gcnt[64 * e]); tb[e + 1] = tb[e] + ((cnt[e] + 255) >> 8); }
}
__device__ __forceinline__ void gather_phase(Frame& F) {
    const int gw = F.vcu * 8 + F.wave, NGW = F.G * 8, lane = F.lane;
    int tb[9], cnt[8]; moe_prefix(F, tb, cnt);
    const int* LIST = (const int*)(F.ws + WS_LIST); const bf16* XB = (const bf16*)(F.ws + WS_XB0); bf16* XG = (bf16*)(F.ws + WS_XG);
    const int rows = tb[8] * 256;
    for (int rr = gw; rr < rows; rr += NGW) { const int tile = rr >> 8; int e = 0;
#pragma unroll
        for (int j = 1; j < 8; ++j) e += (tile >= tb[j]) ? 1 : 0;
        int base = 0, ce = 0;
#pragma unroll
        for (int j = 0; j < 8; ++j) if (j == e) { base = tb[j] * 256; ce = cnt[j]; }
        const int s = rr - base; u32x4 v[4];
        if (s < ce) { const int tok = LIST[e * MTOK + s];
#pragma unroll
            for (int j = 0; j < 4; ++j) v[j] = *(const u32x4*)(XB + (size_t)tok * D + (lane + 64 * j) * 8); }
        else {
#pragma unroll
            for (int j = 0; j < 4; ++j) v[j] = (u32x4){0u, 0u, 0u, 0u}; }
#pragma unroll
        for (int j = 0; j < 4; ++j) *(u32x4*)(XG + (size_t)rr * D + (lane + 64 * j) * 8) = v[j]; }
}
__device__ __forceinline__ void ln_moe_phase(Frame& F, const float* X4, const float* gam, const float* bet, float* XF, bf16* XB) {
    const int gw = F.vcu * 8 + F.wave, NGW = F.G * 8, lane = F.lane;
    int tb[9], cnt[8]; moe_prefix(F, tb, cnt);
    const int* TOK = (const int*)(F.ws + WS_TOK); const bf16* YE = (const bf16*)(F.ws + WS_XG);
    f32x4 gg[8], bb[8];
#pragma unroll
    for (int j = 0; j < 8; ++j) { gg[j] = *(const f32x4*)(gam + 4 * lane + 256 * j); bb[j] = *(const f32x4*)(bet + 4 * lane + 256 * j); }
    for (int m = gw; m < MTOK; m += NGW) {
        const int* t = TOK + (size_t)m * 8; const int e1 = t[0], s1 = t[1], e2 = t[3], s2 = t[4]; const float g1 = __int_as_float(t[2]), g2 = __int_as_float(t[5]);
        int b1 = 0, b2 = 0;
#pragma unroll
        for (int j = 0; j < 8; ++j) { if (j == e1) b1 = tb[j] * 256; if (j == e2) b2 = tb[j] * 256; }
        const bf16* y1 = YE + (size_t)(b1 + s1) * D; const bf16* y2 = YE + (size_t)(b2 + s2) * D;
        f32x4 v[8];
#pragma unroll
        for (int j = 0; j < 8; ++j) { const f32x4 x = *(const f32x4*)(X4 + (size_t)m * D + 4 * lane + 256 * j); const u32x2 a = *(const u32x2*)(y1 + 4 * lane + 256 * j), b = *(const u32x2*)(y2 + 4 * lane + 256 * j);
            v[j][0] = DN_ALPHA * x[0] + g1 * bf_lo(a.x) + g2 * bf_lo(b.x); v[j][1] = DN_ALPHA * x[1] + g1 * bf_hi(a.x) + g2 * bf_hi(b.x);
            v[j][2] = DN_ALPHA * x[2] + g1 * bf_lo(a.y) + g2 * bf_lo(b.y); v[j][3] = DN_ALPHA * x[3] + g1 * bf_hi(a.y) + g2 * bf_hi(b.y); }
        ln_core(v, gg, bb); ln_store(v, XF + (size_t)m * D, XB + (size_t)m * D, lane);
    }
}

constexpr int NPHASE = 19;
__global__ void __launch_bounds__(512, 2) fwd_kernel(Args args) {
    extern __shared__ __attribute__((aligned(16))) unsigned char lds[];
    Frame F; F.lds = (LAS unsigned char*)lds; F.tid = threadIdx.x; F.lane = F.tid & 63; F.wave = __builtin_amdgcn_readfirstlane(F.tid >> 6);
    F.G = gridDim.x; { const int bx = blockIdx.x; F.vcu = (F.G % 8 == 0) ? (bx % 8) * (F.G / 8) + bx / 8 : bx; }
    F.ws = args.ws; unsigned char* ws = args.ws;
    volatile LAS unsigned* MISC = (volatile LAS unsigned*)(F.lds + MISC_OFF);
    for (int u = F.tid; u < (LDS_BYTES - LDSCTL_OFF) / 4; u += 512) ((LAS unsigned*)(F.lds + LDSCTL_OFF))[u] = 0u;
    __syncthreads();
    XcdBarrier bar; bar.bar = (unsigned*)(ws + WS_CTL) + CW_BAR; bar.x = 0; bar.st = nullptr;
    if (!MK_PER_PHASE) bar = xcd_barrier_post((unsigned*)(ws + WS_CTL) + CW_BAR, MISC + 8);
    const int lo = args.ph_lo, hi = args.ph_hi;
#define IN(k) (lo <= (k) && (k) < hi)
#define SEAM(k) do { if (IN(k) && IN((k) + 1)) xcd_barrier(bar); } while (0)
    LAS unsigned char* ring = F.lds;
    const int bx = (int)blockIdx.x;
    bf16* XB0 = (bf16*)(ws + WS_XB0); bf16* XB1 = (bf16*)(ws + WS_XB1); float* XFA = (float*)(ws + WS_XFA); float* XFB = (float*)(ws + WS_XFB); float* Y = args.out;

    if (IN(0)) { p0_prologue(F, args); } SEAM(0);
    if (IN(1)) {
        { pg8::Gemm g{XB0, (const bf16*)(ws + WS_WQKV), D, D, D}; pg8::StaticOrder S; S.init(MTOK, NQKV, F.G, bx);
          pg8::EpiQKV E{(bf16*)(ws + WS_QKV), (const float*)(ws + WS_ROPE)}; pg8::gemm_phase(ring, g, S, E); }
        { pg8::Gemm g{(const bf16*)(ws + WS_PB), (const bf16*)(ws + WS_WPROJ), PLE, PLE, PLE}; pg8::BatchOrder S; S.init(MTOK, D, 2, (size_t)MTOK * PLE, (size_t)D * PLE, F.G, bx);
          pg8::EpiBf16 E{(bf16*)(ws + WS_PPROJ), D, (size_t)MTOK * D, 0}; pg8::gemm_phase(ring, g, S, E); }
        {
          pg8::Gemm g{(const bf16*)(ws + WS_WO2), (const bf16*)(ws + WS_WGS), 512, D, 512}; pg8::BatchOrder S; S.init(D, 512, 4, (size_t)512, (size_t)512 * 512, F.G, bx);
          pg8::EpiBf16 E{(bf16*)(ws + WS_WCOMB), D, (size_t)0, 512}; pg8::gemm_phase(ring, g, S, E); }
    } SEAM(1);
    if (IN(2)) { attn_phase(F); } SEAM(2);
    if (IN(3)) { combine_phase(F); moe_convert_phase(F, args); } SEAM(3);
    if (IN(4)) { pg8::Gemm g{(const bf16*)(ws + WS_ATT), (const bf16*)(ws + WS_WO), D, D, D}; pg8::StaticOrder S; S.init(MTOK, D, F.G, bx);
        pg8::EpiRes E{args.in[0], Y, D, DN_ALPHA}; pg8::gemm_phase(ring, g, S, E); } SEAM(4);
    if (IN(5)) { ln_phase(F, Y, args.in[8], args.in[9], XFA, XB0); } SEAM(5);
    if (IN(6)) { pg8::Gemm g{XB0, (const bf16*)(ws + WS_W13), D, D, D}; pg8::StaticOrder S; S.init(MTOK, FF2, F.G, bx);
        pg8::EpiSwiGLU E{(bf16*)(ws + WS_H), FF}; pg8::gemm_phase(ring, g, S, E); } SEAM(6);
    if (IN(7)) { pg8::Gemm g{(const bf16*)(ws + WS_H), (const bf16*)(ws + WS_W2), FF, FF, FF}; pg8::StaticOrder S; S.init(MTOK, D, F.G, bx);
        pg8::EpiRes E{XFA, Y, D, DN_ALPHA}; pg8::gemm_phase(ring, g, S, E); } SEAM(7);
    if (IN(8)) { ln_phase(F, Y, args.in[10], args.in[11], XFB, XB0); } SEAM(8);
    if (IN(9)) { pg8::Gemm g{XB0, (const bf16*)(ws + WS_WGATE), D, D, D}; pg8::StaticOrder S; S.init(MTOK, D, F.G, bx);
        pg8::EpiPle E{XFB, (const bf16*)(ws + WS_PPROJ), args.in[21], XFA, XB1, D}; pg8::gemm_phase(ring, g, S, E); } SEAM(9);
    if (IN(10)) { pg8::Gemm g{XB1, (const bf16*)(ws + WS_WIN), D, D, D}; pg8::StaticOrder S; S.init(MTOK, D, F.G, bx);
        pg8::EpiBf16 E{(bf16*)(ws + WS_U), D, (size_t)0, 0}; pg8::gemm_phase(ring, g, S, E); } SEAM(10);
    if (IN(11)) { pool_phase(F); } SEAM(11);
    if (IN(12)) { pg8::Gemm g{(const bf16*)(ws + WS_MIX), (const bf16*)(ws + WS_WCOMB), D, D, D}; pg8::StaticOrder S; S.init(MTOK, D, F.G, bx);
        pg8::EpiRes E{XFA, Y, D, DN_ALPHA}; pg8::gemm_phase(ring, g, S, E); } SEAM(12);
    if (IN(13)) { ln_router_phase(F, Y, args.in[8] + D, args.in[9] + D, args.in[15], XFB, XB0); } SEAM(13);
    if (IN(14)) { gather_phase(F); } SEAM(14);
    if (IN(15)) { int tb[9], cnt[8]; moe_prefix(F, tb, cnt);
        pg8::Gemm g{(const bf16*)(ws + WS_XG), (const bf16*)(ws + WS_MW13), D, D, D}; pg8::MoeOrder S; S.nM = tb[8]; S.nN = FF2 / 256; S.nwg = S.nM * S.nN; S.G = F.G; S.c = bx; S.sB = (size_t)FF2 * D;
#pragma unroll
        for (int j = 0; j < 9; ++j) S.tb[j] = tb[j];
        pg8::EpiSwiGLU E{(bf16*)(ws + WS_HM), FF}; pg8::gemm_phase(ring, g, S, E); } SEAM(15);
    if (IN(16)) { int tb[9], cnt[8]; moe_prefix(F, tb, cnt);
        pg8::Gemm g{(const bf16*)(ws + WS_HM), (const bf16*)(ws + WS_MW2), FF, FF, FF}; pg8::MoeOrder S; S.nM = tb[8]; S.nN = D / 256; S.nwg = S.nM * S.nN; S.G = F.G; S.c = bx; S.sB = (size_t)D * FF;
#pragma unroll
        for (int j = 0; j < 9; ++j) S.tb[j] = tb[j];
        pg8::EpiBf16 E{(bf16*)(ws + WS_XG), D, (size_t)0, 0}; pg8::gemm_phase(ring, g, S, E); } SEAM(16);
    if (IN(17)) { ln_moe_phase(F, XFB, args.in[10] + D, args.in[11] + D, XFA, XB0); } SEAM(17);
    if (IN(18)) { pg8::Gemm g{XB0, (const bf16*)(ws + WS_WGATE) + (size_t)D * D, D, D, D}; pg8::StaticOrder S; S.init(MTOK, D, F.G, bx);
        pg8::EpiPle E{XFA, (const bf16*)(ws + WS_PPROJ) + (size_t)MTOK * D, args.in[21] + D, args.out, nullptr, D}; pg8::gemm_phase(ring, g, S, E); }
#undef IN
#undef SEAM
}

extern "C" void kernel_launch(void* const* d_in, const int* in_sizes, int n_in, void* d_out, int out_size, void* d_ws, size_t ws_size, hipStream_t stream) {
    static int grid = 0;
    if (grid == 0) {
        if (n_in != 22 || out_size != MTOK * D || ws_size < WS_END) { fprintf(stderr, "kernel_launch: unexpected shapes (n_in %d, out %d, ws %zu < %zu)\n", n_in, out_size, ws_size, (size_t)WS_END); grid = -1; return; }
        int dev = 0, cus = 0, per_cu = 0;
        if (hipGetDevice(&dev) != hipSuccess || hipDeviceGetAttribute(&cus, hipDeviceAttributeMultiprocessorCount, dev) != hipSuccess) { grid = -1; return; }
        if (hipFuncSetAttribute((const void*)fwd_kernel, hipFuncAttributeMaxDynamicSharedMemorySize, LDS_BYTES) != hipSuccess) { fprintf(stderr, "kernel_launch: hipFuncSetAttribute failed\n"); grid = -1; return; }
        if (hipOccupancyMaxActiveBlocksPerMultiprocessor(&per_cu, (const void*)fwd_kernel, 512, LDS_BYTES) != hipSuccess || per_cu < 1) { fprintf(stderr, "kernel_launch: occupancy query says %d blocks per CU\n", per_cu); }
        (void)hipGetLastError();
        grid = cus;
    }
    if (grid < 0) return;
    (void)hipMemsetAsync((char*)d_ws + WS_CTL, 0, CTL_ZERO_BYTES, stream);
    Args a{};
    for (int i = 0; i < 22; ++i) a.in[i] = (const float*)d_in[i];
    a.out = (float*)d_out; a.ws = (unsigned char*)d_ws;
#if MK_PER_PHASE
    for (int p = 0; p < NPHASE; ++p) { a.ph_lo = p; a.ph_hi = p + 1; hipLaunchKernelGGL(fwd_kernel, dim3(grid), dim3(512), LDS_BYTES, stream, a); }
#else
    a.ph_lo = 0; a.ph_hi = NPHASE; hipLaunchKernelGGL(fwd_kernel, dim3(grid), dim3(512), LDS_BYTES, stream, a);
#endif
}
```

```cpp
#include <hip/hip_runtime.h>
#include <cstdio>
#include <cstdint>

#ifndef MK_PER_PHASE
#define MK_PER_PHASE 0
#endif

#define LAS __attribute__((address_space(3)))
#define GAS __attribute__((address_space(1)))
typedef unsigned short bf16;
typedef short bf16x8 __attribute__((ext_vector_type(8)));
typedef short s16x4 __attribute__((ext_vector_type(4)));
typedef float f32x4 __attribute__((ext_vector_type(4)));
typedef float f32x2 __attribute__((ext_vector_type(2)));
typedef unsigned u32x4 __attribute__((ext_vector_type(4)));
typedef unsigned u32x2 __attribute__((ext_vector_type(2)));
typedef GAS unsigned gu32;

constexpr int D = 2048, BATCH = 4, SEQ = 4096, MTOK = BATCH * SEQ;
constexpr int NH = 16, HD = 128, NQKV = 3 * 3 * D;
constexpr int FF = 5632, FF2 = 2 * FF;
constexpr int NE = 8, PLE = 256;
constexpr float LN_EPS = 1e-5f;
constexpr float DN_ALPHA = 1.41421356237309515f;
constexpr int MOE_ROWS = 2 * MTOK + NE * 256;

constexpr size_t MiB = 1u << 20;
constexpr size_t WS_CTL = 0, CTL_ZERO_BYTES = 1 * MiB;
constexpr size_t WS_LIST = 1 * MiB;
constexpr size_t WS_TOK = 2 * MiB;
constexpr size_t WS_LSE = 3 * MiB;
constexpr size_t WS_ROPE = 6 * MiB;
constexpr size_t WS_WGATE = 8 * MiB;
constexpr size_t WS_WPROJ = 24 * MiB;
constexpr size_t WS_WIN = 26 * MiB;
constexpr size_t WS_WCOMB = 34 * MiB;
constexpr size_t WS_WO2 = 42 * MiB;
constexpr size_t WS_WGS = 50 * MiB;
constexpr size_t WS_PB = 52 * MiB;
constexpr size_t WS_PPROJ = 68 * MiB;
constexpr size_t WS_XB0 = 196 * MiB;
constexpr size_t WS_XFA = 260 * MiB;
constexpr size_t WS_XFB = 388 * MiB;
constexpr size_t WS_WQKV = 516 * MiB;
constexpr size_t WS_WO = 588 * MiB;
constexpr size_t WS_W13 = 596 * MiB;
constexpr size_t WS_W2 = 640 * MiB;
constexpr size_t WS_QKV = 662 * MiB;
constexpr size_t WS_OG = 1238 * MiB;
constexpr size_t WS_ATT = 1430 * MiB;
constexpr size_t WS_MW13 = 662 * MiB;
constexpr size_t WS_MW2 = 1014 * MiB;
constexpr size_t WS_H = 1238 * MiB;
constexpr size_t WS_XB1 = 1430 * MiB;
constexpr size_t WS_U = 1190 * MiB;
constexpr size_t WS_MIX = 1254 * MiB;
constexpr size_t WS_HM = 1190 * MiB;
constexpr size_t WS_XG = 516 * MiB;
constexpr size_t WS_END = 1564 * MiB;
static_assert(WS_MW2 + (size_t)NE * D * FF * 2 <= WS_U && WS_HM + (size_t)MOE_ROWS * FF * 2 <= WS_END && WS_XG + (size_t)MOE_ROWS * D * 2 <= WS_QKV, "ws map");

constexpr int CW_CNT = 64;
constexpr int CW_BAR = 4096;

constexpr int RING_BYTES = 131072;
constexpr int LDSCTL_OFF = RING_BYTES, MISC_OFF = LDSCTL_OFF + 320;
constexpr int LDS_BYTES = 147456;

#define VM_WAIT() asm volatile("s_waitcnt vmcnt(0)" ::: "memory")
__device__ __forceinline__ unsigned cvt_pk_bf16(float lo, float hi) { unsigned r; asm volatile("v_cvt_pk_bf16_f32 %0, %1, %2" : "=v"(r) : "v"(lo), "v"(hi)); return r; }
__device__ __forceinline__ float bf_lo(unsigned w) { return __uint_as_float(w << 16); }
__device__ __forceinline__ float bf_hi(unsigned w) { return __uint_as_float(w & 0xffff0000u); }
__device__ __forceinline__ float wave_sum(float v) {
#pragma unroll
    for (int o = 1; o < 64; o <<= 1) v += __shfl_xor(v, o);
    return v;
}

namespace pg8 {
#define PG8_LAS __attribute__((address_space(3)))
typedef unsigned short bf16_t;
constexpr int BM = 256, BK = 64, HALF = 128, HTB = HALF * BK * 2, STAGE_BYTES = 8 * HTB, NXCD = 8, WGM = 8;

__host__ __device__ __forceinline__ int lds_byte(int r, int c) { const int st = (r >> 4) * 2 + (c >> 5), rr = r & 15, cc = c & 31, ob = rr * 64 + cc * 2; return st * 1024 + (ob ^ (((ob >> 9) & 1) << 5)); }
__host__ __device__ __forceinline__ void stage_rc(int b, int& R, int& C) { const int st = b / 1024, sb = b % 1024, swz = sb ^ (((sb >> 9) & 1) << 5); R = (st >> 1) * 16 + swz / 64; C = (st & 1) * 32 + (swz % 64) / 2; }
__host__ __device__ __forceinline__ int perm32(int rho) { const int n = rho >> 4, i = rho & 15; return 8 * (i >> 2) + 4 * n + (i & 3); }

struct Unit { int pm, pn, e; };
struct Gemm { const bf16_t* A; const bf16_t* Bt; int K, lda, ldb; };

__device__ __forceinline__ void tile_of(int wgid, int nM, int nN, int& pm, int& pn) {
    const int nwg = nM * nN;
    { const int q = nwg / NXCD, r = nwg % NXCD, xcd = wgid % NXCD, off = wgid / NXCD; wgid = (xcd < r ? xcd * (q + 1) : r * (q + 1) + (xcd - r) * q) + off; }
    const int nig = WGM * nN, gid = wgid / nig, fm = gid * WGM, gsz = (nM - fm) < WGM ? (nM - fm) : WGM;
    pm = fm + ((wgid % nig) % gsz); pn = (wgid % nig) / gsz;
}
struct StaticOrder {
    int nM, nN, nwg, G, c;
    __device__ __forceinline__ void init(int M, int N, int G_, int c_) { nM = M / BM; nN = N / BM; nwg = nM * nN; G = G_; c = c_; }
    __device__ __forceinline__ bool next(int i, Unit& u) const {
        const long L = (long)i * G + c; if (L >= nwg) return false;
        tile_of((int)L, nM, nN, u.pm, u.pn); u.e = 0; return true;
    }
    __device__ __forceinline__ const char* a_ptr(const Gemm& g, const Unit& u) const { return (const char*)g.A + (size_t)u.pm * BM * g.lda * 2; }
    __device__ __forceinline__ const char* b_ptr(const Gemm& g, const Unit& u) const { return (const char*)g.Bt + (size_t)u.pn * BM * g.ldb * 2; }
};
struct BatchOrder {
    int nM, nN, nwg, nb, G, c; size_t sA, sB;
    __device__ __forceinline__ void init(int M, int N, int nb_, size_t sA_, size_t sB_, int G_, int c_) { nM = M / BM; nN = N / BM; nwg = nM * nN; nb = nb_; sA = sA_; sB = sB_; G = G_; c = c_; }
    __device__ __forceinline__ bool next(int i, Unit& u) const {
        const long L = (long)i * G + c; if (L >= (long)nwg * nb) return false;
        u.e = (int)(L / nwg); tile_of((int)(L % nwg), nM, nN, u.pm, u.pn); return true;
    }
    __device__ __forceinline__ const char* a_ptr(const Gemm& g, const Unit& u) const { return (const char*)(g.A + (size_t)u.e * sA) + (size_t)u.pm * BM * g.lda * 2; }
    __device__ __forceinline__ const char* b_ptr(const Gemm& g, const Unit& u) const { return (const char*)(g.Bt + (size_t)u.e * sB) + (size_t)u.pn * BM * g.ldb * 2; }
};
struct MoeOrder {
    int nM, nN, nwg, G, c; size_t sB; int tb[9];
    __device__ __forceinline__ bool next(int i, Unit& u) const {
        const long L = (long)i * G + c; if (L >= nwg) return false;
        tile_of((int)L, nM, nN, u.pm, u.pn);
        int e = 0;
#pragma unroll
        for (int j = 1; j < 8; ++j) e += (u.pm >= tb[j]) ? 1 : 0;
        u.e = e; return true;
    }
    __device__ __forceinline__ const char* a_ptr(const Gemm& g, const Unit& u) const { return (const char*)g.A + (size_t)u.pm * BM * g.lda * 2; }
    __device__ __forceinline__ const char* b_ptr(const Gemm& g, const Unit& u) const { return (const char*)(g.Bt + (size_t)u.e * sB) + (size_t)u.pn * BM * g.ldb * 2; }
};


struct EpiBf16 {
    static constexpr bool PERM = true;
    bf16_t* O; int ldc; size_t estride; int ecol;
    __device__ __forceinline__ void operator()(const f32x4 (&acc)[2][2][4][2], const Unit& u, int wr, int wc, int fr, int fq) const {
        const int row0 = u.pm * BM + wr * 64 + fr; const int col0 = u.pn * BM + wc * 32 + 8 * fq + u.e * ecol;
        bf16_t* base = O + (size_t)u.e * estride;
#pragma unroll
        for (int ai = 0; ai < 2; ++ai)
#pragma unroll
            for (int m = 0; m < 4; ++m) { bf16_t* rowp = base + (size_t)(row0 + ai * HALF + m * 16) * ldc + col0;
#pragma unroll
                for (int bj = 0; bj < 2; ++bj) { const f32x4 v0 = acc[ai][bj][m][0], v1 = acc[ai][bj][m][1];
                    u32x4 w; w.x = cvt_pk_bf16(v0[0], v0[1]); w.y = cvt_pk_bf16(v0[2], v0[3]); w.z = cvt_pk_bf16(v1[0], v1[1]); w.w = cvt_pk_bf16(v1[2], v1[3]);
                    *(u32x4*)(rowp + bj * HALF) = w; } }
    }
};
struct EpiQKV {
    static constexpr bool PERM = true;
    bf16_t* O; const float* rope;
    __device__ __forceinline__ void operator()(const f32x4 (&acc)[2][2][4][2], const Unit& u, int wr, int wc, int fr, int fq) const {
        const int gt = u.pn >> 3, t = gt % 3, head = 2 * (u.pn & 7) + (wc >> 1), idx0 = 32 * (wc & 1) + 8 * fq;
        const int row0 = u.pm * BM + wr * 64 + fr; const int col0 = gt * 2048 + head * 128 + idx0;
#pragma unroll
        for (int ai = 0; ai < 2; ++ai)
#pragma unroll
            for (int m = 0; m < 4; ++m) { const int row = row0 + ai * HALF + m * 16; bf16_t* rowp = O + (size_t)row * NQKV + col0;
                f32x4 l0 = acc[ai][0][m][0], l1 = acc[ai][0][m][1], h0 = acc[ai][1][m][0], h1 = acc[ai][1][m][1];
                if (t < 2) { const float* cp = rope + (size_t)(row & (SEQ - 1)) * 64 + idx0; const float* sp = cp + SEQ * 64;
                    const f32x4 c0 = *(const f32x4*)cp, c1 = *(const f32x4*)(cp + 4), s0 = *(const f32x4*)sp, s1 = *(const f32x4*)(sp + 4);
                    const f32x4 a0 = l0 * c0 - h0 * s0, a1 = l1 * c1 - h1 * s1, b0 = h0 * c0 + l0 * s0, b1 = h1 * c1 + l1 * s1;
                    l0 = a0; l1 = a1; h0 = b0; h1 = b1; }
                u32x4 w; w.x = cvt_pk_bf16(l0[0], l0[1]); w.y = cvt_pk_bf16(l0[2], l0[3]); w.z = cvt_pk_bf16(l1[0], l1[1]); w.w = cvt_pk_bf16(l1[2], l1[3]);
                *(u32x4*)rowp = w;
                w.x = cvt_pk_bf16(h0[0], h0[1]); w.y = cvt_pk_bf16(h0[2], h0[3]); w.z = cvt_pk_bf16(h1[0], h1[1]); w.w = cvt_pk_bf16(h1[2], h1[3]);
                *(u32x4*)(rowp + 64) = w; }
    }
};
struct EpiSwiGLU {
    static constexpr bool PERM = true;
    bf16_t* O; int ldc;
    __device__ __forceinline__ void operator()(const f32x4 (&acc)[2][2][4][2], const Unit& u, int wr, int wc, int fr, int fq) const {
        const int row0 = u.pm * BM + wr * 64 + fr; const int col0 = u.pn * HALF + wc * 32 + 8 * fq;
#pragma unroll
        for (int ai = 0; ai < 2; ++ai)
#pragma unroll
            for (int m = 0; m < 4; ++m) { bf16_t* rowp = O + (size_t)(row0 + ai * HALF + m * 16) * ldc + col0;
                float r[8];
#pragma unroll
                for (int n = 0; n < 2; ++n)
#pragma unroll
                    for (int j = 0; j < 4; ++j) { const float a = acc[ai][0][m][n][j], b = acc[ai][1][m][n][j];
                        const float sg = __builtin_amdgcn_rcpf(1.0f + __builtin_amdgcn_exp2f(-1.4426950408889634f * a)); r[n * 4 + j] = a * sg * b; }
                u32x4 w; w.x = cvt_pk_bf16(r[0], r[1]); w.y = cvt_pk_bf16(r[2], r[3]); w.z = cvt_pk_bf16(r[4], r[5]); w.w = cvt_pk_bf16(r[6], r[7]);
                *(u32x4*)rowp = w; }
    }
};
struct EpiRes {
    static constexpr bool PERM = false;
    const float* res; float* Y; int ldc; float alpha;
    __device__ __forceinline__ void operator()(const f32x4 (&acc)[2][2][4][2], const Unit& u, int wr, int wc, int fr, int fq) const {
        const int row0 = u.pm * BM + wr * 64 + fr, col0 = u.pn * BM + wc * 32 + 4 * fq;
#pragma unroll
        for (int ai = 0; ai < 2; ++ai)
#pragma unroll
            for (int m = 0; m < 4; ++m) { const size_t off = (size_t)(row0 + ai * HALF + m * 16) * ldc + col0;
#pragma unroll
                for (int bj = 0; bj < 2; ++bj)
#pragma unroll
                    for (int n = 0; n < 2; ++n) { const f32x4 r = *(const f32x4*)(res + off + bj * HALF + n * 16);
                        *(f32x4*)(Y + off + bj * HALF + n * 16) = r * alpha + acc[ai][bj][m][n]; }
                asm volatile("" ::: "memory"); }
    }
};
struct EpiPle {
    static constexpr bool PERM = false;
    const float* x; const bf16_t* pp; const float* bias; float* outF; bf16_t* outB; int ldc;
    __device__ __forceinline__ void operator()(const f32x4 (&acc)[2][2][4][2], const Unit& u, int wr, int wc, int fr, int fq) const {
        const int row0 = u.pm * BM + wr * 64 + fr, col0 = u.pn * BM + wc * 32 + 4 * fq;
        f32x4 bv[2][2];
#pragma unroll
        for (int bj = 0; bj < 2; ++bj)
#pragma unroll
            for (int n = 0; n < 2; ++n) bv[bj][n] = *(const f32x4*)(bias + col0 + bj * HALF + n * 16);
#pragma unroll
        for (int ai = 0; ai < 2; ++ai)
#pragma unroll
            for (int m = 0; m < 4; ++m) { const size_t off = (size_t)(row0 + ai * HALF + m * 16) * ldc + col0;
#pragma unroll
                for (int bj = 0; bj < 2; ++bj)
#pragma unroll
                    for (int n = 0; n < 2; ++n) { const size_t o2 = off + bj * HALF + n * 16;
                        const f32x4 xv = *(const f32x4*)(x + o2); const u32x2 pw = *(const u32x2*)(pp + o2);
                        const f32x4 v = acc[ai][bj][m][n] + bv[bj][n]; f32x4 o;
                        const float p0 = bf_lo(pw.x), p1 = bf_hi(pw.x), p2 = bf_lo(pw.y), p3 = bf_hi(pw.y);
                        o[0] = xv[0] + p0 * __builtin_amdgcn_rcpf(1.0f + __builtin_amdgcn_exp2f(-1.4426950408889634f * v[0]));
                        o[1] = xv[1] + p1 * __builtin_amdgcn_rcpf(1.0f + __builtin_amdgcn_exp2f(-1.4426950408889634f * v[1]));
                        o[2] = xv[2] + p2 * __builtin_amdgcn_rcpf(1.0f + __builtin_amdgcn_exp2f(-1.4426950408889634f * v[2]));
                        o[3] = xv[3] + p3 * __builtin_amdgcn_rcpf(1.0f + __builtin_amdgcn_exp2f(-1.4426950408889634f * v[3]));
                        *(f32x4*)(outF + o2) = o;
                        if (outB) { u32x2 w; w.x = cvt_pk_bf16(o[0], o[1]); w.y = cvt_pk_bf16(o[2], o[3]); *(u32x2*)(outB + o2) = w; } }
                asm volatile("" ::: "memory"); }
    }
};

template <class Epi, class Sched, bool ALIGN_EPI = true, bool SP2 = true>
__device__ __forceinline__ void gemm_phase(PG8_LAS unsigned char* lds, const Gemm g, const Sched& S, const Epi& E) {
    const int tid = threadIdx.x, wid = __builtin_amdgcn_readfirstlane(tid >> 6), lane = tid & 63, wr = wid >> 2, wc = wid & 3, fr = lane & 15, fq = lane >> 4;
    const int K = g.K, nt = K / BK;
    unsigned voffA[2], voffB[2];
#pragma unroll
    for (int i = 0; i < 2; ++i) { int R, C; stage_rc(tid * 16 + i * 8192, R, C); const int Rb = Epi::PERM ? ((R & ~31) + perm32(R & 31)) : R;
        voffA[i] = (unsigned)(R * g.lda + C) * 2u; voffB[i] = (unsigned)(Rb * g.ldb + C) * 2u; }
    const size_t kstep = (size_t)(BK * 2);
    const size_t hstepA = (size_t)HALF * g.lda * 2, hstepB = (size_t)HALF * g.ldb * 2;
    const unsigned ldsw = (unsigned)wid * 1024u;
    const int aoff = lds_byte(wr * 64 + fr, fq * 8), boff = lds_byte(wc * 32 + fr, fq * 8);
#define PG8_SA(b, h) (((b) * 2 + (h)) * HTB)
#define PG8_SB(b, h) ((4 + (b) * 2 + (h)) * HTB)
#define PG8_STAGE(bufoff, gbase, voff) do { _Pragma("unroll") for (int _i = 0; _i < 2; ++_i) \
        __builtin_amdgcn_global_load_lds((const unsigned*)((const char*)(gbase) + (voff)[_i]), (PG8_LAS unsigned*)(lds + (bufoff) + ldsw + _i * 8192), 16, 0, 0); } while (0)
#define PG8_LDA(dst, b, h) do { _Pragma("unroll") for (int m = 0; m < 4; ++m) _Pragma("unroll") for (int k = 0; k < 2; ++k) dst[m][k] = *(const PG8_LAS bf16x8*)(lds + PG8_SA(b, h) + aoff + m * 2048 + k * 1024); } while (0)
#define PG8_LDB(dst, b, h) do { _Pragma("unroll") for (int n = 0; n < 2; ++n) _Pragma("unroll") for (int k = 0; k < 2; ++k) dst[n][k] = *(const PG8_LAS bf16x8*)(lds + PG8_SB(b, h) + boff + n * 2048 + k * 1024); } while (0)
#define PG8_MMA(ai, bj, At, Bt) do { __builtin_amdgcn_s_setprio(1); _Pragma("unroll") for (int m = 0; m < 4; ++m) _Pragma("unroll") for (int n = 0; n < 2; ++n) _Pragma("unroll") for (int k = 0; k < 2; ++k) \
        acc[ai][bj][m][n] = __builtin_amdgcn_mfma_f32_16x16x32_bf16(Bt[n][k], At[m][k], acc[ai][bj][m][n], 0, 0, 0); __builtin_amdgcn_s_setprio(0); } while (0)
#define PG8_WAIT_V(n) asm volatile("s_waitcnt vmcnt(" #n ")" ::: "memory")
#define PG8_WAIT_L(n) asm volatile("s_waitcnt lgkmcnt(" #n ")" ::: "memory")
#define PG8_BAR __builtin_amdgcn_s_barrier()
#define PG8_SCHED __builtin_amdgcn_sched_barrier(0)
    Unit cur, nxt; int ui = 0;
    if (!S.next(0, cur)) return;
    f32x4 acc[2][2][4][2];
#pragma unroll
    for (int a = 0; a < 2; ++a)
#pragma unroll
        for (int b = 0; b < 2; ++b)
#pragma unroll
            for (int m = 0; m < 4; ++m)
#pragma unroll
                for (int n = 0; n < 2; ++n) acc[a][b][m][n] = (f32x4){0.f, 0.f, 0.f, 0.f};
    bf16x8 At[4][2], B0[2][2], B1[2][2];
    const char* cA = S.a_ptr(g, cur); const char* cB = S.b_ptr(g, cur);
    if constexpr (SP2) {
        PG8_STAGE(PG8_SB(0, 0), cB, voffB); PG8_STAGE(PG8_SB(0, 1), cB + hstepB, voffB); PG8_STAGE(PG8_SA(0, 0), cA, voffA); PG8_STAGE(PG8_SA(0, 1), cA + hstepA, voffA);
        if (wr == 1) PG8_BAR;
        PG8_WAIT_V(2); PG8_BAR;
        PG8_STAGE(PG8_SB(1, 0), cB + kstep, voffB); PG8_STAGE(PG8_SA(1, 0), cA + kstep, voffA); PG8_STAGE(PG8_SB(1, 1), cB + hstepB + kstep, voffB);
        PG8_WAIT_V(6); PG8_BAR;
    } else {
        PG8_STAGE(PG8_SB(0, 0), cB, voffB); PG8_STAGE(PG8_SA(0, 0), cA, voffA); PG8_STAGE(PG8_SB(0, 1), cB + hstepB, voffB); PG8_STAGE(PG8_SA(0, 1), cA + hstepA, voffA);
        if (wr == 1) PG8_BAR;
        PG8_WAIT_V(4); PG8_BAR;
        PG8_STAGE(PG8_SB(1, 0), cB + kstep, voffB); PG8_STAGE(PG8_SA(1, 0), cA + kstep, voffA); PG8_STAGE(PG8_SB(1, 1), cB + hstepB + kstep, voffB);
        PG8_WAIT_V(6); PG8_BAR;
    }
    for (;;) {
        const bool has_next = S.next(ui + 1, nxt);
        const char* nA = has_next ? S.a_ptr(g, nxt) : cA; const char* nB = has_next ? S.b_ptr(g, nxt) : cB;
        for (int t = 0; t < nt; t += 2) {
            const bool last = (t == nt - 2);
            const char* a1 = cA + (size_t)(t + 1) * kstep;
            const char* a2 = last ? nA : cA + (size_t)(t + 2) * kstep; const char* b2 = last ? nB : cB + (size_t)(t + 2) * kstep;
            const char* a3 = a2 + kstep; const char* b3 = b2 + kstep;
            if constexpr (SP2) {
            PG8_LDB(B0, 0, 0); PG8_LDB(B1, 0, 1); PG8_SCHED; PG8_LDA(At, 0, 0); PG8_STAGE(PG8_SA(1, 1), a1 + hstepA, voffA);
            PG8_WAIT_V(8); PG8_WAIT_L(0); PG8_BAR; PG8_MMA(0, 0, At, B0); PG8_MMA(0, 1, At, B1); PG8_BAR; PG8_SCHED;
            PG8_LDA(At, 0, 1); PG8_STAGE(PG8_SB(0, 0), b2, voffB); PG8_STAGE(PG8_SB(0, 1), b2 + hstepB, voffB); PG8_STAGE(PG8_SA(0, 0), a2, voffA);
            PG8_WAIT_V(8); PG8_WAIT_L(0); PG8_BAR; PG8_MMA(1, 0, At, B0); PG8_MMA(1, 1, At, B1); PG8_BAR; PG8_SCHED;
            PG8_LDB(B0, 1, 0); PG8_LDB(B1, 1, 1); PG8_SCHED; PG8_LDA(At, 1, 0); PG8_STAGE(PG8_SA(0, 1), a2 + hstepA, voffA);
            PG8_WAIT_V(8); PG8_WAIT_L(0); PG8_BAR; PG8_MMA(0, 0, At, B0); PG8_MMA(0, 1, At, B1); PG8_BAR; PG8_SCHED;
            PG8_LDA(At, 1, 1); PG8_STAGE(PG8_SB(1, 0), b3, voffB); PG8_STAGE(PG8_SB(1, 1), b3 + hstepB, voffB); PG8_STAGE(PG8_SA(1, 0), a3, voffA);
            PG8_WAIT_V(8); PG8_WAIT_L(0); PG8_BAR; PG8_MMA(1, 0, At, B0); PG8_MMA(1, 1, At, B1); PG8_BAR; PG8_SCHED;
            } else {
            PG8_LDB(B0, 0, 0); PG8_SCHED; PG8_LDA(At, 0, 0); PG8_STAGE(PG8_SA(1, 1), a1 + hstepA, voffA);
            PG8_WAIT_L(8); PG8_BAR; PG8_WAIT_L(0); PG8_MMA(0, 0, At, B0); PG8_BAR; PG8_SCHED;
            PG8_LDB(B1, 0, 1); PG8_STAGE(PG8_SB(0, 0), b2, voffB);
            PG8_BAR; PG8_WAIT_L(0); PG8_MMA(0, 1, At, B1); PG8_BAR;
            PG8_LDA(At, 0, 1); PG8_STAGE(PG8_SA(0, 0), a2, voffA);
            PG8_BAR; PG8_WAIT_L(0); PG8_MMA(1, 0, At, B0); PG8_BAR; PG8_SCHED;
            PG8_STAGE(PG8_SB(0, 1), b2 + hstepB, voffB);
            PG8_WAIT_V(6); PG8_BAR; PG8_MMA(1, 1, At, B1); PG8_BAR;
            PG8_LDB(B0, 1, 0); PG8_SCHED; PG8_LDA(At, 1, 0); PG8_STAGE(PG8_SA(0, 1), a2 + hstepA, voffA);
            PG8_WAIT_L(8); PG8_BAR; PG8_WAIT_L(0); PG8_MMA(0, 0, At, B0); PG8_BAR; PG8_SCHED;
            PG8_LDB(B1, 1, 1); PG8_STAGE(PG8_SB(1, 0), b3, voffB);
            PG8_BAR; PG8_WAIT_L(0); PG8_MMA(0, 1, At, B1); PG8_BAR;
            PG8_LDA(At, 1, 1); PG8_STAGE(PG8_SA(1, 0), a3, voffA);
            PG8_BAR; PG8_WAIT_L(0); PG8_MMA(1, 0, At, B0); PG8_BAR; PG8_SCHED;
            PG8_STAGE(PG8_SB(1, 1), b3 + hstepB, voffB);
            PG8_WAIT_V(6); PG8_BAR; PG8_MMA(1, 1, At, B1); PG8_BAR;
            }
        }
        if constexpr (ALIGN_EPI) { if (wr == 0) PG8_BAR; }
        E(acc, cur, wr, wc, fr, fq);
        if (!has_next) break;
#pragma unroll
        for (int a = 0; a < 2; ++a)
#pragma unroll
            for (int b = 0; b < 2; ++b)
#pragma unroll
                for (int m = 0; m < 4; ++m)
#pragma unroll
                    for (int n = 0; n < 2; ++n) acc[a][b][m][n] = (f32x4){0.f, 0.f, 0.f, 0.f};
        cur = nxt; cA = nA; cB = nB; ++ui;
        if constexpr (ALIGN_EPI) { if (wr == 1) PG8_BAR; }
    }
    PG8_WAIT_V(0);
    if constexpr (!ALIGN_EPI) { if (wr == 0) PG8_BAR; }
    PG8_BAR;
#undef PG8_SA
#undef PG8_SB
#undef PG8_STAGE
#undef PG8_LDA
#undef PG8_LDB
#undef PG8_MMA
#undef PG8_WAIT_V
#undef PG8_WAIT_L
#undef PG8_BAR
#undef PG8_SCHED
}
}

#define XB_TMO      128
#define XB_XCNT(j)  (256  + 64 * (j))
#define XB_XSUB(j)  (1280 + 64 * (j))
#define XB_XGEN(j)  (2304 + 64 * (j))
#define XB_TOP      3328
#define XB_TOPGEN   3392
#define XCD_BAR_WORDS 3456
#define XB_SPIN_CAP (1u << 18)

__device__ __forceinline__ unsigned xb_ld(unsigned* p)              { return __hip_atomic_load(p, __ATOMIC_RELAXED, __HIP_MEMORY_SCOPE_AGENT); }
__device__ __forceinline__ unsigned xb_add(unsigned* p, unsigned v) { return __hip_atomic_fetch_add(p, v, __ATOMIC_RELAXED, __HIP_MEMORY_SCOPE_AGENT); }
__device__ __forceinline__ unsigned xb_xcc_id() { return (unsigned)__builtin_amdgcn_s_getreg((3 << 11) | 20) & 0xFu; }
#define XB_SPIN(cond, bar) do { unsigned _sp = 0; while (cond) { __builtin_amdgcn_s_sleep(1); \
    if ((++_sp & 255u) == 0u) { if (xb_ld(&(bar)[XB_TMO])) break; if (_sp > XB_SPIN_CAP) { atomicAdd(&(bar)[XB_TMO], 1u); break; } } } } while (0)

struct XcdBarrier { unsigned* bar; unsigned x; volatile LAS unsigned* st; };

__device__ __forceinline__ XcdBarrier xcd_barrier_post(unsigned* bar, volatile LAS unsigned* st) {
    XcdBarrier b; b.bar = bar; b.x = xb_xcc_id(); b.st = st;
    if (threadIdx.x == 0) (void)xb_add(&bar[XB_XCNT(b.x)], 1u);
    return b;
}
__device__ __forceinline__ void xcd_barrier_complete(unsigned* bar, unsigned x, unsigned& nloc, unsigned& nx) {
    const unsigned G = gridDim.x * gridDim.y * gridDim.z;
    unsigned sum, cnt, mine, sp = 0u;
    for (;;) {
        sum = 0u; cnt = 0u; mine = 0u;
#pragma unroll
        for (unsigned j = 0; j < 16; ++j) { const unsigned c = xb_ld(&bar[XB_XCNT(j)]); sum += c; cnt += (c > 0u) ? 1u : 0u; mine = (j == x) ? c : mine; }
        if (sum == G) break;
        __builtin_amdgcn_s_sleep(1);
        if ((++sp & 255u) == 0u) { if (xb_ld(&bar[XB_TMO])) break; if (sp > XB_SPIN_CAP) { atomicAdd(&bar[XB_TMO], 1u); break; } }
    }
    nloc = mine > 0u ? mine : 1u; nx = cnt > 0u ? cnt : 1u;
}
__device__ __forceinline__ void xcd_barrier(const XcdBarrier& b) {
    asm volatile("s_waitcnt vmcnt(0)" ::: "memory");
    __syncthreads();
    if (threadIdx.x == 0) {
        unsigned* bar = b.bar;
        __builtin_amdgcn_s_waitcnt(0);
        unsigned nloc = b.st[0], nx = b.st[1];
        if (nloc == 0u) { xcd_barrier_complete(bar, b.x, nloc, nx); b.st[0] = nloc; b.st[1] = nx; }
        const unsigned old = xb_add(&bar[XB_XSUB(b.x)], 1u);
        const unsigned gen = old / nloc;
        if (old + 1u == (gen + 1u) * nloc) {
            __builtin_amdgcn_fence(__ATOMIC_RELEASE, "agent");
            asm volatile("s_waitcnt vmcnt(0)" ::: "memory");
            const unsigned og = xb_add(&bar[XB_TOP], 1u);
            const unsigned tg = og / nx;
            if (og + 1u == (tg + 1u) * nx) xb_add(&bar[XB_TOPGEN], 1u);
            else XB_SPIN(xb_ld(&bar[XB_TOPGEN]) == tg, bar);
            __builtin_amdgcn_fence(__ATOMIC_ACQUIRE, "agent");
            xb_add(&bar[XB_XGEN(b.x)], 1u);
            asm volatile("s_waitcnt vmcnt(0)" ::: "memory");
        } else {
            XB_SPIN(xb_ld(&bar[XB_XGEN(b.x)]) == gen, bar);
            __builtin_amdgcn_fence(__ATOMIC_ACQUIRE, "agent");
            asm volatile("s_waitcnt vmcnt(0)" ::: "memory");
        }
    }
    __syncthreads();
}

struct Frame {
    LAS unsigned char* lds;
    int tid, lane, wave, vcu, G;
    unsigned char* ws;
};
struct Args { const float* in[22]; float* out; unsigned char* ws; int ph_lo, ph_hi; };

__device__ __forceinline__ void cvt_tile(const float* W, size_t ldw, int k0, int n0, bf16* WT, size_t ldt, int dst_row0, int lane) {
    const int kb = lane >> 3, nb = lane & 7;
    const float* src = W + (size_t)(k0 + 8 * kb) * ldw + n0 + 4 * nb;
    f32x4 v[8];
#pragma unroll
    for (int j = 0; j < 8; ++j) v[j] = *(const f32x4*)(src + (size_t)j * ldw);
#pragma unroll
    for (int jn = 0; jn < 4; ++jn) { u32x4 o; o.x = cvt_pk_bf16(v[0][jn], v[1][jn]); o.y = cvt_pk_bf16(v[2][jn], v[3][jn]); o.z = cvt_pk_bf16(v[4][jn], v[5][jn]); o.w = cvt_pk_bf16(v[6][jn], v[7][jn]);
        *(u32x4*)(WT + (size_t)(dst_row0 + 4 * nb + jn) * ldt + k0 + 8 * kb) = o; }
}
struct MapId { __device__ __forceinline__ int operator()(int n) const { return n; } };
struct MapQKV { __device__ __forceinline__ int operator()(int n) const { const int gt = n >> 11, head = (n >> 7) & 15, d = n & 127; return (gt * 8 + (head >> 1)) * 256 + 128 * (d >> 6) + 64 * (head & 1) + (d & 63); } };
struct MapGU { int which; __device__ __forceinline__ int operator()(int n) const { return 256 * (n >> 7) + 128 * which + (n & 127); } };
template <class Map> __device__ __forceinline__ void cvt_matrix(const float* W, int K, int N, bf16* WT, size_t ldt, Map map, int& it0, int gw, int NGW, int lane) {
    const int nblk = N / 32, items = (K / 64) * nblk;
    int it = gw - it0; if (it < 0) it += ((-it + NGW - 1) / NGW) * NGW;
    for (; it < items; it += NGW) { const int kb = it / nblk, nb = it - kb * nblk; cvt_tile(W, (size_t)N, 64 * kb, 32 * nb, WT, ldt, map(32 * nb), lane); }
    it0 = (it0 + items) % NGW;
}
__device__ __forceinline__ void cvt_flat(const float* s, bf16* d, size_t n, int gw, int NGW, int lane) {
    for (size_t i = ((size_t)gw * 64 + lane) * 8; i < n; i += (size_t)NGW * 64 * 8) { const f32x4 a = *(const f32x4*)(s + i), b = *(const f32x4*)(s + i + 4);
        u32x4 o; o.x = cvt_pk_bf16(a[0], a[1]); o.y = cvt_pk_bf16(a[2], a[3]); o.z = cvt_pk_bf16(b[0], b[1]); o.w = cvt_pk_bf16(b[2], b[3]); *(u32x4*)(d + i) = o; }
}

__device__ __forceinline__ void p0_prologue(Frame& F, const Args& a) {
    const int gw = F.vcu * 8 + F.wave, NGW = F.G * 8, lane = F.lane; unsigned char* ws = F.ws; int it0 = 0;
    cvt_matrix(a.in[2], D, NQKV, (bf16*)(ws + WS_WQKV), D, MapQKV{}, it0, gw, NGW, lane);
    cvt_matrix(a.in[3], D, D, (bf16*)(ws + WS_WO), D, MapId{}, it0, gw, NGW, lane);
    cvt_matrix(a.in[12], D, FF, (bf16*)(ws + WS_W13), D, MapGU{0}, it0, gw, NGW, lane);
    cvt_matrix(a.in[13], D, FF, (bf16*)(ws + WS_W13), D, MapGU{1}, it0, gw, NGW, lane);
    cvt_matrix(a.in[14], FF, D, (bf16*)(ws + WS_W2), FF, MapId{}, it0, gw, NGW, lane);
    cvt_matrix(a.in[20], D, D, (bf16*)(ws + WS_WGATE), D, MapId{}, it0, gw, NGW, lane);
    cvt_matrix(a.in[20] + (size_t)D * D, D, D, (bf16*)(ws + WS_WGATE) + (size_t)D * D, D, MapId{}, it0, gw, NGW, lane);
    cvt_matrix(a.in[19], PLE, D, (bf16*)(ws + WS_WPROJ), PLE, MapId{}, it0, gw, NGW, lane);
    cvt_matrix(a.in[19] + (size_t)PLE * D, PLE, D, (bf16*)(ws + WS_WPROJ) + (size_t)D * PLE, PLE, MapId{}, it0, gw, NGW, lane);
    cvt_matrix(a.in[4], D, D, (bf16*)(ws + WS_WIN), D, MapId{}, it0, gw, NGW, lane);
    cvt_matrix(a.in[7], D, D, (bf16*)(ws + WS_WO2), D, MapId{}, it0, gw, NGW, lane);
    { const float* wg = a.in[5]; const float* sc = a.in[6]; bf16* o = (bf16*)(ws + WS_WGS);
      for (size_t i = ((size_t)gw * 64 + lane) * 8; i < (size_t)4 * 512 * 512; i += (size_t)NGW * 64 * 8) { const int g = (int)(i >> 18), d = (int)(i & 511);
          const f32x4 x0 = *(const f32x4*)(wg + i), x1 = *(const f32x4*)(wg + i + 4), s0 = *(const f32x4*)(sc + g * 512 + d), s1 = *(const f32x4*)(sc + g * 512 + d + 4);
          const f32x4 y0 = x0 * s0, y1 = x1 * s1; u32x4 w; w.x = cvt_pk_bf16(y0[0], y0[1]); w.y = cvt_pk_bf16(y0[2], y0[3]); w.z = cvt_pk_bf16(y1[0], y1[1]); w.w = cvt_pk_bf16(y1[2], y1[3]); *(u32x4*)(o + i) = w; } }
    cvt_flat(a.in[0], (bf16*)(ws + WS_XB0), (size_t)MTOK * D, gw, NGW, lane);
    cvt_flat(a.in[1], (bf16*)(ws + WS_PB), (size_t)2 * MTOK * PLE, gw, NGW, lane);
    { float* ct = (float*)(ws + WS_ROPE); float* st = ct + SEQ * 64;
      for (int i = gw * 64 + lane; i < SEQ * 64; i += NGW * 64) { const int pos = i >> 6, j = i & 63;
          const double inv = exp2(-(double)j * (13.287712379549449 / 64.0));
          const double ang = (double)pos * inv; ct[i] = (float)cos(ang); st[i] = (float)sin(ang); } }
}

__device__ __forceinline__ void attn_phase(Frame& F) {
    const bf16* QKV = (const bf16*)(F.ws + WS_QKV); bf16* OG = (bf16*)(F.ws + WS_OG); float* LSE = (float*)(F.ws + WS_LSE);
    LAS unsigned char* Kl = F.lds; LAS unsigned char* Vl = F.lds + 65536;
    const int w = F.wave, lane = F.lane, q16 = lane & 15, g4 = lane >> 4, sw = ((g4 & 1) << 1) | (g4 >> 1);
    const int pi16 = (q16 & 3) | ((q16 & 4) << 1) | ((q16 & 8) >> 1);
    constexpr int UPW = 6144 / 256;
    const int total = 6144; const int per = (total + F.G - 1) / F.G;
    for (int k = 0; k < per; ++k) {
        const int idx = F.vcu * per + k; if (idx >= total) break;
        const int g = idx >> 11, rem = idx & 2047; const int dsh = 2 * g, dil = 1 << dsh, nbsh = 5 - dsh, nb = 1 << nbsh;
        const int n = rem & (nb - 1), rem2 = rem >> nbsh, r = rem2 & (dil - 1), bh = rem2 >> dsh, b = bh >> 4, h = bh & 15;
        const size_t tok0 = (size_t)b * SEQ + r;
        const int colQ = (g * 3 + 0) * 2048 + h * 128, colK = colQ + 2048, colV = colQ + 4096;
        __syncthreads();
#pragma unroll
        for (int i = 0; i < 8; ++i) {
            const int row = (i * 8 + w) * 4 + (lane >> 4), cs = lane & 15;
            int j = 128 * (n - 1) + row; if (n == 0 && row < 128) j += 128;
            const bf16* rp = QKV + (tok0 + (size_t)j * dil) * NQKV;
            const int ck = cs ^ (row & 7), cv = cs ^ (((row & 3) << 2) | ((row >> 2) & 3));
            __builtin_amdgcn_global_load_lds((const unsigned*)(rp + colK + ck * 8), (LAS unsigned*)(Kl + (i * 8 + w) * 1024), 16, 0, 0);
            __builtin_amdgcn_global_load_lds((const unsigned*)(rp + colV + cv * 8), (LAS unsigned*)(Vl + (i * 8 + w) * 1024), 16, 0, 0);
        }
        const size_t qtok = tok0 + (size_t)(128 * n + 16 * w + q16) * dil;
        bf16x8 bq[4];
#pragma unroll
        for (int ks = 0; ks < 4; ++ks) bq[ks] = *(const bf16x8*)(QKV + qtok * NQKV + colQ + 32 * ks + 8 * g4);
        VM_WAIT();
        __syncthreads();
        f32x4 s[9];
#pragma unroll
        for (int ti = 0; ti < 9; ++ti) {
            const int kt = w + ti; f32x4 acc = (f32x4){0.f, 0.f, 0.f, 0.f};
            if (n > 0 || kt >= 8) {
                const int row = 16 * kt + pi16;
#pragma unroll
                for (int ks = 0; ks < 4; ++ks) { const int c = 4 * ks + g4;
                    const bf16x8 av = *(const LAS bf16x8*)(Kl + row * 256 + ((c ^ (row & 7)) << 4));
                    acc = __builtin_amdgcn_mfma_f32_16x16x32_bf16(av, bq[ks], acc, 0, 0, 0); }
            }
            s[ti] = acc;
        }
        const float C2 = 0.08838834764831845f * 1.4426950408889634f; const float NEG = -__builtin_inff();
        float mx = NEG;
#pragma unroll
        for (int ti = 0; ti < 9; ++ti) {
            const bool tile_ok = (n > 0 || w + ti >= 8);
#pragma unroll
            for (int i = 0; i < 4; ++i) { const int kk = 4 * sw + i; bool ok = tile_ok;
                if (ti == 0) ok = ok && (kk >= q16);
                if (ti == 8) ok = ok && (kk <= q16);
                const float v = ok ? s[ti][i] * C2 : NEG; s[ti][i] = v; mx = fmaxf(mx, v); }
        }
        mx = fmaxf(mx, __shfl_xor(mx, 16)); mx = fmaxf(mx, __shfl_xor(mx, 32));
        float l = 0.f;
#pragma unroll
        for (int ti = 0; ti < 9; ++ti)
#pragma unroll
            for (int i = 0; i < 4; ++i) { const float p = __builtin_amdgcn_exp2f(s[ti][i] - mx); s[ti][i] = p; l += p; }
        l += __shfl_xor(l, 16); l += __shfl_xor(l, 32);
        bf16x8 pf[5];
#pragma unroll
        for (int u = 0; u < 5; ++u) { u32x4 wv; wv.x = cvt_pk_bf16(s[2 * u][0], s[2 * u][1]); wv.y = cvt_pk_bf16(s[2 * u][2], s[2 * u][3]);
            if (u < 4) { wv.z = cvt_pk_bf16(s[2 * u + 1][0], s[2 * u + 1][1]); wv.w = cvt_pk_bf16(s[2 * u + 1][2], s[2 * u + 1][3]); } else { wv.z = 0u; wv.w = 0u; }
            pf[u] = __builtin_bit_cast(bf16x8, wv); }
        const int qq = q16 >> 2, pp = q16 & 3;
        const float rl = 1.0f / l;
        const size_t orow = (size_t)g * MTOK * D + qtok * D + h * 128;
#pragma unroll
        for (int dt = 0; dt < 8; ++dt) {
            f32x4 o = (f32x4){0.f, 0.f, 0.f, 0.f};
#pragma unroll
            for (int u = 0; u < 5; ++u) {
                const int r0 = 16 * (w + 2 * u) + 4 * sw + qq, ch = 2 * dt + (pp >> 1);
                const s16x4 lo = __builtin_bit_cast(s16x4, __builtin_amdgcn_ds_read_tr16_b64_v4i16((LAS s16x4*)(Vl + 256 * r0 + 16 * (ch ^ (((r0 & 3) << 2) | ((r0 >> 2) & 3))) + 8 * (pp & 1))));
                s16x4 hi = (s16x4){0, 0, 0, 0};
                if (u < 4) { const int r1 = r0 + 16;
                    hi = __builtin_bit_cast(s16x4, __builtin_amdgcn_ds_read_tr16_b64_v4i16((LAS s16x4*)(Vl + 256 * r1 + 16 * (ch ^ (((r1 & 3) << 2) | ((r1 >> 2) & 3))) + 8 * (pp & 1)))); }
                bf16x8 av; av[0] = lo[0]; av[1] = lo[1]; av[2] = lo[2]; av[3] = lo[3]; av[4] = hi[0]; av[5] = hi[1]; av[6] = hi[2]; av[7] = hi[3];
                o = __builtin_amdgcn_mfma_f32_16x16x32_bf16(av, pf[u], o, 0, 0, 0);
            }
            o = o * rl;
            u32x2 wv; wv.x = cvt_pk_bf16(o[0], o[1]); wv.y = cvt_pk_bf16(o[2], o[3]);
            *(u32x2*)(OG + orow + 16 * dt + 4 * g4) = wv;
        }
        if (g4 == 0) LSE[((size_t)g * MTOK + qtok) * NH + h] = mx * 0.6931471805599453f + __logf(l);
    }
    (void)UPW;
    __syncthreads();
}

__device__ __forceinline__ void combine_phase(Frame& F) {
    const bf16* OG = (const bf16*)(F.ws + WS_OG); const float* LSE = (const float*)(F.ws + WS_LSE); bf16* ATT = (bf16*)(F.ws + WS_ATT);
    const int gw = F.vcu * 8 + F.wave, NGW = F.G * 8, lane = F.lane;
    for (int m = gw; m < MTOK; m += NGW) {
#pragma unroll
        for (int j = 0; j < 4; ++j) { const int c = lane + 64 * j, h = c >> 4;
            const float l0 = LSE[(size_t)m * NH + h], l1 = LSE[((size_t)MTOK + m) * NH + h], l2 = LSE[((size_t)2 * MTOK + m) * NH + h];
            const float mx = fmaxf(l0, fmaxf(l1, l2)); float w0 = __expf(l0 - mx), w1 = __expf(l1 - mx), w2 = __expf(l2 - mx); const float rs = 1.0f / (w0 + w1 + w2); w0 *= rs; w1 *= rs; w2 *= rs;
            const u32x4 a = *(const u32x4*)(OG + (size_t)m * D + c * 8), b = *(const u32x4*)(OG + ((size_t)MTOK + m) * D + c * 8), d = *(const u32x4*)(OG + ((size_t)2 * MTOK + m) * D + c * 8);
            u32x4 o;
#pragma unroll
            for (int e = 0; e < 4; ++e) { const float lo = w0 * bf_lo(a[e]) + w1 * bf_lo(b[e]) + w2 * bf_lo(d[e]), hi = w0 * bf_hi(a[e]) + w1 * bf_hi(b[e]) + w2 * bf_hi(d[e]); o[e] = cvt_pk_bf16(lo, hi); }
            *(u32x4*)(ATT + (size_t)m * D + c * 8) = o; }
    }
}
__device__ __forceinline__ void moe_convert_phase(Frame& F, const Args& a) {
    const int gw = F.vcu * 8 + F.wave, NGW = F.G * 8, lane = F.lane; int it0 = 0;
    bf16* W13 = (bf16*)(F.ws + WS_MW13); bf16* W2 = (bf16*)(F.ws + WS_MW2);
    for (int e = 0; e < NE; ++e) {
        cvt_matrix(a.in[16] + (size_t)e * D * FF, D, FF, W13 + (size_t)e * FF2 * D, D, MapGU{0}, it0, gw, NGW, lane);
        cvt_matrix(a.in[17] + (size_t)e * D * FF, D, FF, W13 + (size_t)e * FF2 * D, D, MapGU{1}, it0, gw, NGW, lane);
        cvt_matrix(a.in[18] + (size_t)e * FF * D, FF, D, W2 + (size_t)e * D * FF, FF, MapId{}, it0, gw, NGW, lane);
    }
}

__device__ __forceinline__ void ln_core(f32x4 (&v)[8], const f32x4 (&gg)[8], const f32x4 (&bb)[8]) {
    float s = 0.f;
#pragma unroll
    for (int j = 0; j < 8; ++j) s += (v[j][0] + v[j][1]) + (v[j][2] + v[j][3]);
    const float mean = wave_sum(s) * (1.f / D); float s2 = 0.f;
#pragma unroll
    for (int j = 0; j < 8; ++j) { v[j] = v[j] - mean; s2 += (v[j][0] * v[j][0] + v[j][1] * v[j][1]) + (v[j][2] * v[j][2] + v[j][3] * v[j][3]); }
    const float rstd = 1.0f / sqrtf(wave_sum(s2) * (1.f / D) + LN_EPS);
#pragma unroll
    for (int j = 0; j < 8; ++j) v[j] = v[j] * rstd * gg[j] + bb[j];
}
__device__ __forceinline__ void ln_store(const f32x4 (&v)[8], float* xf, bf16* xb, int lane) {
#pragma unroll
    for (int j = 0; j < 8; ++j) { *(f32x4*)(xf + 4 * lane + 256 * j) = v[j]; u32x2 w; w.x = cvt_pk_bf16(v[j][0], v[j][1]); w.y = cvt_pk_bf16(v[j][2], v[j][3]); *(u32x2*)(xb + 4 * lane + 256 * j) = w; }
}
__device__ __forceinline__ void ln_phase(Frame& F, const float* Y, const float* gam, const float* bet, float* XF, bf16* XB) {
    const int gw = F.vcu * 8 + F.wave, NGW = F.G * 8, lane = F.lane;
    f32x4 gg[8], bb[8];
#pragma unroll
    for (int j = 0; j < 8; ++j) { gg[j] = *(const f32x4*)(gam + 4 * lane + 256 * j); bb[j] = *(const f32x4*)(bet + 4 * lane + 256 * j); }
    for (int m = gw; m < MTOK; m += NGW) {
        f32x4 v[8];
#pragma unroll
        for (int j = 0; j < 8; ++j) v[j] = *(const f32x4*)(Y + (size_t)m * D + 4 * lane + 256 * j);
        ln_core(v, gg, bb); ln_store(v, XF + (size_t)m * D, XB + (size_t)m * D, lane);
    }
}
__device__ __forceinline__ void pool_phase(Frame& F) {
    const bf16* U = (const bf16*)(F.ws + WS_U); bf16* MIX = (bf16*)(F.ws + WS_MIX);
    const int gw = F.vcu * 8 + F.wave, NGW = F.G * 8, lane = F.lane;
    for (int m = gw; m < MTOK; m += NGW) { const int t = m & (SEQ - 1);
#pragma unroll
        for (int j = 0; j < 4; ++j) { const int c = lane + 64 * j, wlen = 2 << (c >> 6);
            const int cnt = (t + 1 < wlen) ? t + 1 : wlen; float acc[8];
#pragma unroll
            for (int e = 0; e < 8; ++e) acc[e] = 0.f;
            u32x4 self = (u32x4){0u, 0u, 0u, 0u};
            for (int i = 0; i < cnt; ++i) { const u32x4 x = *(const u32x4*)(U + (size_t)(m - i) * D + c * 8); if (i == 0) self = x;
#pragma unroll
                for (int e = 0; e < 4; ++e) { acc[2 * e] += bf_lo(x[e]); acc[2 * e + 1] += bf_hi(x[e]); } }
            const float rc = 1.0f / (float)cnt; u32x4 o;
#pragma unroll
            for (int e = 0; e < 4; ++e) o[e] = cvt_pk_bf16(acc[2 * e] * rc - bf_lo(self[e]), acc[2 * e + 1] * rc - bf_hi(self[e]));
            *(u32x4*)(MIX + (size_t)m * D + c * 8) = o; }
    }
}
__device__ __forceinline__ void ln_router_phase(Frame& F, const float* Y, const float* gam, const float* bet, const float* wrt, float* XF, bf16* XB) {
    const int gw = F.vcu * 8 + F.wave, NGW = F.G * 8, lane = F.lane, tid = F.tid;
    LAS float* WR = (LAS float*)F.lds;
    LAS int* cntl = (LAS int*)(F.lds + 65536);
    LAS int* info = (LAS int*)(F.lds + 65536 + 64);
    int* LIST = (int*)(F.ws + WS_LIST); int* TOK = (int*)(F.ws + WS_TOK); unsigned* gcnt = (unsigned*)(F.ws + WS_CTL) + CW_CNT;
    __syncthreads();
    for (int i = tid; i < D * NE; i += 512) { const int c = i >> 3, e = i & 7; WR[e * D + c] = wrt[i]; }
    if (tid < 16) cntl[tid] = 0;
    __syncthreads();
    f32x4 gg[8], bb[8];
#pragma unroll
    for (int j = 0; j < 8; ++j) { gg[j] = *(const f32x4*)(gam + 4 * lane + 256 * j); bb[j] = *(const f32x4*)(bet + 4 * lane + 256 * j); }
    int k = 0;
    for (int m = gw; m < MTOK; m += NGW, ++k) {
        f32x4 v[8];
#pragma unroll
        for (int j = 0; j < 8; ++j) v[j] = *(const f32x4*)(Y + (size_t)m * D + 4 * lane + 256 * j);
        ln_core(v, gg, bb); ln_store(v, XF + (size_t)m * D, XB + (size_t)m * D, lane);
        float lg[8];
#pragma unroll
        for (int e = 0; e < 8; ++e) { float s = 0.f;
#pragma unroll
            for (int j = 0; j < 8; ++j) { const f32x4 wv = *(const LAS f32x4*)(WR + e * D + 4 * lane + 256 * j); s += (v[j][0] * wv[0] + v[j][1] * wv[1]) + (v[j][2] * wv[2] + v[j][3] * wv[3]); }
            lg[e] = wave_sum(s); }
        int e1 = 0; float v1 = lg[0];
#pragma unroll
        for (int e = 1; e < 8; ++e) if (lg[e] > v1) { v1 = lg[e]; e1 = e; }
        int e2 = -1; float v2 = -__builtin_inff();
#pragma unroll
        for (int e = 0; e < 8; ++e) if (e != e1 && lg[e] > v2) { v2 = lg[e]; e2 = e; }
        if (lane == 0 && k < 8) { const float ex = __expf(v2 - v1), g1 = 1.0f / (1.0f + ex), g2 = ex * g1;
            const int ls1 = atomicAdd((int*)&cntl[e1], 1), ls2 = atomicAdd((int*)&cntl[e2], 1);
            LAS int* q = info + (F.wave * 8 + k) * 8; q[0] = m; q[1] = e1; q[2] = e2; q[3] = ls1; q[4] = ls2; q[5] = __float_as_int(g1); q[6] = __float_as_int(g2); }
    }
    const int nrows = k < 8 ? k : 8;
    if (lane == 0) info[512 + F.wave] = nrows;
    __syncthreads();
    if (tid < 8) cntl[8 + tid] = (int)__hip_atomic_fetch_add(gcnt + 64 * tid, (unsigned)cntl[tid], __ATOMIC_RELAXED, __HIP_MEMORY_SCOPE_AGENT);
    __syncthreads();
    if (tid < 64) { const int wv = tid >> 3, kk = tid & 7;
        if (kk < info[512 + wv]) { const LAS int* q = info + tid * 8; const int m = q[0], e1 = q[1], e2 = q[2], s1 = cntl[8 + e1] + q[3], s2 = cntl[8 + e2] + q[4];
            LIST[e1 * MTOK + s1] = m; LIST[e2 * MTOK + s2] = m;
            int* t = TOK + (size_t)m * 8; t[0] = e1; t[1] = s1; t[2] = q[5]; t[3] = e2; t[4] = s2; t[5] = q[6]; } }
    __syncthreads();
}
__device__ __forceinline__ void moe_prefix(Frame& F, int (&tb)[9], int (&cnt)[8]) {
    const unsigned* gcnt = (const unsigned*)(F.ws + WS_CTL) + CW_CNT; tb[0] = 0;
#pragma unroll
    for (int e = 0; e < 8; ++e) { cnt[e] = (int)__builtin_amdgcn_readfirstlane(gcnt[64 * e]); tb[e + 1] = tb[e] + ((cnt[e] + 255) >> 8); }
}
__device__ __forceinline__ void gather_phase(Frame& F) {
    const int gw = F.vcu * 8 + F.wave, NGW = F.G * 8, lane = F.lane;
    int tb[9], cnt[8]; moe_prefix(F, tb, cnt);
    const int* LIST = (const int*)(F.ws + WS_LIST); const bf16* XB = (const bf16*)(F.ws + WS_XB0); bf16* XG = (bf16*)(F.ws + WS_XG);
    const int rows = tb[8] * 256;
    for (int rr = gw; rr < rows; rr += NGW) { const int tile = rr >> 8; int e = 0;
#pragma unroll
        for (int j = 1; j < 8; ++j) e += (tile >= tb[j]) ? 1 : 0;
        int base = 0, ce = 0;
#pragma unroll
        for (int j = 0; j < 8; ++j) if (j == e) { base = tb[j] * 256; ce = cnt[j]; }
        const int s = rr - base; u32x4 v[4];
        if (s < ce) { const int tok = LIST[e * MTOK + s];
#pragma unroll
            for (int j = 0; j < 4; ++j) v[j] = *(const u32x4*)(XB + (size_t)tok * D + (lane + 64 * j) * 8); }
        else {
#pragma unroll
            for (int j = 0; j < 4; ++j) v[j] = (u32x4){0u, 0u, 0u, 0u}; }
#pragma unroll
        for (int j = 0; j < 4; ++j) *(u32x4*)(XG + (size_t)rr * D + (lane + 64 * j) * 8) = v[j]; }
}
__device__ __forceinline__ void ln_moe_phase(Frame& F, const float* X4, const float* gam, const float* bet, float* XF, bf16* XB) {
    const int gw = F.vcu * 8 + F.wave, NGW = F.G * 8, lane = F.lane;
    int tb[9], cnt[8]; moe_prefix(F, tb, cnt);
    const int* TOK = (const int*)(F.ws + WS_TOK); const bf16* YE = (const bf16*)(F.ws + WS_XG);
    f32x4 gg[8], bb[8];
#pragma unroll
    for (int j = 0; j < 8; ++j) { gg[j] = *(const f32x4*)(gam + 4 * lane + 256 * j); bb[j] = *(const f32x4*)(bet + 4 * lane + 256 * j); }
    for (int m = gw; m < MTOK; m += NGW) {
        const int* t = TOK + (size_t)m * 8; const int e1 = t[0], s1 = t[1], e2 = t[3], s2 = t[4]; const float g1 = __int_as_float(t[2]), g2 = __int_as_float(t[5]);
        int b1 = 0, b2 = 0;
#pragma unroll
        for (int j = 0; j < 8; ++j) { if (j == e1) b1 = tb[j] * 256; if (j == e2) b2 = tb[j] * 256; }
        const bf16* y1 = YE + (size_t)(b1 + s1) * D; const bf16* y2 = YE + (size_t)(b2 + s2) * D;
        f32x4 v[8];
#pragma unroll
        for (int j = 0; j < 8; ++j) { const f32x4 x = *(const f32x4*)(X4 + (size_t)m * D + 4 * lane + 256 * j); const u32x2 a = *(const u32x2*)(y1 + 4 * lane + 256 * j), b = *(const u32x2*)(y2 + 4 * lane + 256 * j);
            v[j][0] = DN_ALPHA * x[0] + g1 * bf_lo(a.x) + g2 * bf_lo(b.x); v[j][1] = DN_ALPHA * x[1] + g1 * bf_hi(a.x) + g2 * bf_hi(b.x);
            v[j][2] = DN_ALPHA * x[2] + g1 * bf_lo(a.y) + g2 * bf_lo(b.y); v[j][3] = DN_ALPHA * x[3] + g1 * bf_hi(a.y) + g2 * bf_hi(b.y); }
        ln_core(v, gg, bb); ln_store(v, XF + (size_t)m * D, XB + (size_t)m * D, lane);
    }
}

constexpr int NPHASE = 19;
__global__ void __launch_bounds__(512, 2) fwd_kernel(Args args) {
    extern __shared__ __attribute__((aligned(16))) unsigned char lds[];
    Frame F; F.lds = (LAS unsigned char*)lds; F.tid = threadIdx.x; F.lane = F.tid & 63; F.wave = __builtin_amdgcn_readfirstlane(F.tid >> 6);
    F.G = gridDim.x; { const int bx = blockIdx.x; F.vcu = (F.G % 8 == 0) ? (bx % 8) * (F.G / 8) + bx / 8 : bx; }
    F.ws = args.ws; unsigned char* ws = args.ws;
    volatile LAS unsigned* MISC = (volatile LAS unsigned*)(F.lds + MISC_OFF);
    for (int u = F.tid; u < (LDS_BYTES - LDSCTL_OFF) / 4; u += 512) ((LAS unsigned*)(F.lds + LDSCTL_OFF))[u] = 0u;
    __syncthreads();
    XcdBarrier bar; bar.bar = (unsigned*)(ws + WS_CTL) + CW_BAR; bar.x = 0; bar.st = nullptr;
    if (!MK_PER_PHASE) bar = xcd_barrier_post((unsigned*)(ws + WS_CTL) + CW_BAR, MISC + 8);
    const int lo = args.ph_lo, hi = args.ph_hi;
#define IN(k) (lo <= (k) && (k) < hi)
#define SEAM(k) do { if (IN(k) && IN((k) + 1)) xcd_barrier(bar); } while (0)
    LAS unsigned char* ring = F.lds;
    const int bx = (int)blockIdx.x;
    bf16* XB0 = (bf16*)(ws + WS_XB0); bf16* XB1 = (bf16*)(ws + WS_XB1); float* XFA = (float*)(ws + WS_XFA); float* XFB = (float*)(ws + WS_XFB); float* Y = args.out;

    if (IN(0)) { p0_prologue(F, args); } SEAM(0);
    if (IN(1)) {
        { pg8::Gemm g{XB0, (const bf16*)(ws + WS_WQKV), D, D, D}; pg8::StaticOrder S; S.init(MTOK, NQKV, F.G, bx);
          pg8::EpiQKV E{(bf16*)(ws + WS_QKV), (const float*)(ws + WS_ROPE)}; pg8::gemm_phase(ring, g, S, E); }
        { pg8::Gemm g{(const bf16*)(ws + WS_PB), (const bf16*)(ws + WS_WPROJ), PLE, PLE, PLE}; pg8::BatchOrder S; S.init(MTOK, D, 2, (size_t)MTOK * PLE, (size_t)D * PLE, F.G, bx);
          pg8::EpiBf16 E{(bf16*)(ws + WS_PPROJ), D, (size_t)MTOK * D, 0}; pg8::gemm_phase(ring, g, S, E); }
        {
          pg8::Gemm g{(const bf16*)(ws + WS_WO2), (const bf16*)(ws + WS_WGS), 512, D, 512}; pg8::BatchOrder S; S.init(D, 512, 4, (size_t)512, (size_t)512 * 512, F.G, bx);
          pg8::EpiBf16 E{(bf16*)(ws + WS_WCOMB), D, (size_t)0, 512}; pg8::gemm_phase(ring, g, S, E); }
    } SEAM(1);
    if (IN(2)) { attn_phase(F); } SEAM(2);
    if (IN(3)) { combine_phase(F); moe_convert_phase(F, args); } SEAM(3);
    if (IN(4)) { pg8::Gemm g{(const bf16*)(ws + WS_ATT), (const bf16*)(ws + WS_WO), D, D, D}; pg8::StaticOrder S; S.init(MTOK, D, F.G, bx);
        pg8::EpiRes E{args.in[0], Y, D, DN_ALPHA}; pg8::gemm_phase(ring, g, S, E); } SEAM(4);
    if (IN(5)) { ln_phase(F, Y, args.in[8], args.in[9], XFA, XB0); } SEAM(5);
    if (IN(6)) { pg8::Gemm g{XB0, (const bf16*)(ws + WS_W13), D, D, D}; pg8::StaticOrder S; S.init(MTOK, FF2, F.G, bx);
        pg8::EpiSwiGLU E{(bf16*)(ws + WS_H), FF}; pg8::gemm_phase(ring, g, S, E); } SEAM(6);
    if (IN(7)) { pg8::Gemm g{(const bf16*)(ws + WS_H), (const bf16*)(ws + WS_W2), FF, FF, FF}; pg8::StaticOrder S; S.init(MTOK, D, F.G, bx);
        pg8::EpiRes E{XFA, Y, D, DN_ALPHA}; pg8::gemm_phase(ring, g, S, E); } SEAM(7);
    if (IN(8)) { ln_phase(F, Y, args.in[10], args.in[11], XFB, XB0); } SEAM(8);
    if (IN(9)) { pg8::Gemm g{XB0, (const bf16*)(ws + WS_WGATE), D, D, D}; pg8::StaticOrder S; S.init(MTOK, D, F.G, bx);
        pg8::EpiPle E{XFB, (const bf16*)(ws + WS_PPROJ), args.in[21], XFA, XB1, D}; pg8::gemm_phase(ring, g, S, E); } SEAM(9);
    if (IN(10)) { pg8::Gemm g{XB1, (const bf16*)(ws + WS_WIN), D, D, D}; pg8::StaticOrder S; S.init(MTOK, D, F.G, bx);
        pg8::EpiBf16 E{(bf16*)(ws + WS_U), D, (size_t)0, 0}; pg8::gemm_phase(ring, g, S, E); } SEAM(10);
    if (IN(11)) { pool_phase(F); } SEAM(11);
    if (IN(12)) { pg8::Gemm g{(const bf16*)(ws + WS_MIX), (const bf16*)(ws + WS_WCOMB), D, D, D}; pg8::StaticOrder S; S.init(MTOK, D, F.G, bx);
        pg8::EpiRes E{XFA, Y, D, DN_ALPHA}; pg8::gemm_phase(ring, g, S, E); } SEAM(12);
    if (IN(13)) { ln_router_phase(F, Y, args.in[8] + D, args.in[9] + D, args.in[15], XFB, XB0); } SEAM(13);
    if (IN(14)) { gather_phase(F); } SEAM(14);
    if (IN(15)) { int tb[9], cnt[8]; moe_prefix(F, tb, cnt);
        pg8::Gemm g{(const bf16*)(ws + WS_XG), (const bf16*)(ws + WS_MW13), D, D, D}; pg8::MoeOrder S; S.nM = tb[8]; S.nN = FF2 / 256; S.nwg = S.nM * S.nN; S.G = F.G; S.c = bx; S.sB = (size_t)FF2 * D;
#pragma unroll
        for (int j = 0; j < 9; ++j) S.tb[j] = tb[j];
        pg8::EpiSwiGLU E{(bf16*)(ws + WS_HM), FF}; pg8::gemm_phase(ring, g, S, E); } SEAM(15);
    if (IN(16)) { int tb[9], cnt[8]; moe_prefix(F, tb, cnt);
        pg8::Gemm g{(const bf16*)(ws + WS_HM), (const bf16*)(ws + WS_MW2), FF, FF, FF}; pg8::MoeOrder S; S.nM = tb[8]; S.nN = D / 256; S.nwg = S.nM * S.nN; S.G = F.G; S.c = bx; S.sB = (size_t)D * FF;
#pragma unroll
        for (int j = 0; j < 9; ++j) S.tb[j] = tb[j];
        pg8::EpiBf16 E{(bf16*)(ws + WS_XG), D, (size_t)0, 0}; pg8::gemm_phase(ring, g, S, E); } SEAM(16);
    if (IN(17)) { ln_moe_phase(F, XFB, args.in[10] + D, args.in[11] + D, XFA, XB0); } SEAM(17);
    if (IN(18)) { pg8::Gemm g{XB0, (const bf16*)(ws + WS_WGATE) + (size_t)D * D, D, D, D}; pg8::StaticOrder S; S.init(MTOK, D, F.G, bx);
        pg8::EpiPle E{XFA, (const bf16*)(ws + WS_PPROJ) + (size_t)MTOK * D, args.in[21] + D, args.out, nullptr, D}; pg8::gemm_phase(ring, g, S, E); }
#undef IN
#undef SEAM
}

extern "C" void kernel_launch(void* const* d_in, const int* in_sizes, int n_in, void* d_out, int out_size, void* d_ws, size_t ws_size, hipStream_t stream) {
    static int grid = 0;
    if (grid == 0) {
        if (n_in != 22 || out_size != MTOK * D || ws_size < WS_END) { fprintf(stderr, "kernel_launch: unexpected shapes (n_in %d, out %d, ws %zu < %zu)\n", n_in, out_size, ws_size, (size_t)WS_END); grid = -1; return; }
        int dev = 0, cus = 0, per_cu = 0;
        if (hipGetDevice(&dev) != hipSuccess || hipDeviceGetAttribute(&cus, hipDeviceAttributeMultiprocessorCount, dev) != hipSuccess) { grid = -1; return; }
        if (hipFuncSetAttribute((const void*)fwd_kernel, hipFuncAttributeMaxDynamicSharedMemorySize, LDS_BYTES) != hipSuccess) { fprintf(stderr, "kernel_launch: hipFuncSetAttribute failed\n"); grid = -1; return; }
        if (hipOccupancyMaxActiveBlocksPerMultiprocessor(&per_cu, (const void*)fwd_kernel, 512, LDS_BYTES) != hipSuccess || per_cu < 1) { fprintf(stderr, "kernel_launch: occupancy query says %d blocks per CU\n", per_cu); }
        (void)hipGetLastError();
        grid = cus;
    }
    if (grid < 0) return;
    (void)hipMemsetAsync((char*)d_ws + WS_CTL, 0, CTL_ZERO_BYTES, stream);
    Args a{};
    for (int i = 0; i < 22; ++i) a.in[i] = (const float*)d_in[i];
    a.out = (float*)d_out; a.ws = (unsigned char*)d_ws;
#if MK_PER_PHASE
    for (int p = 0; p < NPHASE; ++p) { a.ph_lo = p; a.ph_hi = p + 1; hipLaunchKernelGGL(fwd_kernel, dim3(grid), dim3(512), LDS_BYTES, stream, a); }
#else
    a.ph_lo = 0; a.ph_hi = NPHASE; hipLaunchKernelGGL(fwd_kernel, dim3(grid), dim3(512), LDS_BYTES, stream, a);
#endif
}
```

```cpp
#include <hip/hip_runtime.h>
#include <cstdio>
#include <cstdint>

#ifndef MK_PER_PHASE
#define MK_PER_PHASE 0
#endif
#ifndef STAMP_SEL
#define STAMP_SEL 0
#endif
#ifndef PHT_SEL
#define PHT_SEL -1
#endif
#define PHT_MULT 4
#ifndef DUP_MASK
#define DUP_MASK 0u
#endif

#define LAS __attribute__((address_space(3)))
#define GAS __attribute__((address_space(1)))
typedef unsigned short bf16;
typedef short bf16x8 __attribute__((ext_vector_type(8)));
typedef short s16x4 __attribute__((ext_vector_type(4)));
typedef float f32x4 __attribute__((ext_vector_type(4)));
typedef float f32x2 __attribute__((ext_vector_type(2)));
typedef unsigned u32x4 __attribute__((ext_vector_type(4)));
typedef unsigned u32x2 __attribute__((ext_vector_type(2)));
typedef GAS unsigned gu32;

constexpr int D = 2048, BATCH = 4, SEQ = 4096, MTOK = BATCH * SEQ;
constexpr int NH = 16, HD = 128, NQKV = 3 * 3 * D;
constexpr int FF = 5632, FF2 = 2 * FF;
constexpr int NE = 8, PLE = 256;
constexpr float LN_EPS = 1e-5f;
constexpr float DN_ALPHA = 1.41421356237309515f;
constexpr int MOE_ROWS = 2 * MTOK + NE * 256;

constexpr size_t MiB = 1u << 20;
constexpr size_t WS_CTL = 0, CTL_ZERO_BYTES = 1 * MiB;
constexpr size_t WS_LIST = 1 * MiB;
constexpr size_t WS_TOK = 2 * MiB;
constexpr size_t WS_LSE = 3 * MiB;
constexpr size_t WS_ROPE = 6 * MiB;
constexpr size_t WS_WGATE = 8 * MiB;
constexpr size_t WS_WPROJ = 24 * MiB;
constexpr size_t WS_WIN = 26 * MiB;
constexpr size_t WS_WCOMB = 34 * MiB;
constexpr size_t WS_WO2 = 42 * MiB;
constexpr size_t WS_WGS = 50 * MiB;
constexpr size_t WS_PB = 52 * MiB;
constexpr size_t WS_PPROJ = 68 * MiB;
constexpr size_t WS_XB0 = 196 * MiB;
constexpr size_t WS_YB = 260 * MiB;
constexpr size_t WS_WQKV = 516 * MiB;
constexpr size_t WS_WO = 588 * MiB;
constexpr size_t WS_W13 = 596 * MiB;
constexpr size_t WS_W2 = 640 * MiB;
constexpr size_t WS_QKV = 662 * MiB;
constexpr size_t WS_OG = 1238 * MiB;
constexpr size_t WS_ATT = 1430 * MiB;
constexpr size_t WS_MW13 = 662 * MiB;
constexpr size_t WS_MW2 = 1014 * MiB;
constexpr size_t WS_H = 1238 * MiB;
constexpr size_t WS_XB1 = 1430 * MiB;
constexpr size_t WS_U = 1190 * MiB;
constexpr size_t WS_MIX = 1254 * MiB;
constexpr size_t WS_HM = 1190 * MiB;
constexpr size_t WS_XG = 516 * MiB;
constexpr size_t WS_YEP = 324 * MiB;
constexpr size_t WS_END = 1564 * MiB;
static_assert(WS_MW2 + (size_t)NE * D * FF * 2 <= WS_U && WS_HM + (size_t)MOE_ROWS * FF * 2 <= WS_END && WS_XG + (size_t)MOE_ROWS * D * 2 <= WS_QKV, "ws map");

constexpr int CW_CNT = 64;
constexpr int CW_BAR = 4096;

constexpr int RING_BYTES = 131072;
constexpr int LDSCTL_OFF = RING_BYTES, MISC_OFF = LDSCTL_OFF + 320;
constexpr int LDS_BYTES = 163840;

#define VM_WAIT() asm volatile("s_waitcnt vmcnt(0)" ::: "memory")
__device__ __forceinline__ unsigned cvt_pk_bf16(float lo, float hi) { unsigned r; asm volatile("v_cvt_pk_bf16_f32 %0, %1, %2" : "=v"(r) : "v"(lo), "v"(hi)); return r; }
__device__ __forceinline__ float bf_lo(unsigned w) { return __uint_as_float(w << 16); }
__device__ __forceinline__ float bf_hi(unsigned w) { return __uint_as_float(w & 0xffff0000u); }
__device__ __forceinline__ float wave_sum(float v) {
#pragma unroll
    for (int o = 1; o < 64; o <<= 1) v += __shfl_xor(v, o);
    return v;
}

namespace pg8 {
#define PG8_LAS __attribute__((address_space(3)))
typedef unsigned short bf16_t;
constexpr int BM = 256, BK = 64, HALF = 128, HTB = HALF * BK * 2, STAGE_BYTES = 8 * HTB, NXCD = 8, WGM = 8;

__host__ __device__ __forceinline__ int lds_byte(int r, int c) { const int st = (r >> 4) * 2 + (c >> 5), rr = r & 15, cc = c & 31, ob = rr * 64 + cc * 2; return st * 1024 + (ob ^ (((ob >> 9) & 1) << 5)); }
__host__ __device__ __forceinline__ void stage_rc(int b, int& R, int& C) { const int st = b / 1024, sb = b % 1024, swz = sb ^ (((sb >> 9) & 1) << 5); R = (st >> 1) * 16 + swz / 64; C = (st & 1) * 32 + (swz % 64) / 2; }
__host__ __device__ __forceinline__ int perm32(int rho) { const int n = rho >> 4, i = rho & 15; return 8 * (i >> 2) + 4 * n + (i & 3); }

struct Unit { int pm, pn, e; };
struct Gemm { const bf16_t* A; const bf16_t* Bt; int K, lda, ldb; };

__device__ __forceinline__ void tile_of(int wgid, int nM, int nN, int& pm, int& pn) {
    const int nwg = nM * nN;
    { const int q = nwg / NXCD, r = nwg % NXCD, xcd = wgid % NXCD, off = wgid / NXCD; wgid = (xcd < r ? xcd * (q + 1) : r * (q + 1) + (xcd - r) * q) + off; }
    const int nig = WGM * nN, gid = wgid / nig, fm = gid * WGM, gsz = (nM - fm) < WGM ? (nM - fm) : WGM;
    pm = fm + ((wgid % nig) % gsz); pn = (wgid % nig) / gsz;
}
struct StaticOrder {
    int nM, nN, nwg, G, c;
    __device__ __forceinline__ void init(int M, int N, int G_, int c_) { nM = M / BM; nN = N / BM; nwg = nM * nN; G = G_; c = c_; }
    __device__ __forceinline__ bool next(int i, Unit& u) const {
        const long L = (long)i * G + c; if (L >= nwg) return false;
        tile_of((int)L, nM, nN, u.pm, u.pn); u.e = 0; return true;
    }
    __device__ __forceinline__ const char* a_ptr(const Gemm& g, const Unit& u) const { return (const char*)g.A + (size_t)u.pm * BM * g.lda * 2; }
    __device__ __forceinline__ const char* b_ptr(const Gemm& g, const Unit& u) const { return (const char*)g.Bt + (size_t)u.pn * BM * g.ldb * 2; }
    __device__ __forceinline__ int unit_nt(const Gemm& g, const Unit&) const { return g.K / BK; }
};
struct BatchOrder {
    int nM, nN, nwg, nb, G, c; size_t sA, sB;
    __device__ __forceinline__ void init(int M, int N, int nb_, size_t sA_, size_t sB_, int G_, int c_) { nM = M / BM; nN = N / BM; nwg = nM * nN; nb = nb_; sA = sA_; sB = sB_; G = G_; c = c_; }
    __device__ __forceinline__ bool next(int i, Unit& u) const {
        const long L = (long)i * G + c; if (L >= (long)nwg * nb) return false;
        u.e = (int)(L / nwg); tile_of((int)(L % nwg), nM, nN, u.pm, u.pn); return true;
    }
    __device__ __forceinline__ const char* a_ptr(const Gemm& g, const Unit& u) const { return (const char*)(g.A + (size_t)u.e * sA) + (size_t)u.pm * BM * g.lda * 2; }
    __device__ __forceinline__ const char* b_ptr(const Gemm& g, const Unit& u) const { return (const char*)(g.Bt + (size_t)u.e * sB) + (size_t)u.pn * BM * g.ldb * 2; }
    __device__ __forceinline__ int unit_nt(const Gemm& g, const Unit&) const { return g.K / BK; }
};
struct MoeOrder {
    int nM, nN, nwg, G, c; size_t sB; int tb[9]; bool gather;
    __device__ __forceinline__ bool next(int i, Unit& u) const {
        const long L = (long)i * G + c; if (L >= nwg) return false;
        tile_of((int)L, nM, nN, u.pm, u.pn);
        int e = 0;
#pragma unroll
        for (int j = 1; j < 8; ++j) e += (u.pm >= tb[j]) ? 1 : 0;
        u.e = e; return true;
    }
    __device__ __forceinline__ const char* a_ptr(const Gemm& g, const Unit& u) const { return (const char*)g.A + (gather ? (size_t)0 : (size_t)u.pm * BM * g.lda * 2); }
    __device__ __forceinline__ const char* b_ptr(const Gemm& g, const Unit& u) const { return (const char*)(g.Bt + (size_t)u.e * sB) + (size_t)u.pn * BM * g.ldb * 2; }
    __device__ __forceinline__ int unit_nt(const Gemm& g, const Unit&) const { return g.K / BK; }
};

struct MoeDownOrder {
    int nM, G, c, nfull, kq_elems, kq_nt; size_t sB; int tb[9];
    __device__ __forceinline__ bool next(int i, Unit& u) const {
        const long L = (long)i * G + c; int kq1 = 0, uu;
        if (L < nfull) uu = (int)L;
        else { const long L2 = L - nfull; if (L2 >= 4l * (8 * nM - nfull)) return false; uu = nfull + (int)(L2 >> 2); kq1 = (int)(L2 & 3) + 1; }
        u.pm = uu >> 3; u.pn = uu & 7;
        int e = 0;
#pragma unroll
        for (int j = 1; j < 8; ++j) e += (u.pm >= tb[j]) ? 1 : 0;
        u.e = e | (kq1 << 8); return true;
    }
    __device__ __forceinline__ const char* a_ptr(const Gemm& g, const Unit& u) const { const int kq1 = u.e >> 8; return (const char*)g.A + ((size_t)u.pm * BM * g.lda + (size_t)(kq1 ? (kq1 - 1) * kq_elems : 0)) * 2; }
    __device__ __forceinline__ const char* b_ptr(const Gemm& g, const Unit& u) const { const int kq1 = u.e >> 8; return (const char*)(g.Bt + (size_t)(u.e & 255) * sB) + ((size_t)u.pn * BM * g.ldb + (size_t)(kq1 ? (kq1 - 1) * kq_elems : 0)) * 2; }
    __device__ __forceinline__ int unit_nt(const Gemm& g, const Unit& u) const { return (u.e >> 8) ? kq_nt : g.K / BK; }
};


struct EpiBf16 {
    static constexpr bool PERM = true;
    bf16_t* O; int ldc; size_t estride; int ecol;
    __device__ __forceinline__ void operator()(const f32x4 (&acc)[2][2][4][2], const Unit& u, int wr, int wc, int fr, int fq) const {
        const int row0 = u.pm * BM + wr * 64 + fr; const int col0 = u.pn * BM + wc * 32 + 8 * fq + u.e * ecol;
        bf16_t* base = O + (size_t)u.e * estride;
#pragma unroll
        for (int ai = 0; ai < 2; ++ai)
#pragma unroll
            for (int m = 0; m < 4; ++m) { bf16_t* rowp = base + (size_t)(row0 + ai * HALF + m * 16) * ldc + col0;
#pragma unroll
                for (int bj = 0; bj < 2; ++bj) { const f32x4 v0 = acc[ai][bj][m][0], v1 = acc[ai][bj][m][1];
                    u32x4 w; w.x = cvt_pk_bf16(v0[0], v0[1]); w.y = cvt_pk_bf16(v0[2], v0[3]); w.z = cvt_pk_bf16(v1[0], v1[1]); w.w = cvt_pk_bf16(v1[2], v1[3]);
                    *(u32x4*)(rowp + bj * HALF) = w; } }
    }
};
struct EpiMoeDown {
    static constexpr bool PERM = true;
    bf16_t* YE; bf16_t* YEP; int pm_split; size_t qstride;
    __device__ __forceinline__ void operator()(const f32x4 (&acc)[2][2][4][2], const Unit& u, int wr, int wc, int fr, int fq) const {
        const int kq1 = u.e >> 8; const int col0 = u.pn * BM + wc * 32 + 8 * fq;
        bf16_t* base = kq1 ? YEP + (size_t)(kq1 - 1) * qstride + (size_t)((u.pm - pm_split) * BM) * D : YE + (size_t)(u.pm * BM) * D;
        const int row0 = wr * 64 + fr;
#pragma unroll
        for (int ai = 0; ai < 2; ++ai)
#pragma unroll
            for (int m = 0; m < 4; ++m) { bf16_t* rowp = base + (size_t)(row0 + ai * HALF + m * 16) * D + col0;
#pragma unroll
                for (int bj = 0; bj < 2; ++bj) { const f32x4 v0 = acc[ai][bj][m][0], v1 = acc[ai][bj][m][1];
                    u32x4 w; w.x = cvt_pk_bf16(v0[0], v0[1]); w.y = cvt_pk_bf16(v0[2], v0[3]); w.z = cvt_pk_bf16(v1[0], v1[1]); w.w = cvt_pk_bf16(v1[2], v1[3]);
                    *(u32x4*)(rowp + bj * HALF) = w; } }
    }
};
struct EpiQKV {
    static constexpr bool PERM = true;
    bf16_t* O; const float* rope;
    __device__ __forceinline__ void operator()(const f32x4 (&acc)[2][2][4][2], const Unit& u, int wr, int wc, int fr, int fq) const {
        const int gt = u.pn >> 3, t = gt % 3, dsh = 2 * (gt / 3), head = 2 * (u.pn & 7) + (wc >> 1), idx0 = 32 * (wc & 1) + 8 * fq;
        const int row0 = u.pm * BM + wr * 64 + fr; bf16_t* hb = O + ((size_t)(gt * 16 + head) * MTOK) * 128 + idx0;
#pragma unroll
        for (int ai = 0; ai < 2; ++ai)
#pragma unroll
            for (int m = 0; m < 4; ++m) { const int row = row0 + ai * HALF + m * 16; const int sq = row & (SEQ - 1);
                bf16_t* rowp = hb + (size_t)((row & ~(SEQ - 1)) + (sq & ((1 << dsh) - 1)) * (SEQ >> dsh) + (sq >> dsh)) * 128;
                f32x4 l0 = acc[ai][0][m][0], l1 = acc[ai][0][m][1], h0 = acc[ai][1][m][0], h1 = acc[ai][1][m][1];
                if (t < 2) { const float* cp = rope + (size_t)(row & (SEQ - 1)) * 64 + idx0; const float* sp = cp + SEQ * 64;
                    const f32x4 c0 = *(const f32x4*)cp, c1 = *(const f32x4*)(cp + 4), s0 = *(const f32x4*)sp, s1 = *(const f32x4*)(sp + 4);
                    const f32x4 a0 = l0 * c0 - h0 * s0, a1 = l1 * c1 - h1 * s1, b0 = h0 * c0 + l0 * s0, b1 = h1 * c1 + l1 * s1;
                    l0 = a0; l1 = a1; h0 = b0; h1 = b1; }
                u32x4 w; w.x = cvt_pk_bf16(l0[0], l0[1]); w.y = cvt_pk_bf16(l0[2], l0[3]); w.z = cvt_pk_bf16(l1[0], l1[1]); w.w = cvt_pk_bf16(l1[2], l1[3]);
                *(u32x4*)rowp = w;
                w.x = cvt_pk_bf16(h0[0], h0[1]); w.y = cvt_pk_bf16(h0[2], h0[3]); w.z = cvt_pk_bf16(h1[0], h1[1]); w.w = cvt_pk_bf16(h1[2], h1[3]);
                *(u32x4*)(rowp + 64) = w; }
    }
};
struct EpiSwiGLU {
    static constexpr bool PERM = true;
    bf16_t* O; int ldc;
    __device__ __forceinline__ void operator()(const f32x4 (&acc)[2][2][4][2], const Unit& u, int wr, int wc, int fr, int fq) const {
        const int row0 = u.pm * BM + wr * 64 + fr; const int col0 = u.pn * HALF + wc * 32 + 8 * fq;
#pragma unroll
        for (int ai = 0; ai < 2; ++ai)
#pragma unroll
            for (int m = 0; m < 4; ++m) { bf16_t* rowp = O + (size_t)(row0 + ai * HALF + m * 16) * ldc + col0;
                float r[8];
#pragma unroll
                for (int n = 0; n < 2; ++n)
#pragma unroll
                    for (int j = 0; j < 4; ++j) { const float a = acc[ai][0][m][n][j], b = acc[ai][1][m][n][j];
                        const float sg = __builtin_amdgcn_rcpf(1.0f + __builtin_amdgcn_exp2f(-1.4426950408889634f * a)); r[n * 4 + j] = a * sg * b; }
                u32x4 w; w.x = cvt_pk_bf16(r[0], r[1]); w.y = cvt_pk_bf16(r[2], r[3]); w.z = cvt_pk_bf16(r[4], r[5]); w.w = cvt_pk_bf16(r[6], r[7]);
                *(u32x4*)rowp = w; }
    }
};
template <bool F32OUT> struct EpiRes {
    static constexpr bool PERM = true;
    const bf16_t* res; void* Y; int ldc; float alpha;
    __device__ __forceinline__ void operator()(const f32x4 (&acc)[2][2][4][2], const Unit& u, int wr, int wc, int fr, int fq) const {
        const int row0 = u.pm * BM + wr * 64 + fr, col0 = u.pn * BM + wc * 32 + 8 * fq;
#pragma unroll
        for (int ai = 0; ai < 2; ++ai)
#pragma unroll
            for (int m = 0; m < 4; ++m) { const size_t off = (size_t)(row0 + ai * HALF + m * 16) * ldc + col0;
#pragma unroll
                for (int bj = 0; bj < 2; ++bj) { const u32x4 rw = *(const u32x4*)(res + off + bj * HALF);
                    f32x4 v0 = acc[ai][bj][m][0], v1 = acc[ai][bj][m][1];
                    v0[0] += alpha * bf_lo(rw.x); v0[1] += alpha * bf_hi(rw.x); v0[2] += alpha * bf_lo(rw.y); v0[3] += alpha * bf_hi(rw.y);
                    v1[0] += alpha * bf_lo(rw.z); v1[1] += alpha * bf_hi(rw.z); v1[2] += alpha * bf_lo(rw.w); v1[3] += alpha * bf_hi(rw.w);
                    if constexpr (F32OUT) { float* yp = (float*)Y + off + bj * HALF; *(f32x4*)yp = v0; *(f32x4*)(yp + 4) = v1; }
                    else { u32x4 w; w.x = cvt_pk_bf16(v0[0], v0[1]); w.y = cvt_pk_bf16(v0[2], v0[3]); w.z = cvt_pk_bf16(v1[0], v1[1]); w.w = cvt_pk_bf16(v1[2], v1[3]); *(u32x4*)((bf16_t*)Y + off + bj * HALF) = w; } }
                if (m == 3) asm volatile("" ::: "memory"); }
    }
};
struct EpiPle {
    static constexpr bool PERM = true;
    const bf16_t* x; const bf16_t* pp; const float* bias; float* outF; bf16_t* outB; int ldc;
    __device__ __forceinline__ void operator()(const f32x4 (&acc)[2][2][4][2], const Unit& u, int wr, int wc, int fr, int fq) const {
        const int row0 = u.pm * BM + wr * 64 + fr, col0 = u.pn * BM + wc * 32 + 8 * fq;
        f32x4 bv[2][2];
#pragma unroll
        for (int bj = 0; bj < 2; ++bj)
#pragma unroll
            for (int n = 0; n < 2; ++n) bv[bj][n] = *(const f32x4*)(bias + col0 + bj * HALF + 4 * n);
#pragma unroll
        for (int ai = 0; ai < 2; ++ai)
#pragma unroll
            for (int m = 0; m < 4; ++m) { const size_t off = (size_t)(row0 + ai * HALF + m * 16) * ldc + col0;
#pragma unroll
                for (int bj = 0; bj < 2; ++bj) { const size_t o2 = off + bj * HALF;
                    const u32x4 xw = *(const u32x4*)(x + o2), pw = *(const u32x4*)(pp + o2);
                    float o[8];
#pragma unroll
                    for (int e = 0; e < 4; ++e) { const int n = e >> 1, j = (e & 1) * 2;
                        const float v0 = acc[ai][bj][m][n][j] + bv[bj][n][j], v1 = acc[ai][bj][m][n][j + 1] + bv[bj][n][j + 1];
                        o[2 * e] = bf_lo(xw[e]) + bf_lo(pw[e]) * __builtin_amdgcn_rcpf(1.0f + __builtin_amdgcn_exp2f(-1.4426950408889634f * v0));
                        o[2 * e + 1] = bf_hi(xw[e]) + bf_hi(pw[e]) * __builtin_amdgcn_rcpf(1.0f + __builtin_amdgcn_exp2f(-1.4426950408889634f * v1)); }
                    if (outF) { float* yp = outF + o2; *(f32x4*)yp = (f32x4){o[0], o[1], o[2], o[3]}; *(f32x4*)(yp + 4) = (f32x4){o[4], o[5], o[6], o[7]}; }
                    else { u32x4 w; w.x = cvt_pk_bf16(o[0], o[1]); w.y = cvt_pk_bf16(o[2], o[3]); w.z = cvt_pk_bf16(o[4], o[5]); w.w = cvt_pk_bf16(o[6], o[7]); *(u32x4*)(outB + o2) = w; } }
                if (m & 1) asm volatile("" ::: "memory"); }
    }
};

constexpr int IDX_LDS_OFF = 131072 + 1024;
template <class Epi, class Sched, bool ALIGN_EPI = true, bool SP2 = true, bool STAMP = false, bool GATHER = false>
__device__ __forceinline__ void gemm_phase(PG8_LAS unsigned char* lds, const Gemm g, const Sched& S, const Epi& E, unsigned long long* stp = nullptr) {
    const int tid = threadIdx.x, wid = __builtin_amdgcn_readfirstlane(tid >> 6), lane = tid & 63, wr = wid >> 2, wc = wid & 3, fr = lane & 15, fq = lane >> 4;
    unsigned voffA[2], voffB[2]; int gR[2], gC[2];
#pragma unroll
    for (int i = 0; i < 2; ++i) { int R, C; stage_rc(tid * 16 + i * 8192, R, C); const int Rb = Epi::PERM ? ((R & ~31) + perm32(R & 31)) : R; gR[i] = R; gC[i] = C;
        voffA[i] = (unsigned)(R * g.lda + C) * 2u; voffB[i] = (unsigned)(Rb * g.ldb + C) * 2u; }
    const size_t kstep = (size_t)(BK * 2);
    const size_t hstepA = (size_t)HALF * g.lda * 2, hstepB = (size_t)HALF * g.ldb * 2;
    const PG8_LAS unsigned short* gidx = (const PG8_LAS unsigned short*)(lds + IDX_LDS_OFF);
    unsigned cvo[2][2], nvo[2][2];
#define PG8_GOFF(dst, ui_) do { _Pragma("unroll") for (int _h = 0; _h < 2; ++_h) _Pragma("unroll") for (int _i = 0; _i < 2; ++_i) \
        dst[_h][_i] = GATHER ? ((unsigned)gidx[(ui_) * 256 + _h * HALF + gR[_i]] * (unsigned)(g.lda * 2) + (unsigned)(gC[_i] * 2)) : (voffA[_i] + (unsigned)(_h * hstepA)); } while (0)
    PG8_GOFF(cvo, 0);
#pragma unroll
    for (int _h = 0; _h < 2; ++_h)
#pragma unroll
        for (int _i = 0; _i < 2; ++_i) nvo[_h][_i] = cvo[_h][_i];
    const unsigned ldsw = (unsigned)wid * 1024u;
    const int aoff = lds_byte(wr * 64 + fr, fq * 8), boff = lds_byte(wc * 32 + fr, fq * 8);
#define PG8_SA(b, h) (((b) * 2 + (h)) * HTB)
#define PG8_SB(b, h) ((4 + (b) * 2 + (h)) * HTB)
#define PG8_STAGE(bufoff, gbase, voff) do { _Pragma("unroll") for (int _i = 0; _i < 2; ++_i) \
        __builtin_amdgcn_global_load_lds((const unsigned*)((const char*)(gbase) + (voff)[_i]), (PG8_LAS unsigned*)(lds + (bufoff) + ldsw + _i * 8192), 16, 0, 0); } while (0)
#define PG8_LDA(dst, b, h) do { _Pragma("unroll") for (int m = 0; m < 4; ++m) _Pragma("unroll") for (int k = 0; k < 2; ++k) dst[m][k] = *(const PG8_LAS bf16x8*)(lds + PG8_SA(b, h) + aoff + m * 2048 + k * 1024); } while (0)
#define PG8_LDB(dst, b, h) do { _Pragma("unroll") for (int n = 0; n < 2; ++n) _Pragma("unroll") for (int k = 0; k < 2; ++k) dst[n][k] = *(const PG8_LAS bf16x8*)(lds + PG8_SB(b, h) + boff + n * 2048 + k * 1024); } while (0)
#define PG8_MMA(ai, bj, At, Bt) do { __builtin_amdgcn_s_setprio(1); _Pragma("unroll") for (int m = 0; m < 4; ++m) _Pragma("unroll") for (int n = 0; n < 2; ++n) _Pragma("unroll") for (int k = 0; k < 2; ++k) \
        acc[ai][bj][m][n] = __builtin_amdgcn_mfma_f32_16x16x32_bf16(Bt[n][k], At[m][k], acc[ai][bj][m][n], 0, 0, 0); __builtin_amdgcn_s_setprio(0); } while (0)
#define PG8_WAIT_V(n) asm volatile("s_waitcnt vmcnt(" #n ")" ::: "memory")
#define PG8_WAIT_L(n) asm volatile("s_waitcnt lgkmcnt(" #n ")" ::: "memory")
#define PG8_BAR __builtin_amdgcn_s_barrier()
#define PG8_SCHED __builtin_amdgcn_sched_barrier(0)
    Unit cur, nxt; int ui = 0;
    if (!S.next(0, cur)) return;
    long long st_c0 = 0, st_w0 = 0, st_k = 0, st_e = 0, st_t = 0; if (STAMP) { st_c0 = clock64(); st_w0 = wall_clock64(); }
    f32x4 acc[2][2][4][2];
#pragma unroll
    for (int a = 0; a < 2; ++a)
#pragma unroll
        for (int b = 0; b < 2; ++b)
#pragma unroll
            for (int m = 0; m < 4; ++m)
#pragma unroll
                for (int n = 0; n < 2; ++n) acc[a][b][m][n] = (f32x4){0.f, 0.f, 0.f, 0.f};
    bf16x8 At[4][2], B0[2][2], B1[2][2];
    const char* cA = S.a_ptr(g, cur); const char* cB = S.b_ptr(g, cur);
    if constexpr (SP2) {
        PG8_STAGE(PG8_SB(0, 0), cB, voffB); PG8_STAGE(PG8_SB(0, 1), cB + hstepB, voffB); PG8_STAGE(PG8_SA(0, 0), cA, cvo[0]); PG8_STAGE(PG8_SA(0, 1), cA, cvo[1]);
        if (wr == 1) PG8_BAR;
        PG8_WAIT_V(2); PG8_BAR;
        PG8_STAGE(PG8_SB(1, 0), cB + kstep, voffB); PG8_STAGE(PG8_SA(1, 0), cA + kstep, cvo[0]); PG8_STAGE(PG8_SB(1, 1), cB + hstepB + kstep, voffB);
        PG8_WAIT_V(6); PG8_BAR;
    } else {
        PG8_STAGE(PG8_SB(0, 0), cB, voffB); PG8_STAGE(PG8_SA(0, 0), cA, cvo[0]); PG8_STAGE(PG8_SB(0, 1), cB + hstepB, voffB); PG8_STAGE(PG8_SA(0, 1), cA, cvo[1]);
        if (wr == 1) PG8_BAR;
        PG8_WAIT_V(4); PG8_BAR;
        PG8_STAGE(PG8_SB(1, 0), cB + kstep, voffB); PG8_STAGE(PG8_SA(1, 0), cA + kstep, cvo[0]); PG8_STAGE(PG8_SB(1, 1), cB + hstepB + kstep, voffB);
        PG8_WAIT_V(6); PG8_BAR;
    }
    for (;;) {
        const bool has_next = S.next(ui + 1, nxt);
        const char* nA = has_next ? S.a_ptr(g, nxt) : cA; const char* nB = has_next ? S.b_ptr(g, nxt) : cB;
        const int nt = S.unit_nt(g, cur);
        if (GATHER && has_next) PG8_GOFF(nvo, ui + 1);
        if (STAMP) st_t = clock64();
        for (int t = 0; t < nt; t += 2) {
            const bool last = (t == nt - 2);
            const char* a1 = cA + (size_t)(t + 1) * kstep;
            const char* a2 = last ? nA : cA + (size_t)(t + 2) * kstep; const char* b2 = last ? nB : cB + (size_t)(t + 2) * kstep;
            const char* a3 = a2 + kstep; const char* b3 = b2 + kstep;
            unsigned xvo[2][2];
#pragma unroll
            for (int _h = 0; _h < 2; ++_h)
#pragma unroll
                for (int _i = 0; _i < 2; ++_i) xvo[_h][_i] = (GATHER && last) ? nvo[_h][_i] : cvo[_h][_i];
            if constexpr (SP2) {
            PG8_LDB(B0, 0, 0); PG8_LDB(B1, 0, 1); PG8_SCHED; PG8_LDA(At, 0, 0); PG8_STAGE(PG8_SA(1, 1), a1, cvo[1]);
            PG8_WAIT_V(8); PG8_WAIT_L(0); PG8_BAR; PG8_MMA(0, 0, At, B0); PG8_MMA(0, 1, At, B1); PG8_BAR; PG8_SCHED;
            PG8_LDA(At, 0, 1); PG8_STAGE(PG8_SB(0, 0), b2, voffB); PG8_STAGE(PG8_SB(0, 1), b2 + hstepB, voffB); PG8_STAGE(PG8_SA(0, 0), a2, xvo[0]);
            PG8_WAIT_V(8); PG8_WAIT_L(0); PG8_BAR; PG8_MMA(1, 0, At, B0); PG8_MMA(1, 1, At, B1); PG8_BAR; PG8_SCHED;
            PG8_LDB(B0, 1, 0); PG8_LDB(B1, 1, 1); PG8_SCHED; PG8_LDA(At, 1, 0); PG8_STAGE(PG8_SA(0, 1), a2, xvo[1]);
            PG8_WAIT_V(8); PG8_WAIT_L(0); PG8_BAR; PG8_MMA(0, 0, At, B0); PG8_MMA(0, 1, At, B1); PG8_BAR; PG8_SCHED;
            PG8_LDA(At, 1, 1); PG8_STAGE(PG8_SB(1, 0), b3, voffB); PG8_STAGE(PG8_SB(1, 1), b3 + hstepB, voffB); PG8_STAGE(PG8_SA(1, 0), a3, xvo[0]);
            PG8_WAIT_V(8); PG8_WAIT_L(0); PG8_BAR; PG8_MMA(1, 0, At, B0); PG8_MMA(1, 1, At, B1); PG8_BAR; PG8_SCHED;
            } else {
            PG8_LDB(B0, 0, 0); PG8_SCHED; PG8_LDA(At, 0, 0); PG8_STAGE(PG8_SA(1, 1), a1, cvo[1]);
            PG8_WAIT_L(8); PG8_BAR; PG8_WAIT_L(0); PG8_MMA(0, 0, At, B0); PG8_BAR; PG8_SCHED;
            PG8_LDB(B1, 0, 1); PG8_STAGE(PG8_SB(0, 0), b2, voffB);
            PG8_BAR; PG8_WAIT_L(0); PG8_MMA(0, 1, At, B1); PG8_BAR;
            PG8_LDA(At, 0, 1); PG8_STAGE(PG8_SA(0, 0), a2, xvo[0]);
            PG8_BAR; PG8_WAIT_L(0); PG8_MMA(1, 0, At, B0); PG8_BAR; PG8_SCHED;
            PG8_STAGE(PG8_SB(0, 1), b2 + hstepB, voffB);
            PG8_WAIT_V(6); PG8_BAR; PG8_MMA(1, 1, At, B1); PG8_BAR;
            PG8_LDB(B0, 1, 0); PG8_SCHED; PG8_LDA(At, 1, 0); PG8_STAGE(PG8_SA(0, 1), a2, xvo[1]);
            PG8_WAIT_L(8); PG8_BAR; PG8_WAIT_L(0); PG8_MMA(0, 0, At, B0); PG8_BAR; PG8_SCHED;
            PG8_LDB(B1, 1, 1); PG8_STAGE(PG8_SB(1, 0), b3, voffB);
            PG8_BAR; PG8_WAIT_L(0); PG8_MMA(0, 1, At, B1); PG8_BAR;
            PG8_LDA(At, 1, 1); PG8_STAGE(PG8_SA(1, 0), a3, xvo[0]);
            PG8_BAR; PG8_WAIT_L(0); PG8_MMA(1, 0, At, B0); PG8_BAR; PG8_SCHED;
            PG8_STAGE(PG8_SB(1, 1), b3 + hstepB, voffB);
            PG8_WAIT_V(6); PG8_BAR; PG8_MMA(1, 1, At, B1); PG8_BAR;
            }
        }
        if (STAMP) { const long long c = clock64(); st_k += c - st_t; st_t = c; }
        if constexpr (ALIGN_EPI) { if (wr == 0) PG8_BAR; }
        E(acc, cur, wr, wc, fr, fq);
        if (STAMP) { const long long c = clock64(); st_e += c - st_t; }
        if (!has_next) break;
#pragma unroll
        for (int a = 0; a < 2; ++a)
#pragma unroll
            for (int b = 0; b < 2; ++b)
#pragma unroll
                for (int m = 0; m < 4; ++m)
#pragma unroll
                    for (int n = 0; n < 2; ++n) acc[a][b][m][n] = (f32x4){0.f, 0.f, 0.f, 0.f};
        cur = nxt; cA = nA; cB = nB; ++ui;
        if (GATHER) {
#pragma unroll
            for (int _h = 0; _h < 2; ++_h)
#pragma unroll
                for (int _i = 0; _i < 2; ++_i) cvo[_h][_i] = nvo[_h][_i]; }
        if constexpr (ALIGN_EPI) { if (wr == 1) PG8_BAR; }
    }
    PG8_WAIT_V(0);
    if constexpr (!ALIGN_EPI) { if (wr == 0) PG8_BAR; }
    PG8_BAR;
    if (STAMP) { if (blockIdx.x == 0 && tid == 0) { const long long c1 = clock64(), w1 = wall_clock64(); stp[0] = (unsigned long long)((c1 - st_c0) * 100 / (w1 - st_w0)); stp[1] = (unsigned long long)(st_k / ((ui + 1) * (g.K / BK))); stp[2] = (unsigned long long)(st_e / (10 * (ui + 1))); } }
#undef PG8_GOFF
#undef PG8_SA
#undef PG8_SB
#undef PG8_STAGE
#undef PG8_LDA
#undef PG8_LDB
#undef PG8_MMA
#undef PG8_WAIT_V
#undef PG8_WAIT_L
#undef PG8_BAR
#undef PG8_SCHED
}
}

#define XB_TMO      128
#define XB_XCNT(j)  (256  + 64 * (j))
#define XB_XSUB(j)  (1280 + 64 * (j))
#define XB_XGEN(j)  (2304 + 64 * (j))
#define XB_TOP      3328
#define XB_TOPGEN   3392
#define XCD_BAR_WORDS 3456
#define XB_SPIN_CAP (1u << 18)

__device__ __forceinline__ unsigned xb_ld(unsigned* p)              { return __hip_atomic_load(p, __ATOMIC_RELAXED, __HIP_MEMORY_SCOPE_AGENT); }
__device__ __forceinline__ unsigned xb_add(unsigned* p, unsigned v) { return __hip_atomic_fetch_add(p, v, __ATOMIC_RELAXED, __HIP_MEMORY_SCOPE_AGENT); }
__device__ __forceinline__ unsigned xb_xcc_id() { return (unsigned)__builtin_amdgcn_s_getreg((3 << 11) | 20) & 0xFu; }
#define XB_SPIN(cond, bar) do { unsigned _sp = 0; while (cond) { __builtin_amdgcn_s_sleep(1); \
    if ((++_sp & 255u) == 0u) { if (xb_ld(&(bar)[XB_TMO])) break; if (_sp > XB_SPIN_CAP) { atomicAdd(&(bar)[XB_TMO], 1u); break; } } } } while (0)

struct XcdBarrier { unsigned* bar; unsigned x; volatile LAS unsigned* st; };

__device__ __forceinline__ XcdBarrier xcd_barrier_post(unsigned* bar, volatile LAS unsigned* st) {
    XcdBarrier b; b.bar = bar; b.x = xb_xcc_id(); b.st = st;
    if (threadIdx.x == 0) (void)xb_add(&bar[XB_XCNT(b.x)], 1u);
    return b;
}
__device__ __forceinline__ void xcd_barrier_complete(unsigned* bar, unsigned x, unsigned& nloc, unsigned& nx) {
    const unsigned G = gridDim.x * gridDim.y * gridDim.z;
    unsigned sum, cnt, mine, sp = 0u;
    for (;;) {
        sum = 0u; cnt = 0u; mine = 0u;
#pragma unroll
        for (unsigned j = 0; j < 16; ++j) { const unsigned c = xb_ld(&bar[XB_XCNT(j)]); sum += c; cnt += (c > 0u) ? 1u : 0u; mine = (j == x) ? c : mine; }
        if (sum == G) break;
        __builtin_amdgcn_s_sleep(1);
        if ((++sp & 255u) == 0u) { if (xb_ld(&bar[XB_TMO])) break; if (sp > XB_SPIN_CAP) { atomicAdd(&bar[XB_TMO], 1u); break; } }
    }
    nloc = mine > 0u ? mine : 1u; nx = cnt > 0u ? cnt : 1u;
}
__device__ __forceinline__ void xcd_barrier(const XcdBarrier& b) {
    asm volatile("s_waitcnt vmcnt(0)" ::: "memory");
    __syncthreads();
    if (threadIdx.x == 0) {
        unsigned* bar = b.bar;
        __builtin_amdgcn_s_waitcnt(0);
        unsigned nloc = b.st[0], nx = b.st[1];
        if (nloc == 0u) { xcd_barrier_complete(bar, b.x, nloc, nx); b.st[0] = nloc; b.st[1] = nx; }
        const unsigned old = xb_add(&bar[XB_XSUB(b.x)], 1u);
        const unsigned gen = old / nloc;
        if (old + 1u == (gen + 1u) * nloc) {
            __builtin_amdgcn_fence(__ATOMIC_RELEASE, "agent");
            asm volatile("s_waitcnt vmcnt(0)" ::: "memory");
            const unsigned og = xb_add(&bar[XB_TOP], 1u);
            const unsigned tg = og / nx;
            if (og + 1u == (tg + 1u) * nx) xb_add(&bar[XB_TOPGEN], 1u);
            else XB_SPIN(xb_ld(&bar[XB_TOPGEN]) == tg, bar);
            __builtin_amdgcn_fence(__ATOMIC_ACQUIRE, "agent");
            xb_add(&bar[XB_XGEN(b.x)], 1u);
            asm volatile("s_waitcnt vmcnt(0)" ::: "memory");
        } else {
            XB_SPIN(xb_ld(&bar[XB_XGEN(b.x)]) == gen, bar);
            __builtin_amdgcn_fence(__ATOMIC_ACQUIRE, "agent");
            asm volatile("s_waitcnt vmcnt(0)" ::: "memory");
        }
    }
    __syncthreads();
}

struct Frame {
    LAS unsigned char* lds;
    int tid, lane, wave, vcu, G;
    unsigned char* ws;
};
struct Args { const float* in[22]; float* out; unsigned char* ws; int ph_lo, ph_hi; };

__device__ __forceinline__ void cvt_tile(const float* W, size_t ldw, int k0, int n0, bf16* WT, size_t ldt, int dst_row0, int lane) {
    const int kb = lane >> 3, nb = lane & 7;
    const float* src = W + (size_t)(k0 + 8 * kb) * ldw + n0 + 4 * nb;
    f32x4 v[8];
#pragma unroll
    for (int j = 0; j < 8; ++j) v[j] = *(const f32x4*)(src + (size_t)j * ldw);
#pragma unroll
    for (int jn = 0; jn < 4; ++jn) { u32x4 o; o.x = cvt_pk_bf16(v[0][jn], v[1][jn]); o.y = cvt_pk_bf16(v[2][jn], v[3][jn]); o.z = cvt_pk_bf16(v[4][jn], v[5][jn]); o.w = cvt_pk_bf16(v[6][jn], v[7][jn]);
        *(u32x4*)(WT + (size_t)(dst_row0 + 4 * nb + jn) * ldt + k0 + 8 * kb) = o; }
}
struct MapId { __device__ __forceinline__ int operator()(int n) const { return n; } };
struct MapQKV { __device__ __forceinline__ int operator()(int n) const { const int gt = n >> 11, head = (n >> 7) & 15, d = n & 127; return (gt * 8 + (head >> 1)) * 256 + 128 * (d >> 6) + 64 * (head & 1) + (d & 63); } };
struct MapGU { int which; __device__ __forceinline__ int operator()(int n) const { return 256 * (n >> 7) + 128 * which + (n & 127); } };
template <class Map> __device__ __forceinline__ void cvt_matrix(const float* W, int K, int N, bf16* WT, size_t ldt, Map map, int& it0, int gw, int NGW, int lane) {
    const int nblk = N / 32, items = (K / 64) * nblk;
    int it = gw - it0; if (it < 0) it += ((-it + NGW - 1) / NGW) * NGW;
    for (; it < items; it += 2 * NGW) { const int it2 = it + NGW; const bool two = it2 < items;
        const int kb = it / nblk, nb = it - kb * nblk, kb2 = two ? it2 / nblk : kb, nb2 = two ? it2 - kb2 * nblk : nb;
        const int q8 = lane >> 3, n8 = lane & 7;
        const float* sa = W + (size_t)(64 * kb + 8 * q8) * N + 32 * nb + 4 * n8; const float* sb = W + (size_t)(64 * kb2 + 8 * q8) * N + 32 * nb2 + 4 * n8;
        f32x4 va[8], vb[8];
#pragma unroll
        for (int j = 0; j < 8; ++j) va[j] = *(const f32x4*)(sa + (size_t)j * N);
#pragma unroll
        for (int j = 0; j < 8; ++j) vb[j] = *(const f32x4*)(sb + (size_t)j * N);
        const int da = map(32 * nb), db = map(32 * nb2);
#pragma unroll
        for (int jn = 0; jn < 4; ++jn) { u32x4 o; o.x = cvt_pk_bf16(va[0][jn], va[1][jn]); o.y = cvt_pk_bf16(va[2][jn], va[3][jn]); o.z = cvt_pk_bf16(va[4][jn], va[5][jn]); o.w = cvt_pk_bf16(va[6][jn], va[7][jn]);
            *(u32x4*)(WT + (size_t)(da + 4 * n8 + jn) * ldt + 64 * kb + 8 * q8) = o; }
        if (two) {
#pragma unroll
            for (int jn = 0; jn < 4; ++jn) { u32x4 o; o.x = cvt_pk_bf16(vb[0][jn], vb[1][jn]); o.y = cvt_pk_bf16(vb[2][jn], vb[3][jn]); o.z = cvt_pk_bf16(vb[4][jn], vb[5][jn]); o.w = cvt_pk_bf16(vb[6][jn], vb[7][jn]);
                *(u32x4*)(WT + (size_t)(db + 4 * n8 + jn) * ldt + 64 * kb2 + 8 * q8) = o; } }
    }
    it0 = (it0 + items) % NGW;
}
__device__ __forceinline__ void cvt_flat(const float* s, bf16* d, size_t n, int gw, int NGW, int lane) {
    for (size_t i = ((size_t)gw * 64 + lane) * 8; i < n; i += (size_t)NGW * 64 * 8) { const f32x4 a = *(const f32x4*)(s + i), b = *(const f32x4*)(s + i + 4);
        u32x4 o; o.x = cvt_pk_bf16(a[0], a[1]); o.y = cvt_pk_bf16(a[2], a[3]); o.z = cvt_pk_bf16(b[0], b[1]); o.w = cvt_pk_bf16(b[2], b[3]); *(u32x4*)(d + i) = o; }
}

__device__ __forceinline__ void p0_prologue(Frame& F, const Args& a) {
    const int gw = F.vcu * 8 + F.wave, NGW = F.G * 8, lane = F.lane; unsigned char* ws = F.ws; int it0 = 0;
    cvt_matrix(a.in[2], D, NQKV, (bf16*)(ws + WS_WQKV), D, MapQKV{}, it0, gw, NGW, lane);
    cvt_matrix(a.in[3], D, D, (bf16*)(ws + WS_WO), D, MapId{}, it0, gw, NGW, lane);
    cvt_matrix(a.in[12], D, FF, (bf16*)(ws + WS_W13), D, MapGU{0}, it0, gw, NGW, lane);
    cvt_matrix(a.in[13], D, FF, (bf16*)(ws + WS_W13), D, MapGU{1}, it0, gw, NGW, lane);
    cvt_matrix(a.in[14], FF, D, (bf16*)(ws + WS_W2), FF, MapId{}, it0, gw, NGW, lane);
    cvt_matrix(a.in[20], D, D, (bf16*)(ws + WS_WGATE), D, MapId{}, it0, gw, NGW, lane);
    cvt_matrix(a.in[20] + (size_t)D * D, D, D, (bf16*)(ws + WS_WGATE) + (size_t)D * D, D, MapId{}, it0, gw, NGW, lane);
    cvt_matrix(a.in[19], PLE, D, (bf16*)(ws + WS_WPROJ), PLE, MapId{}, it0, gw, NGW, lane);
    cvt_matrix(a.in[19] + (size_t)PLE * D, PLE, D, (bf16*)(ws + WS_WPROJ) + (size_t)D * PLE, PLE, MapId{}, it0, gw, NGW, lane);
    cvt_matrix(a.in[4], D, D, (bf16*)(ws + WS_WIN), D, MapId{}, it0, gw, NGW, lane);
    cvt_matrix(a.in[7], D, D, (bf16*)(ws + WS_WO2), D, MapId{}, it0, gw, NGW, lane);
    { const float* wg = a.in[5]; const float* sc = a.in[6]; bf16* o = (bf16*)(ws + WS_WGS);
      for (size_t i = ((size_t)gw * 64 + lane) * 8; i < (size_t)4 * 512 * 512; i += (size_t)NGW * 64 * 8) { const int g = (int)(i >> 18), d = (int)(i & 511);
          const f32x4 x0 = *(const f32x4*)(wg + i), x1 = *(const f32x4*)(wg + i + 4), s0 = *(const f32x4*)(sc + g * 512 + d), s1 = *(const f32x4*)(sc + g * 512 + d + 4);
          const f32x4 y0 = x0 * s0, y1 = x1 * s1; u32x4 w; w.x = cvt_pk_bf16(y0[0], y0[1]); w.y = cvt_pk_bf16(y0[2], y0[3]); w.z = cvt_pk_bf16(y1[0], y1[1]); w.w = cvt_pk_bf16(y1[2], y1[3]); *(u32x4*)(o + i) = w; } }
    cvt_flat(a.in[0], (bf16*)(ws + WS_XB0), (size_t)MTOK * D, gw, NGW, lane);
    cvt_flat(a.in[1], (bf16*)(ws + WS_PB), (size_t)2 * MTOK * PLE, gw, NGW, lane);
    { float* ct = (float*)(ws + WS_ROPE); float* st = ct + SEQ * 64;
      for (int i = gw * 64 + lane; i < SEQ * 64; i += NGW * 64) { const int pos = i >> 6, j = i & 63;
          const double inv = exp2(-(double)j * (13.287712379549449 / 64.0));
          const double ang = (double)pos * inv; ct[i] = (float)cos(ang); st[i] = (float)sin(ang); } }
}

__device__ __forceinline__ void attn_load_block(const bf16* hp, int blk, LAS unsigned char* slot, bool isV, int w, int lane) {
#pragma unroll
    for (int i = 0; i < 4; ++i) {
        const int idx = i * 8 + w, row = idx * 4 + (lane >> 4), cs = lane & 15;
        const int c = cs ^ (isV ? (((row & 3) << 2) | ((row >> 2) & 3)) : (row & 7));
        const bf16* rp = hp + (size_t)(128 * blk + row) * 128 + c * 8;
        __builtin_amdgcn_global_load_lds((const unsigned*)rp, (LAS unsigned*)(slot + idx * 1024), 16, 0, 0);
    }
}
__device__ __forceinline__ void attn_phase(Frame& F) {
    const bf16* QKV = (const bf16*)(F.ws + WS_QKV); bf16* OG = (bf16*)(F.ws + WS_OG); float* LSE = (float*)(F.ws + WS_LSE);
    LAS unsigned char* Kl = F.lds; LAS unsigned char* Vl = F.lds + 98304;
    volatile LAS unsigned* MISCw = (volatile LAS unsigned*)(F.lds + MISC_OFF);
    const unsigned keep0 = MISCw[8], keep1 = MISCw[9];
    const int w = F.wave, lane = F.lane, q16 = lane & 15, g4 = lane >> 4, sw = ((g4 & 1) << 1) | (g4 >> 1);
    const int pi16 = (q16 & 3) | ((q16 & 4) << 1) | ((q16 & 8) >> 1);
    const int qq = q16 >> 2, pp = q16 & 3;
    bf16x8 bqn[4];
#pragma unroll
    for (int ks = 0; ks < 4; ++ks) bqn[ks] = (bf16x8){0, 0, 0, 0, 0, 0, 0, 0};
    __syncthreads();
    for (int i = F.tid; i < LDS_BYTES / 16; i += 512) *(LAS u32x4*)(F.lds + i * 16) = (u32x4){0u, 0u, 0u, 0u};
    for (int p = F.vcu; p < 768; p += F.G) {
        const int b = 3 - p / 192, pr = p % 192, g = pr >> 6, h = (pr & 63) >> 2, qs = pr & 3;
        const int dsh = 2 * g, dil = 1 << dsh, nb = 32 >> dsh;
        const bf16* planeQ = QKV + ((size_t)((g * 3 + 0) * 16 + h) * MTOK) * 128; const bf16* planeK = planeQ + (size_t)16 * MTOK * 128; const bf16* planeV = planeK + (size_t)16 * MTOK * 128;
        for (int u = 0; u < 8; ++u) {
            int r, n;
            if (g == 0) { r = 0; n = qs * 8 + u; } else if (g == 1) { r = qs; n = u; } else { r = qs * 4 + (u >> 1); n = u & 1; }
            const bool first = (u == 0) || (n == 0), cont = (u < 7) && (n + 1 < nb);
            const size_t tok0 = (size_t)b * SEQ + r; const size_t crow = (size_t)b * SEQ + (size_t)r * (SEQ >> dsh);
            const bf16* hQ = planeQ + crow * 128; const bf16* hK = planeK + crow * 128; const bf16* hV = planeV + crow * 128;
            const int par = n & 1, k3 = n % 3, kp3 = (n + 2) % 3, kn3 = (n + 1) % 3;
            const size_t qtok = tok0 + (size_t)(128 * n + 16 * w + q16) * dil;
            bf16x8 bq[4];
            if (first) {
                __syncthreads();
                attn_load_block(hK, n, Kl + k3 * 32768, false, w, lane);
                attn_load_block(hV, n, Vl + par * 32768, true, w, lane);
                if (n > 0) { attn_load_block(hK, n - 1, Kl + kp3 * 32768, false, w, lane);
                             attn_load_block(hV, n - 1, Vl + (par ^ 1) * 32768, true, w, lane); }
#pragma unroll
                for (int ks = 0; ks < 4; ++ks) bq[ks] = *(const bf16x8*)(hQ + (size_t)(128 * n + 16 * w + q16) * 128 + 32 * ks + 8 * g4);
            } else {
#pragma unroll
                for (int ks = 0; ks < 4; ++ks) bq[ks] = bqn[ks];
            }
            if (first) asm volatile("s_waitcnt vmcnt(0)" ::: "memory"); else asm volatile("s_waitcnt vmcnt(4)" ::: "memory");
            __syncthreads();
            if (!first) attn_load_block(hV, n, Vl + par * 32768, true, w, lane);
            if (cont) attn_load_block(hK, n + 1, Kl + kn3 * 32768, false, w, lane);
            f32x4 s[9];
            {
                bf16x8 ka[2][4];
#define ATT_LDK(buf, ti_) do { const int _kt = w + (ti_); const int _row = ((_kt >> 3) ? k3 : kp3) * 128 + (_kt & 7) * 16 + pi16; \
                    _Pragma("unroll") for (int _ks = 0; _ks < 4; ++_ks) ka[buf][_ks] = *(const LAS bf16x8*)(Kl + _row * 256 + (((4 * _ks + g4) ^ (_row & 7)) << 4)); } while (0)
                ATT_LDK(0, 0);
#pragma unroll
                for (int ti = 0; ti < 9; ++ti) {
                    if (ti < 8) ATT_LDK((ti + 1) & 1, ti + 1);
                    __builtin_amdgcn_sched_barrier(0);
                    f32x4 acc = (f32x4){0.f, 0.f, 0.f, 0.f};
#pragma unroll
                    for (int ks = 0; ks < 4; ++ks) acc = __builtin_amdgcn_mfma_f32_16x16x32_bf16(ka[ti & 1][ks], bq[ks], acc, 0, 0, 0);
                    s[ti] = acc;
                }
#undef ATT_LDK
            }
            const float C2 = 0.08838834764831845f * 1.4426950408889634f; const float NEG = -__builtin_inff();
            float mx = NEG;
#pragma unroll
            for (int ti = 0; ti < 9; ++ti) {
                const bool tile_ok = (n > 0 || w + ti >= 8);
#pragma unroll
                for (int i = 0; i < 4; ++i) { const int kk = 4 * sw + i; bool ok = tile_ok;
                    if (ti == 0) ok = ok && (kk >= q16);
                    if (ti == 8) ok = ok && (kk <= q16);
                    const float v = ok ? s[ti][i] * C2 : NEG; s[ti][i] = v; mx = fmaxf(mx, v); }
            }
            mx = fmaxf(mx, __shfl_xor(mx, 16)); mx = fmaxf(mx, __shfl_xor(mx, 32));
            float l = 0.f;
#pragma unroll
            for (int ti = 0; ti < 9; ++ti)
#pragma unroll
                for (int i = 0; i < 4; ++i) { const float pv = __builtin_amdgcn_exp2f(s[ti][i] - mx); s[ti][i] = pv; l += pv; }
            l += __shfl_xor(l, 16); l += __shfl_xor(l, 32);
            bf16x8 pf[5];
#pragma unroll
            for (int uu = 0; uu < 5; ++uu) { u32x4 wv; wv.x = cvt_pk_bf16(s[2 * uu][0], s[2 * uu][1]); wv.y = cvt_pk_bf16(s[2 * uu][2], s[2 * uu][3]);
                if (uu < 4) { wv.z = cvt_pk_bf16(s[2 * uu + 1][0], s[2 * uu + 1][1]); wv.w = cvt_pk_bf16(s[2 * uu + 1][2], s[2 * uu + 1][3]); } else { wv.z = 0u; wv.w = 0u; }
                pf[uu] = __builtin_bit_cast(bf16x8, wv); }
            if (cont) asm volatile("s_waitcnt vmcnt(4)" ::: "memory"); else asm volatile("s_waitcnt vmcnt(0)" ::: "memory");
            __syncthreads();
            if (cont) {
#pragma unroll
                for (int ks = 0; ks < 4; ++ks) bqn[ks] = *(const bf16x8*)(hQ + (size_t)(128 * (n + 1) + 16 * w + q16) * 128 + 32 * ks + 8 * g4);
            }
            const float rl = 1.0f / l;
            const size_t orow = (size_t)g * MTOK * D + qtok * D + h * 128;
            {
                s16x4 va[2][9];
#define ATT_TRV(r_, ch_) __builtin_bit_cast(s16x4, __builtin_amdgcn_ds_read_tr16_b64_v4i16((LAS s16x4*)(Vl + 256 * (r_) + 16 * ((ch_) ^ ((((r_) & 3) << 2) | (((r_) >> 2) & 3))) + 8 * (pp & 1))))
#define ATT_LDV(buf, dt_) do { const int _ch = 2 * (dt_) + (pp >> 1); \
                    _Pragma("unroll") for (int _u = 0; _u < 5; ++_u) { const int _kt0 = w + 2 * _u; const int _r0 = (par ^ 1 ^ (_kt0 >> 3)) * 128 + (_kt0 & 7) * 16 + 4 * sw + qq; va[buf][_u] = ATT_TRV(_r0, _ch); \
                        if (_u < 4) { const int _kt1 = _kt0 + 1; const int _r1 = (par ^ 1 ^ (_kt1 >> 3)) * 128 + (_kt1 & 7) * 16 + 4 * sw + qq; va[buf][5 + _u] = ATT_TRV(_r1, _ch); } } } while (0)
                ATT_LDV(0, 0);
#pragma unroll
                for (int dt = 0; dt < 8; ++dt) {
                    if (dt < 7) ATT_LDV((dt + 1) & 1, dt + 1);
                    __builtin_amdgcn_sched_barrier(0);
                    f32x4 o = (f32x4){0.f, 0.f, 0.f, 0.f};
#pragma unroll
                    for (int uu = 0; uu < 5; ++uu) { const s16x4 lo = va[dt & 1][uu]; const s16x4 hi = (uu < 4) ? va[dt & 1][5 + uu] : (s16x4){0, 0, 0, 0};
                        bf16x8 av; av[0] = lo[0]; av[1] = lo[1]; av[2] = lo[2]; av[3] = lo[3]; av[4] = hi[0]; av[5] = hi[1]; av[6] = hi[2]; av[7] = hi[3];
                        o = __builtin_amdgcn_mfma_f32_16x16x32_bf16(av, pf[uu], o, 0, 0, 0); }
                    o = o * rl;
                    u32x2 wv; wv.x = cvt_pk_bf16(o[0], o[1]); wv.y = cvt_pk_bf16(o[2], o[3]);
                    *(u32x2*)(OG + orow + 16 * dt + 4 * g4) = wv;
                }
#undef ATT_LDV
#undef ATT_TRV
            }
            if (g4 == 0) LSE[((size_t)g * MTOK + qtok) * NH + h] = mx * 0.6931471805599453f + __logf(l);
        }
    }
    __syncthreads();
    if (F.tid == 0) { MISCw[8] = keep0; MISCw[9] = keep1; }
    __syncthreads();
}

__device__ __forceinline__ void combine_phase(Frame& F, int gw, int NGW) {
    const bf16* OG = (const bf16*)(F.ws + WS_OG); const float* LSE = (const float*)(F.ws + WS_LSE); bf16* ATT = (bf16*)(F.ws + WS_ATT);
    const int lane = F.lane;
    for (int m = gw; m < MTOK; m += NGW) {
#pragma unroll
        for (int j = 0; j < 4; ++j) { const int c = lane + 64 * j, h = c >> 4;
            const float l0 = LSE[(size_t)m * NH + h], l1 = LSE[((size_t)MTOK + m) * NH + h], l2 = LSE[((size_t)2 * MTOK + m) * NH + h];
            const float mx = fmaxf(l0, fmaxf(l1, l2)); float w0 = __expf(l0 - mx), w1 = __expf(l1 - mx), w2 = __expf(l2 - mx); const float rs = 1.0f / (w0 + w1 + w2); w0 *= rs; w1 *= rs; w2 *= rs;
            const u32x4 a = *(const u32x4*)(OG + (size_t)m * D + c * 8), b = *(const u32x4*)(OG + ((size_t)MTOK + m) * D + c * 8), d = *(const u32x4*)(OG + ((size_t)2 * MTOK + m) * D + c * 8);
            u32x4 o;
#pragma unroll
            for (int e = 0; e < 4; ++e) { const float lo = w0 * bf_lo(a[e]) + w1 * bf_lo(b[e]) + w2 * bf_lo(d[e]), hi = w0 * bf_hi(a[e]) + w1 * bf_hi(b[e]) + w2 * bf_hi(d[e]); o[e] = cvt_pk_bf16(lo, hi); }
            *(u32x4*)(ATT + (size_t)m * D + c * 8) = o; }
    }
}
__device__ __forceinline__ void moe_convert_phase(Frame& F, const Args& a, int gw, int NGW) {
    const int lane = F.lane; int it0 = 0;
    bf16* W13 = (bf16*)(F.ws + WS_MW13); bf16* W2 = (bf16*)(F.ws + WS_MW2);
    for (int e = 0; e < NE; ++e) {
        cvt_matrix(a.in[16] + (size_t)e * D * FF, D, FF, W13 + (size_t)e * FF2 * D, D, MapGU{0}, it0, gw, NGW, lane);
        cvt_matrix(a.in[17] + (size_t)e * D * FF, D, FF, W13 + (size_t)e * FF2 * D, D, MapGU{1}, it0, gw, NGW, lane);
        cvt_matrix(a.in[18] + (size_t)e * FF * D, FF, D, W2 + (size_t)e * D * FF, FF, MapId{}, it0, gw, NGW, lane);
    }
}

__device__ __forceinline__ void ln_core(f32x4 (&v)[8], const f32x4 (&gg)[8], const f32x4 (&bb)[8]) {
    float s = 0.f;
#pragma unroll
    for (int j = 0; j < 8; ++j) s += (v[j][0] + v[j][1]) + (v[j][2] + v[j][3]);
    const float mean = wave_sum(s) * (1.f / D); float s2 = 0.f;
#pragma unroll
    for (int j = 0; j < 8; ++j) { v[j] = v[j] - mean; s2 += (v[j][0] * v[j][0] + v[j][1] * v[j][1]) + (v[j][2] * v[j][2] + v[j][3] * v[j][3]); }
    const float rstd = 1.0f / sqrtf(wave_sum(s2) * (1.f / D) + LN_EPS);
#pragma unroll
    for (int j = 0; j < 8; ++j) v[j] = v[j] * rstd * gg[j] + bb[j];
}
__device__ __forceinline__ void ln_store(const f32x4 (&v)[8], bf16* xb, int lane) {
#pragma unroll
    for (int j = 0; j < 8; ++j) { u32x2 w; w.x = cvt_pk_bf16(v[j][0], v[j][1]); w.y = cvt_pk_bf16(v[j][2], v[j][3]); *(u32x2*)(xb + 4 * lane + 256 * j) = w; }
}
__device__ __forceinline__ void ln_load_gb8(const float* gam, const float* bet, f32x4 (&gg)[8], f32x4 (&bb)[8], int lane) {
#pragma unroll
    for (int j = 0; j < 4; ++j) { const int c = (lane + 64 * j) * 8; gg[2 * j] = *(const f32x4*)(gam + c); gg[2 * j + 1] = *(const f32x4*)(gam + c + 4); bb[2 * j] = *(const f32x4*)(bet + c); bb[2 * j + 1] = *(const f32x4*)(bet + c + 4); }
}
__device__ __forceinline__ void ln_store8(const f32x4 (&v)[8], bf16* xb, int lane) {
#pragma unroll
    for (int j = 0; j < 4; ++j) { u32x4 w; w.x = cvt_pk_bf16(v[2 * j][0], v[2 * j][1]); w.y = cvt_pk_bf16(v[2 * j][2], v[2 * j][3]); w.z = cvt_pk_bf16(v[2 * j + 1][0], v[2 * j + 1][1]); w.w = cvt_pk_bf16(v[2 * j + 1][2], v[2 * j + 1][3]);
        *(u32x4*)(xb + (lane + 64 * j) * 8) = w; }
}
__device__ __forceinline__ void ln_unpack8(const u32x4 (&w)[4], f32x4 (&v)[8]) {
#pragma unroll
    for (int j = 0; j < 4; ++j) { v[2 * j] = (f32x4){bf_lo(w[j].x), bf_hi(w[j].x), bf_lo(w[j].y), bf_hi(w[j].y)}; v[2 * j + 1] = (f32x4){bf_lo(w[j].z), bf_hi(w[j].z), bf_lo(w[j].w), bf_hi(w[j].w)}; }
}
__device__ __forceinline__ void ln_phase(Frame& F, const bf16* YB, const float* gam, const float* bet, bf16* XB) {
    const int gw = F.vcu * 8 + F.wave, NGW = F.G * 8, lane = F.lane;
    f32x4 gg[8], bb[8]; ln_load_gb8(gam, bet, gg, bb, lane);
    for (int m = gw; m < MTOK; m += 2 * NGW) {
        const int m2 = m + NGW; const bool has2 = m2 < MTOK;
        u32x4 wa[4], wb[4];
#pragma unroll
        for (int j = 0; j < 4; ++j) wa[j] = *(const u32x4*)(YB + (size_t)m * D + (lane + 64 * j) * 8);
#pragma unroll
        for (int j = 0; j < 4; ++j) wb[j] = *(const u32x4*)(YB + (size_t)(has2 ? m2 : m) * D + (lane + 64 * j) * 8);
        f32x4 v[8];
        ln_unpack8(wa, v); ln_core(v, gg, bb); ln_store8(v, XB + (size_t)m * D, lane);
        if (has2) { ln_unpack8(wb, v); ln_core(v, gg, bb); ln_store8(v, XB + (size_t)m2 * D, lane); }
    }
}
template <int J> __device__ __forceinline__ void pool_chunk8(const bf16* U, bf16* MIX, int m0, int t0, int lane) {
    constexpr int W = 2 << J, NR = W + 7;
    const int c = lane + 64 * J;
    u32x4 x[NR];
#pragma unroll
    for (int i = 0; i < NR; ++i) { const int dt = i - (W - 1); x[i] = *(const u32x4*)(U + (size_t)(m0 + ((t0 + dt >= 0) ? dt : 0)) * D + c * 8); }
    float sum[8];
#pragma unroll
    for (int e = 0; e < 8; ++e) sum[e] = 0.f;
#pragma unroll
    for (int i = 0; i < W - 1; ++i) { const float k = (t0 + i - (W - 1) >= 0) ? 1.f : 0.f;
#pragma unroll
        for (int e = 0; e < 4; ++e) { sum[2 * e] += k * bf_lo(x[i][e]); sum[2 * e + 1] += k * bf_hi(x[i][e]); } }
#pragma unroll
    for (int rr = 0; rr < 8; ++rr) {
        const int t = t0 + rr; const u32x4 cur = x[W - 1 + rr];
#pragma unroll
        for (int e = 0; e < 4; ++e) { sum[2 * e] += bf_lo(cur[e]); sum[2 * e + 1] += bf_hi(cur[e]); }
        const int cnt = (t + 1 < W) ? t + 1 : W; const float rc = 1.0f / (float)cnt; u32x4 o;
#pragma unroll
        for (int e = 0; e < 4; ++e) o[e] = cvt_pk_bf16(sum[2 * e] * rc - bf_lo(cur[e]), sum[2 * e + 1] * rc - bf_hi(cur[e]));
        *(u32x4*)(MIX + (size_t)(m0 + rr) * D + c * 8) = o;
        const float k = (t - (W - 1) >= 0) ? 1.f : 0.f;
#pragma unroll
        for (int e = 0; e < 4; ++e) { sum[2 * e] -= k * bf_lo(x[rr][e]); sum[2 * e + 1] -= k * bf_hi(x[rr][e]); }
    }
}
__device__ __forceinline__ void pool_phase(Frame& F) {
    const bf16* U = (const bf16*)(F.ws + WS_U); bf16* MIX = (bf16*)(F.ws + WS_MIX);
    const int gw = F.vcu * 8 + F.wave, NGW = F.G * 8, lane = F.lane;
    for (int m0 = gw * 8; m0 < MTOK; m0 += NGW * 8) { const int t0 = m0 & (SEQ - 1);
        pool_chunk8<0>(U, MIX, m0, t0, lane); pool_chunk8<1>(U, MIX, m0, t0, lane); pool_chunk8<2>(U, MIX, m0, t0, lane); pool_chunk8<3>(U, MIX, m0, t0, lane); }
}
__device__ __forceinline__ void ln_router_phase(Frame& F, const float* Y, const float* gam, const float* bet, const float* wrt, bf16* XB) {
    const int gw = F.vcu * 8 + F.wave, NGW = F.G * 8, lane = F.lane, tid = F.tid;
    LAS float* WR = (LAS float*)F.lds;
    LAS int* cntl = (LAS int*)(F.lds + 65536);
    LAS int* info = (LAS int*)(F.lds + 65536 + 64);
    int* LIST = (int*)(F.ws + WS_LIST); int* TOK = (int*)(F.ws + WS_TOK); unsigned* gcnt = (unsigned*)(F.ws + WS_CTL) + CW_CNT;
    __syncthreads();
    for (int i = tid; i < D * NE; i += 512) { const int c = i >> 3, e = i & 7; WR[e * D + c] = wrt[i]; }
    if (tid < 16) cntl[tid] = 0;
    __syncthreads();
    f32x4 gg[8], bb[8];
#pragma unroll
    for (int j = 0; j < 8; ++j) { gg[j] = *(const f32x4*)(gam + 4 * lane + 256 * j); bb[j] = *(const f32x4*)(bet + 4 * lane + 256 * j); }
    int k = 0;
    f32x4 vn[8];
#pragma unroll
    for (int j = 0; j < 8; ++j) vn[j] = *(const f32x4*)(Y + (size_t)(gw < MTOK ? gw : 0) * D + 4 * lane + 256 * j);
    for (int m = gw; m < MTOK; m += NGW, ++k) {
        f32x4 v[8];
#pragma unroll
        for (int j = 0; j < 8; ++j) v[j] = vn[j];
        { const int mn = (m + NGW < MTOK) ? m + NGW : m;
#pragma unroll
          for (int j = 0; j < 8; ++j) vn[j] = *(const f32x4*)(Y + (size_t)mn * D + 4 * lane + 256 * j); }
        ln_core(v, gg, bb); ln_store(v, XB + (size_t)m * D, lane);
        float lg[8];
#pragma unroll
        for (int e = 0; e < 8; ++e) { float s = 0.f;
#pragma unroll
            for (int j = 0; j < 8; ++j) { const f32x4 wv = *(const LAS f32x4*)(WR + e * D + 4 * lane + 256 * j); s += (v[j][0] * wv[0] + v[j][1] * wv[1]) + (v[j][2] * wv[2] + v[j][3] * wv[3]); }
            lg[e] = wave_sum(s); }
        int e1 = 0; float v1 = lg[0];
#pragma unroll
        for (int e = 1; e < 8; ++e) if (lg[e] > v1) { v1 = lg[e]; e1 = e; }
        int e2 = -1; float v2 = -__builtin_inff();
#pragma unroll
        for (int e = 0; e < 8; ++e) if (e != e1 && lg[e] > v2) { v2 = lg[e]; e2 = e; }
        if (lane == 0 && k < 8) { const float ex = __expf(v2 - v1), g1 = 1.0f / (1.0f + ex), g2 = ex * g1;
            const int ls1 = atomicAdd((int*)&cntl[e1], 1), ls2 = atomicAdd((int*)&cntl[e2], 1);
            LAS int* q = info + (F.wave * 8 + k) * 8; q[0] = m; q[1] = e1; q[2] = e2; q[3] = ls1; q[4] = ls2; q[5] = __float_as_int(g1); q[6] = __float_as_int(g2); }
    }
    const int nrows = k < 8 ? k : 8;
    if (lane == 0) info[512 + F.wave] = nrows;
    __syncthreads();
    if (tid < 8) cntl[8 + tid] = (int)__hip_atomic_fetch_add(gcnt + 64 * tid, (unsigned)cntl[tid], __ATOMIC_RELAXED, __HIP_MEMORY_SCOPE_AGENT);
    __syncthreads();
    if (tid < 64) { const int wv = tid >> 3, kk = tid & 7;
        if (kk < info[512 + wv]) { const LAS int* q = info + tid * 8; const int m = q[0], e1 = q[1], e2 = q[2], s1 = cntl[8 + e1] + q[3], s2 = cntl[8 + e2] + q[4];
            LIST[e1 * MTOK + s1] = m; LIST[e2 * MTOK + s2] = m;
            int* t = TOK + (size_t)m * 8; t[0] = e1; t[1] = s1; t[2] = q[5]; t[3] = e2; t[4] = s2; t[5] = q[6]; } }
    __syncthreads();
}
__device__ __forceinline__ void moe_prefix(Frame& F, int (&tb)[9], int (&cnt)[8]) {
    const unsigned* gcnt = (const unsigned*)(F.ws + WS_CTL) + CW_CNT; tb[0] = 0;
#pragma unroll
    for (int e = 0; e < 8; ++e) { cnt[e] = (int)__builtin_amdgcn_readfirstlane(gcnt[64 * e]); tb[e + 1] = tb[e] + ((cnt[e] + 255) >> 8); }
}
__device__ __forceinline__ void moe_fill_idx(Frame& F, const pg8::MoeOrder& S, const int (&tb)[9], const int (&cnt)[8]) {
    LAS unsigned short* idx = (LAS unsigned short*)(F.lds + pg8::IDX_LDS_OFF); const int* LIST = (const int*)(F.ws + WS_LIST);
    const int row = F.tid & 255, sub = F.tid >> 8;
    for (int ui = 0; ui < 30; ui += 2) {
        pg8::Unit u0; if (!S.next(ui, u0)) break;
        pg8::Unit u; const int uu = ui + sub;
        if (S.next(uu, u)) { int base = 0, ce = 0;
#pragma unroll
            for (int j = 0; j < 8; ++j) if (j == u.e) { base = tb[j]; ce = cnt[j]; }
            const int sidx = (u.pm - base) * 256 + row; const int tok = LIST[u.e * MTOK + (sidx < ce ? sidx : 0)];
            idx[uu * 256 + row] = (unsigned short)tok; }
    }
    __syncthreads();
}
__device__ __forceinline__ int gather_src(const int (&tb)[9], const int (&cnt)[8], const int* LIST, int rr) {
    const int tile = rr >> 8; int e = 0;
#pragma unroll
    for (int j = 1; j < 8; ++j) e += (tile >= tb[j]) ? 1 : 0;
    int base = 0, ce = 0;
#pragma unroll
    for (int j = 0; j < 8; ++j) if (j == e) { base = tb[j] * 256; ce = cnt[j]; }
    const int sidx = rr - base; return (sidx < ce) ? LIST[e * MTOK + sidx] : -1;
}
__device__ __forceinline__ void gather_phase(Frame& F) {
    const int gw = F.vcu * 8 + F.wave, NGW = F.G * 8, lane = F.lane;
    int tb[9], cnt[8]; moe_prefix(F, tb, cnt);
    const int* LIST = (const int*)(F.ws + WS_LIST); const bf16* XB = (const bf16*)(F.ws + WS_XB0); bf16* XG = (bf16*)(F.ws + WS_XG);
    const int rows = tb[8] * 256;
    for (int rr = gw; rr < rows; rr += 4 * NGW) {
        int tk[4];
#pragma unroll
        for (int k = 0; k < 4; ++k) { const int r = rr + k * NGW; tk[k] = (r < rows) ? gather_src(tb, cnt, LIST, r) : -2; }
        u32x4 v[4][4];
#pragma unroll
        for (int k = 0; k < 4; ++k)
#pragma unroll
            for (int j = 0; j < 4; ++j) v[k][j] = (tk[k] >= 0) ? *(const u32x4*)(XB + (size_t)tk[k] * D + (lane + 64 * j) * 8) : (u32x4){0u, 0u, 0u, 0u};
#pragma unroll
        for (int k = 0; k < 4; ++k) if (tk[k] != -2) {
#pragma unroll
            for (int j = 0; j < 4; ++j) *(u32x4*)(XG + (size_t)(rr + k * NGW) * D + (lane + 64 * j) * 8) = v[k][j]; }
    }
}
struct MoeRow { int r1, r2; float g1, g2; };
__device__ __forceinline__ MoeRow moe_row_info(const int* TOK, const int (&tb)[9], int m) {
    const int* t = TOK + (size_t)m * 8; const int e1 = t[0], s1 = t[1], e2 = t[3], s2 = t[4]; MoeRow r; r.g1 = __int_as_float(t[2]); r.g2 = __int_as_float(t[5]);
    int b1 = 0, b2 = 0;
#pragma unroll
    for (int j = 0; j < 8; ++j) { if (j == e1) b1 = tb[j] * 256; if (j == e2) b2 = tb[j] * 256; }
    r.r1 = b1 + s1; r.r2 = b2 + s2; return r;
}
__device__ __forceinline__ void ln_moe_phase(Frame& F, const bf16* X4, const float* gam, const float* bet, bf16* XB) {
    const int gw = F.vcu * 8 + F.wave, NGW = F.G * 8, lane = F.lane;
    int tb[9], cnt[8]; moe_prefix(F, tb, cnt);
    const int* TOK = (const int*)(F.ws + WS_TOK); const bf16* YE = (const bf16*)(F.ws + WS_XG); const bf16* YEP = (const bf16*)(F.ws + WS_YEP); constexpr size_t QSTR = (size_t)8 * 256 * D;
    const int split0 = (((8 * tb[8]) / F.G) * F.G >> 3) * 256;
    f32x4 gg[8], bb[8]; ln_load_gb8(gam, bet, gg, bb, lane);
    for (int m0 = gw; m0 < MTOK; m0 += 2 * NGW) {
        const bool has2 = (m0 + NGW) < MTOK; const int mm[2] = {m0, has2 ? m0 + NGW : m0};
        MoeRow ri[2]; ri[0] = moe_row_info(TOK, tb, mm[0]); ri[1] = moe_row_info(TOK, tb, mm[1]);
        u32x4 xw[2][4], aw[2][4], bw[2][4]; const bf16* y1[2]; const bf16* y2[2]; bool p1[2], p2[2];
#pragma unroll
        for (int q = 0; q < 2; ++q) { p1[q] = ri[q].r1 >= split0; p2[q] = ri[q].r2 >= split0;
            y1[q] = p1[q] ? YEP + (size_t)(ri[q].r1 - split0) * D : YE + (size_t)ri[q].r1 * D; y2[q] = p2[q] ? YEP + (size_t)(ri[q].r2 - split0) * D : YE + (size_t)ri[q].r2 * D;
#pragma unroll
            for (int j = 0; j < 4; ++j) { const int c = (lane + 64 * j) * 8; xw[q][j] = *(const u32x4*)(X4 + (size_t)mm[q] * D + c); aw[q][j] = *(const u32x4*)(y1[q] + c); bw[q][j] = *(const u32x4*)(y2[q] + c); } }
#pragma unroll
        for (int q = 0; q < 2; ++q) { if (q == 1 && !has2) break;
            const float g1 = ri[q].g1, g2 = ri[q].g2; f32x4 v[8];
#pragma unroll
            for (int j = 0; j < 4; ++j) { const int c = (lane + 64 * j) * 8; const u32x4 x = xw[q][j], a = aw[q][j], b = bw[q][j];
                float fa[8], fb[8];
#pragma unroll
                for (int e = 0; e < 4; ++e) { fa[2 * e] = bf_lo(a[e]); fa[2 * e + 1] = bf_hi(a[e]); fb[2 * e] = bf_lo(b[e]); fb[2 * e + 1] = bf_hi(b[e]); }
                if (p1[q]) {
#pragma unroll
                    for (int kq = 1; kq < 4; ++kq) { const u32x4 t4 = *(const u32x4*)(y1[q] + (size_t)kq * QSTR + c);
#pragma unroll
                        for (int e = 0; e < 4; ++e) { fa[2 * e] += bf_lo(t4[e]); fa[2 * e + 1] += bf_hi(t4[e]); } } }
                if (p2[q]) {
#pragma unroll
                    for (int kq = 1; kq < 4; ++kq) { const u32x4 t4 = *(const u32x4*)(y2[q] + (size_t)kq * QSTR + c);
#pragma unroll
                        for (int e = 0; e < 4; ++e) { fb[2 * e] += bf_lo(t4[e]); fb[2 * e + 1] += bf_hi(t4[e]); } } }
#pragma unroll
                for (int e = 0; e < 4; ++e) { const float lo = DN_ALPHA * bf_lo(x[e]) + g1 * fa[2 * e] + g2 * fb[2 * e], hi = DN_ALPHA * bf_hi(x[e]) + g1 * fa[2 * e + 1] + g2 * fb[2 * e + 1];
                    v[2 * j + (e >> 1)][(e & 1) * 2] = lo; v[2 * j + (e >> 1)][(e & 1) * 2 + 1] = hi; } }
            ln_core(v, gg, bb); ln_store8(v, XB + (size_t)mm[q] * D, lane);
        }
    }
}

constexpr int NPHASE = 19;
__global__ void __launch_bounds__(512, 2) fwd_kernel(Args args) {
    extern __shared__ __attribute__((aligned(16))) unsigned char lds[];
    Frame F; F.lds = (LAS unsigned char*)lds; F.tid = threadIdx.x; F.lane = F.tid & 63; F.wave = __builtin_amdgcn_readfirstlane(F.tid >> 6);
    F.G = gridDim.x; { const int bx = blockIdx.x; F.vcu = (F.G % 8 == 0) ? (bx % 8) * (F.G / 8) + bx / 8 : bx; }
    F.ws = args.ws; unsigned char* ws = args.ws;
    volatile LAS unsigned* MISC = (volatile LAS unsigned*)(F.lds + MISC_OFF);
    for (int u = F.tid; u < (LDS_BYTES - LDSCTL_OFF) / 4; u += 512) ((LAS unsigned*)(F.lds + LDSCTL_OFF))[u] = 0u;
    __syncthreads();
    XcdBarrier bar; bar.bar = (unsigned*)(ws + WS_CTL) + CW_BAR; bar.x = 0; bar.st = nullptr;
    if (args.ph_hi - args.ph_lo > 1) bar = xcd_barrier_post((unsigned*)(ws + WS_CTL) + CW_BAR, MISC + 8);
    const int lo = args.ph_lo, hi = args.ph_hi;
#define IN(k) (lo <= (k) && (k) < hi)
    long long pht0 = 0, pht1 = 0; if (PHT_SEL == 0) pht0 = wall_clock64();
#define SEAM(k) do { if (IN(k) && IN((k) + 1)) xcd_barrier(bar); if (PHT_SEL == (k) + 1) pht0 = wall_clock64(); if (PHT_SEL == (k)) pht1 = wall_clock64(); } while (0)
    LAS unsigned char* ring = F.lds;
    const int bx = (int)blockIdx.x;
    bf16* XB0 = (bf16*)(ws + WS_XB0); bf16* XB1 = (bf16*)(ws + WS_XB1); bf16* YB = (bf16*)(ws + WS_YB); float* Y = args.out;

    if (IN(0)) { p0_prologue(F, args); }
    if constexpr ((DUP_MASK >> 0) & 1u) { if (IN(0)) { p0_prologue(F, args); } }
    SEAM(0);
    if (IN(1)) {
        { pg8::Gemm g{XB0, (const bf16*)(ws + WS_WQKV), D, D, D}; pg8::StaticOrder S; S.init(MTOK, NQKV, F.G, bx);
          pg8::EpiQKV E{(bf16*)(ws + WS_QKV), (const float*)(ws + WS_ROPE)}; pg8::gemm_phase(ring, g, S, E); }
    }
    if constexpr ((DUP_MASK >> 1) & 1u) { if (IN(1)) {
        { pg8::Gemm g{XB0, (const bf16*)(ws + WS_WQKV), D, D, D}; pg8::StaticOrder S; S.init(MTOK, NQKV, F.G, bx);
          pg8::EpiQKV E{(bf16*)(ws + WS_QKV), (const float*)(ws + WS_ROPE)}; pg8::gemm_phase(ring, g, S, E); }
    } }
    SEAM(1);
    if (IN(2)) { attn_phase(F); }
    if constexpr ((DUP_MASK >> 2) & 1u) { if (IN(2)) { attn_phase(F); } }
    SEAM(2);
    if (IN(3)) {
        if ((F.vcu & 3) == 0) {
        { pg8::Gemm g{(const bf16*)(ws + WS_PB), (const bf16*)(ws + WS_WPROJ), PLE, PLE, PLE}; pg8::BatchOrder S; S.init(MTOK, D, 2, (size_t)MTOK * PLE, (size_t)D * PLE, F.G / 4, F.vcu >> 2);
          pg8::EpiBf16 E{(bf16*)(ws + WS_PPROJ), D, (size_t)MTOK * D, 0}; pg8::gemm_phase(ring, g, S, E); }
        {
          pg8::Gemm g{(const bf16*)(ws + WS_WO2), (const bf16*)(ws + WS_WGS), 512, D, 512}; pg8::BatchOrder S; S.init(D, 512, 4, (size_t)512, (size_t)512 * 512, F.G / 4, F.vcu >> 2);
          pg8::EpiBf16 E{(bf16*)(ws + WS_WCOMB), D, (size_t)0, 512}; pg8::gemm_phase(ring, g, S, E); }
        } else { const int r3 = F.vcu - (F.vcu >> 2) - 1;
            combine_phase(F, r3 * 8 + F.wave, (F.G - F.G / 4) * 8); moe_convert_phase(F, args, r3 * 8 + F.wave, (F.G - F.G / 4) * 8); }
    }
    SEAM(3);
    if (IN(4)) { pg8::Gemm g{(const bf16*)(ws + WS_ATT), (const bf16*)(ws + WS_WO), D, D, D}; pg8::StaticOrder S; S.init(MTOK, D, F.G, bx);
        pg8::EpiRes<false> E{XB0, YB, D, DN_ALPHA}; pg8::gemm_phase(ring, g, S, E); }
    if constexpr ((DUP_MASK >> 4) & 1u) { if (IN(4)) { pg8::Gemm g{(const bf16*)(ws + WS_ATT), (const bf16*)(ws + WS_WO), D, D, D}; pg8::StaticOrder S; S.init(MTOK, D, F.G, bx);
        pg8::EpiRes<false> E{XB0, YB, D, DN_ALPHA}; pg8::gemm_phase(ring, g, S, E); } }
    SEAM(4);
    if (IN(5)) { ln_phase(F, YB, args.in[8], args.in[9], XB0); }
    if constexpr ((DUP_MASK >> 5) & 1u) { if (IN(5)) { ln_phase(F, YB, args.in[8], args.in[9], XB0); } }
    SEAM(5);
    if (IN(6)) { pg8::Gemm g{XB0, (const bf16*)(ws + WS_W13), D, D, D}; pg8::StaticOrder S; S.init(MTOK, FF2, F.G, bx);
        pg8::EpiSwiGLU E{(bf16*)(ws + WS_H), FF}; pg8::gemm_phase<pg8::EpiSwiGLU, pg8::StaticOrder, true, true, (STAMP_SEL != 0)>(ring, g, S, E, (unsigned long long*)(ws + WS_CTL + 512 * 1024)); }
    if constexpr ((DUP_MASK >> 6) & 1u) { if (IN(6)) { pg8::Gemm g{XB0, (const bf16*)(ws + WS_W13), D, D, D}; pg8::StaticOrder S; S.init(MTOK, FF2, F.G, bx);
        pg8::EpiSwiGLU E{(bf16*)(ws + WS_H), FF}; pg8::gemm_phase(ring, g, S, E); } }
    SEAM(6);
    if (IN(7)) { pg8::Gemm g{(const bf16*)(ws + WS_H), (const bf16*)(ws + WS_W2), FF, FF, FF}; pg8::StaticOrder S; S.init(MTOK, D, F.G, bx);
        pg8::EpiRes<false> E{XB0, YB, D, DN_ALPHA}; pg8::gemm_phase(ring, g, S, E); }
    if constexpr ((DUP_MASK >> 7) & 1u) { if (IN(7)) { pg8::Gemm g{(const bf16*)(ws + WS_H), (const bf16*)(ws + WS_W2), FF, FF, FF}; pg8::StaticOrder S; S.init(MTOK, D, F.G, bx);
        pg8::EpiRes<false> E{XB0, YB, D, DN_ALPHA}; pg8::gemm_phase(ring, g, S, E); } }
    SEAM(7);
    if (IN(8)) { ln_phase(F, YB, args.in[10], args.in[11], XB0); }
    if constexpr ((DUP_MASK >> 8) & 1u) { if (IN(8)) { ln_phase(F, YB, args.in[10], args.in[11], XB0); } }
    SEAM(8);
    if (IN(9)) { pg8::Gemm g{XB0, (const bf16*)(ws + WS_WGATE), D, D, D}; pg8::StaticOrder S; S.init(MTOK, D, F.G, bx);
        pg8::EpiPle E{XB0, (const bf16*)(ws + WS_PPROJ), args.in[21], nullptr, XB1, D}; pg8::gemm_phase(ring, g, S, E); }
    if constexpr ((DUP_MASK >> 9) & 1u) { if (IN(9)) { pg8::Gemm g{XB0, (const bf16*)(ws + WS_WGATE), D, D, D}; pg8::StaticOrder S; S.init(MTOK, D, F.G, bx);
        pg8::EpiPle E{XB0, (const bf16*)(ws + WS_PPROJ), args.in[21], nullptr, XB1, D}; pg8::gemm_phase(ring, g, S, E); } }
    SEAM(9);
    if (IN(10)) { pg8::Gemm g{XB1, (const bf16*)(ws + WS_WIN), D, D, D}; pg8::StaticOrder S; S.init(MTOK, D, F.G, bx);
        pg8::EpiBf16 E{(bf16*)(ws + WS_U), D, (size_t)0, 0}; pg8::gemm_phase(ring, g, S, E); }
    if constexpr ((DUP_MASK >> 10) & 1u) { if (IN(10)) { pg8::Gemm g{XB1, (const bf16*)(ws + WS_WIN), D, D, D}; pg8::StaticOrder S; S.init(MTOK, D, F.G, bx);
        pg8::EpiBf16 E{(bf16*)(ws + WS_U), D, (size_t)0, 0}; pg8::gemm_phase(ring, g, S, E); } }
    SEAM(10);
    if (IN(11)) { pool_phase(F); }
    if constexpr ((DUP_MASK >> 11) & 1u) { if (IN(11)) { pool_phase(F); } }
    SEAM(11);
    if (IN(12)) { pg8::Gemm g{(const bf16*)(ws + WS_MIX), (const bf16*)(ws + WS_WCOMB), D, D, D}; pg8::StaticOrder S; S.init(MTOK, D, F.G, bx);
        pg8::EpiRes<true> E{XB1, Y, D, DN_ALPHA}; pg8::gemm_phase(ring, g, S, E); }
    if constexpr ((DUP_MASK >> 12) & 1u) { if (IN(12)) { pg8::Gemm g{(const bf16*)(ws + WS_MIX), (const bf16*)(ws + WS_WCOMB), D, D, D}; pg8::StaticOrder S; S.init(MTOK, D, F.G, bx);
        pg8::EpiRes<true> E{XB1, Y, D, DN_ALPHA}; pg8::gemm_phase(ring, g, S, E); } }
    SEAM(12);
    if (IN(13)) { ln_router_phase(F, Y, args.in[8] + D, args.in[9] + D, args.in[15], XB0); }
    if constexpr ((DUP_MASK >> 13) & 1u) { if (IN(13)) { ln_router_phase(F, Y, args.in[8] + D, args.in[9] + D, args.in[15], XB0); } }
    SEAM(13);
    if (PHT_SEL == 15) pht0 = wall_clock64();
    if (IN(15)) { int tb[9], cnt[8]; moe_prefix(F, tb, cnt);
        pg8::Gemm g{XB0, (const bf16*)(ws + WS_MW13), D, D, D}; pg8::MoeOrder S; S.nM = tb[8]; S.nN = FF2 / 256; S.nwg = S.nM * S.nN; S.G = F.G; S.c = bx; S.sB = (size_t)FF2 * D; S.gather = true;
#pragma unroll
        for (int j = 0; j < 9; ++j) S.tb[j] = tb[j];
        moe_fill_idx(F, S, tb, cnt);
        pg8::EpiSwiGLU E{(bf16*)(ws + WS_HM), FF}; pg8::gemm_phase<pg8::EpiSwiGLU, pg8::MoeOrder, true, true, false, true>(ring, g, S, E); }
    if constexpr ((DUP_MASK >> 15) & 1u) { if (IN(15)) { int tb[9], cnt[8]; moe_prefix(F, tb, cnt);
        pg8::Gemm g{XB0, (const bf16*)(ws + WS_MW13), D, D, D}; pg8::MoeOrder S; S.nM = tb[8]; S.nN = FF2 / 256; S.nwg = S.nM * S.nN; S.G = F.G; S.c = bx; S.sB = (size_t)FF2 * D; S.gather = true;
#pragma unroll
        for (int j = 0; j < 9; ++j) S.tb[j] = tb[j];
        moe_fill_idx(F, S, tb, cnt);
        pg8::EpiSwiGLU E{(bf16*)(ws + WS_HM), FF}; pg8::gemm_phase<pg8::EpiSwiGLU, pg8::MoeOrder, true, true, false, true>(ring, g, S, E); } }
    SEAM(15);
    if (IN(16)) { int tb[9], cnt[8]; moe_prefix(F, tb, cnt);
        pg8::Gemm g{(const bf16*)(ws + WS_HM), (const bf16*)(ws + WS_MW2), FF, FF, FF}; pg8::MoeDownOrder S; S.nM = tb[8]; S.G = F.G; S.c = F.vcu; S.nfull = ((8 * tb[8]) / F.G) * F.G; S.kq_elems = FF / 4; S.kq_nt = FF / 4 / 64; S.sB = (size_t)D * FF;
#pragma unroll
        for (int j = 0; j < 9; ++j) S.tb[j] = tb[j];
        pg8::EpiMoeDown E{(bf16*)(ws + WS_XG), (bf16*)(ws + WS_YEP), S.nfull >> 3, (size_t)8 * 256 * D}; pg8::gemm_phase(ring, g, S, E); }
    if constexpr ((DUP_MASK >> 16) & 1u) { if (IN(16)) { int tb[9], cnt[8]; moe_prefix(F, tb, cnt);
        pg8::Gemm g{(const bf16*)(ws + WS_HM), (const bf16*)(ws + WS_MW2), FF, FF, FF}; pg8::MoeDownOrder S; S.nM = tb[8]; S.G = F.G; S.c = F.vcu; S.nfull = ((8 * tb[8]) / F.G) * F.G; S.kq_elems = FF / 4; S.kq_nt = FF / 4 / 64; S.sB = (size_t)D * FF;
#pragma unroll
        for (int j = 0; j < 9; ++j) S.tb[j] = tb[j];
        pg8::EpiMoeDown E{(bf16*)(ws + WS_XG), (bf16*)(ws + WS_YEP), S.nfull >> 3, (size_t)8 * 256 * D}; pg8::gemm_phase(ring, g, S, E); } }
    SEAM(16);
    if (IN(17)) { ln_moe_phase(F, XB0, args.in[10] + D, args.in[11] + D, XB1); }
    if constexpr ((DUP_MASK >> 17) & 1u) { if (IN(17)) { ln_moe_phase(F, XB0, args.in[10] + D, args.in[11] + D, XB1); } }
    SEAM(17);
    if (IN(18)) { pg8::Gemm g{XB1, (const bf16*)(ws + WS_WGATE) + (size_t)D * D, D, D, D}; pg8::StaticOrder S; S.init(MTOK, D, F.G, bx);
        pg8::EpiPle E{XB1, (const bf16*)(ws + WS_PPROJ) + (size_t)MTOK * D, args.in[21] + D, args.out, nullptr, D}; pg8::gemm_phase(ring, g, S, E); }
    if constexpr ((DUP_MASK >> 18) & 1u) { if (IN(18)) { pg8::Gemm g{XB1, (const bf16*)(ws + WS_WGATE) + (size_t)D * D, D, D, D}; pg8::StaticOrder S; S.init(MTOK, D, F.G, bx);
        pg8::EpiPle E{XB1, (const bf16*)(ws + WS_PPROJ) + (size_t)MTOK * D, args.in[21] + D, args.out, nullptr, D}; pg8::gemm_phase(ring, g, S, E); } }
    if (STAMP_SEL != 0 && blockIdx.x == 0 && F.tid == 0 && hi == NPHASE) { const unsigned long long us = ((volatile unsigned long long*)(ws + WS_CTL + 512 * 1024))[STAMP_SEL - 1]; const long long w0 = wall_clock64(); while ((unsigned long long)(wall_clock64() - w0) < us * 100ull) __builtin_amdgcn_s_sleep(32); }
    if (PHT_SEL >= 0 && blockIdx.x == 0 && F.tid == 0 && hi == NPHASE) { if (PHT_SEL == NPHASE - 1) pht1 = wall_clock64(); const long long w0 = wall_clock64(); while (wall_clock64() - w0 < PHT_MULT * (pht1 - pht0)) __builtin_amdgcn_s_sleep(32); }
#undef IN
#undef SEAM
}

extern "C" void kernel_launch(void* const* d_in, const int* in_sizes, int n_in, void* d_out, int out_size, void* d_ws, size_t ws_size, hipStream_t stream) {
    static int grid = 0; static bool one_launch = true;
    if (grid == 0) {
        if (n_in != 22 || out_size != MTOK * D || ws_size < WS_END) { fprintf(stderr, "kernel_launch: unexpected shapes (n_in %d, out %d, ws %zu < %zu)\n", n_in, out_size, ws_size, (size_t)WS_END); grid = -1; return; }
        int dev = 0, cus = 0, per_cu = 0;
        if (hipGetDevice(&dev) != hipSuccess || hipDeviceGetAttribute(&cus, hipDeviceAttributeMultiprocessorCount, dev) != hipSuccess) { grid = -1; return; }
        if (hipFuncSetAttribute((const void*)fwd_kernel, hipFuncAttributeMaxDynamicSharedMemorySize, LDS_BYTES) != hipSuccess) { fprintf(stderr, "kernel_launch: hipFuncSetAttribute failed\n"); grid = -1; return; }
        if (hipOccupancyMaxActiveBlocksPerMultiprocessor(&per_cu, (const void*)fwd_kernel, 512, LDS_BYTES) != hipSuccess || per_cu < 1) { fprintf(stderr, "kernel_launch: occupancy query says %d blocks per CU\n", per_cu); }
        (void)hipGetLastError();
        grid = 256;
        one_launch = (cus >= 256);
    }
    if (grid < 0) return;
    (void)hipMemsetAsync((char*)d_ws + WS_CTL, 0, CTL_ZERO_BYTES, stream);
    Args a{};
    for (int i = 0; i < 22; ++i) a.in[i] = (const float*)d_in[i];
    a.out = (float*)d_out; a.ws = (unsigned char*)d_ws;
    if (MK_PER_PHASE || !one_launch) { for (int p = 0; p < NPHASE; ++p) { a.ph_lo = p; a.ph_hi = p + 1; hipLaunchKernelGGL(fwd_kernel, dim3(grid), dim3(512), LDS_BYTES, stream, a); } }
    else { a.ph_lo = 0; a.ph_hi = NPHASE; hipLaunchKernelGGL(fwd_kernel, dim3(grid), dim3(512), LDS_BYTES, stream, a); }
}
```

```cpp
#include <hip/hip_runtime.h>
#include <cstdio>
#include <cstdint>

#ifndef MK_PER_PHASE
#define MK_PER_PHASE 0
#endif
#ifndef STAMP_SEL
#define STAMP_SEL 0
#endif
#ifndef PHT_SEL
#define PHT_SEL -1
#endif
#define PHT_MULT 4
#ifndef DUP_MASK
#define DUP_MASK 0u
#endif

#define LAS __attribute__((address_space(3)))
#define GAS __attribute__((address_space(1)))
typedef unsigned short bf16;
typedef short bf16x8 __attribute__((ext_vector_type(8)));
typedef short s16x4 __attribute__((ext_vector_type(4)));
typedef float f32x4 __attribute__((ext_vector_type(4)));
typedef float f32x2 __attribute__((ext_vector_type(2)));
typedef unsigned u32x4 __attribute__((ext_vector_type(4)));
typedef unsigned u32x2 __attribute__((ext_vector_type(2)));
typedef GAS unsigned gu32;

constexpr int D = 2048, BATCH = 4, SEQ = 4096, MTOK = BATCH * SEQ;
constexpr int NH = 16, HD = 128, NQKV = 3 * 3 * D;
constexpr int FF = 5632, FF2 = 2 * FF;
constexpr int NE = 8, PLE = 256;
constexpr float LN_EPS = 1e-5f;
constexpr float DN_ALPHA = 1.41421356237309515f;
constexpr int MOE_ROWS = 2 * MTOK + NE * 256;

constexpr size_t MiB = 1u << 20;
constexpr size_t WS_CTL = 0, CTL_ZERO_BYTES = 1 * MiB;
constexpr size_t WS_LIST = 1 * MiB;
constexpr size_t WS_TOK = 2 * MiB;
constexpr size_t WS_LSE = 3 * MiB;
constexpr size_t WS_ROPE = 6 * MiB;
constexpr size_t WS_WGATE = 8 * MiB;
constexpr size_t WS_WPROJ = 24 * MiB;
constexpr size_t WS_WIN = 26 * MiB;
constexpr size_t WS_WCOMB = 34 * MiB;
constexpr size_t WS_WO2 = 42 * MiB;
constexpr size_t WS_WGS = 50 * MiB;
constexpr size_t WS_PB = 52 * MiB;
constexpr size_t WS_PPROJ = 68 * MiB;
constexpr size_t WS_XB0 = 196 * MiB;
constexpr size_t WS_YB = 260 * MiB;
constexpr size_t WS_WQKV = 516 * MiB;
constexpr size_t WS_WO = 588 * MiB;
constexpr size_t WS_W13 = 596 * MiB;
constexpr size_t WS_W2 = 640 * MiB;
constexpr size_t WS_QKV = 662 * MiB;
constexpr size_t WS_OG = 1238 * MiB;
constexpr size_t WS_ATT = 1430 * MiB;
constexpr size_t WS_MW13 = 662 * MiB;
constexpr size_t WS_MW2 = 1014 * MiB;
constexpr size_t WS_H = 1238 * MiB;
constexpr size_t WS_XB1 = 1430 * MiB;
constexpr size_t WS_U = 1190 * MiB;
constexpr size_t WS_MIX = 1254 * MiB;
constexpr size_t WS_HM = 1190 * MiB;
constexpr size_t WS_XG = 516 * MiB;
constexpr size_t WS_YEP = 324 * MiB;
constexpr size_t WS_END = 1564 * MiB;
static_assert(WS_MW2 + (size_t)NE * D * FF * 2 <= WS_U && WS_HM + (size_t)MOE_ROWS * FF * 2 <= WS_END && WS_XG + (size_t)MOE_ROWS * D * 2 <= WS_QKV, "ws map");

constexpr int CW_CNT = 64;
constexpr int CW_BAR = 4096;

constexpr int RING_BYTES = 131072;
constexpr int LDSCTL_OFF = RING_BYTES, MISC_OFF = LDSCTL_OFF + 320;
constexpr int LDS_BYTES = 163840;

#define VM_WAIT() asm volatile("s_waitcnt vmcnt(0)" ::: "memory")
__device__ __forceinline__ unsigned cvt_pk_bf16(float lo, float hi) { unsigned r; asm volatile("v_cvt_pk_bf16_f32 %0, %1, %2" : "=v"(r) : "v"(lo), "v"(hi)); return r; }
__device__ __forceinline__ float bf_lo(unsigned w) { return __uint_as_float(w << 16); }
__device__ __forceinline__ float bf_hi(unsigned w) { return __uint_as_float(w & 0xffff0000u); }
__device__ __forceinline__ float wave_sum(float v) {
#pragma unroll
    for (int o = 1; o < 64; o <<= 1) v += __shfl_xor(v, o);
    return v;
}

namespace pg8 {
#define PG8_LAS __attribute__((address_space(3)))
typedef unsigned short bf16_t;
constexpr int BM = 256, BK = 64, HALF = 128, HTB = HALF * BK * 2, STAGE_BYTES = 8 * HTB, NXCD = 8, WGM = 8;

__host__ __device__ __forceinline__ int lds_byte(int r, int c) { const int st = (r >> 4) * 2 + (c >> 5), rr = r & 15, cc = c & 31, ob = rr * 64 + cc * 2; return st * 1024 + (ob ^ (((ob >> 9) & 1) << 5)); }
__host__ __device__ __forceinline__ void stage_rc(int b, int& R, int& C) { const int st = b / 1024, sb = b % 1024, swz = sb ^ (((sb >> 9) & 1) << 5); R = (st >> 1) * 16 + swz / 64; C = (st & 1) * 32 + (swz % 64) / 2; }
__host__ __device__ __forceinline__ int perm32(int rho) { const int n = rho >> 4, i = rho & 15; return 8 * (i >> 2) + 4 * n + (i & 3); }

struct Unit { int pm, pn, e; };
struct Gemm { const bf16_t* A; const bf16_t* Bt; int K, lda, ldb; };

__device__ __forceinline__ void tile_of(int wgid, int nM, int nN, int& pm, int& pn) {
    const int nwg = nM * nN;
    { const int q = nwg / NXCD, r = nwg % NXCD, xcd = wgid % NXCD, off = wgid / NXCD; wgid = (xcd < r ? xcd * (q + 1) : r * (q + 1) + (xcd - r) * q) + off; }
    const int nig = WGM * nN, gid = wgid / nig, fm = gid * WGM, gsz = (nM - fm) < WGM ? (nM - fm) : WGM;
    pm = fm + ((wgid % nig) % gsz); pn = (wgid % nig) / gsz;
}
struct StaticOrder {
    int nM, nN, nwg, G, c;
    __device__ __forceinline__ void init(int M, int N, int G_, int c_) { nM = M / BM; nN = N / BM; nwg = nM * nN; G = G_; c = c_; }
    __device__ __forceinline__ bool next(int i, Unit& u) const {
        const long L = (long)i * G + c; if (L >= nwg) return false;
        tile_of((int)L, nM, nN, u.pm, u.pn); u.e = 0; return true;
    }
    __device__ __forceinline__ const char* a_ptr(const Gemm& g, const Unit& u) const { return (const char*)g.A + (size_t)u.pm * BM * g.lda * 2; }
    __device__ __forceinline__ const char* b_ptr(const Gemm& g, const Unit& u) const { return (const char*)g.Bt + (size_t)u.pn * BM * g.ldb * 2; }
    __device__ __forceinline__ int unit_nt(const Gemm& g, const Unit&) const { return g.K / BK; }
    __device__ __forceinline__ void after_unit(int) const {}
};
struct BatchOrder {
    int nM, nN, nwg, nb, G, c; size_t sA, sB;
    __device__ __forceinline__ void init(int M, int N, int nb_, size_t sA_, size_t sB_, int G_, int c_) { nM = M / BM; nN = N / BM; nwg = nM * nN; nb = nb_; sA = sA_; sB = sB_; G = G_; c = c_; }
    __device__ __forceinline__ bool next(int i, Unit& u) const {
        const long L = (long)i * G + c; if (L >= (long)nwg * nb) return false;
        u.e = (int)(L / nwg); tile_of((int)(L % nwg), nM, nN, u.pm, u.pn); return true;
    }
    __device__ __forceinline__ const char* a_ptr(const Gemm& g, const Unit& u) const { return (const char*)(g.A + (size_t)u.e * sA) + (size_t)u.pm * BM * g.lda * 2; }
    __device__ __forceinline__ const char* b_ptr(const Gemm& g, const Unit& u) const { return (const char*)(g.Bt + (size_t)u.e * sB) + (size_t)u.pn * BM * g.ldb * 2; }
    __device__ __forceinline__ int unit_nt(const Gemm& g, const Unit&) const { return g.K / BK; }
    __device__ __forceinline__ void after_unit(int) const {}
};
struct MoeOrder {
    int nM, nN, nwg, G, c; size_t sB; int tb[9]; bool gather;
    __device__ __forceinline__ bool next(int i, Unit& u) const {
        const long L = (long)i * G + c; if (L >= nwg) return false;
        tile_of((int)L, nM, nN, u.pm, u.pn);
        int e = 0;
#pragma unroll
        for (int j = 1; j < 8; ++j) e += (u.pm >= tb[j]) ? 1 : 0;
        u.e = e; return true;
    }
    __device__ __forceinline__ const char* a_ptr(const Gemm& g, const Unit& u) const { return (const char*)g.A + (gather ? (size_t)0 : (size_t)u.pm * BM * g.lda * 2); }
    __device__ __forceinline__ const char* b_ptr(const Gemm& g, const Unit& u) const { return (const char*)(g.Bt + (size_t)u.e * sB) + (size_t)u.pn * BM * g.ldb * 2; }
    __device__ __forceinline__ int unit_nt(const Gemm& g, const Unit&) const { return g.K / BK; }
    __device__ __forceinline__ void after_unit(int) const {}
};

struct MoeDownOrder {
    int nM, G, c, nfull, kq_elems, kq_nt; size_t sB; int tb[9];
    __device__ __forceinline__ bool next(int i, Unit& u) const {
        const long L = (long)i * G + c; int kq1 = 0, uu;
        if (L < nfull) uu = (int)L;
        else { const long L2 = L - nfull; if (L2 >= 4l * (8 * nM - nfull)) return false; uu = nfull + (int)(L2 >> 2); kq1 = (int)(L2 & 3) + 1; }
        u.pm = uu >> 3; u.pn = uu & 7;
        int e = 0;
#pragma unroll
        for (int j = 1; j < 8; ++j) e += (u.pm >= tb[j]) ? 1 : 0;
        u.e = e | (kq1 << 8); return true;
    }
    __device__ __forceinline__ const char* a_ptr(const Gemm& g, const Unit& u) const { const int kq1 = u.e >> 8; return (const char*)g.A + ((size_t)u.pm * BM * g.lda + (size_t)(kq1 ? (kq1 - 1) * kq_elems : 0)) * 2; }
    __device__ __forceinline__ const char* b_ptr(const Gemm& g, const Unit& u) const { const int kq1 = u.e >> 8; return (const char*)(g.Bt + (size_t)(u.e & 255) * sB) + ((size_t)u.pn * BM * g.ldb + (size_t)(kq1 ? (kq1 - 1) * kq_elems : 0)) * 2; }
    __device__ __forceinline__ int unit_nt(const Gemm& g, const Unit& u) const { return (u.e >> 8) ? kq_nt : g.K / BK; }
    __device__ __forceinline__ void after_unit(int) const {}
};


struct EpiBf16 {
    static constexpr bool PERM = true;
    bf16_t* O; int ldc; size_t estride; int ecol;
    __device__ __forceinline__ void operator()(const f32x4 (&acc)[2][2][4][2], const Unit& u, int wr, int wc, int fr, int fq) const {
        const int row0 = u.pm * BM + wr * 64 + fr; const int col0 = u.pn * BM + wc * 32 + 8 * fq + u.e * ecol;
        bf16_t* base = O + (size_t)u.e * estride;
#pragma unroll
        for (int ai = 0; ai < 2; ++ai)
#pragma unroll
            for (int m = 0; m < 4; ++m) { bf16_t* rowp = base + (size_t)(row0 + ai * HALF + m * 16) * ldc + col0;
#pragma unroll
                for (int bj = 0; bj < 2; ++bj) { const f32x4 v0 = acc[ai][bj][m][0], v1 = acc[ai][bj][m][1];
                    u32x4 w; w.x = cvt_pk_bf16(v0[0], v0[1]); w.y = cvt_pk_bf16(v0[2], v0[3]); w.z = cvt_pk_bf16(v1[0], v1[1]); w.w = cvt_pk_bf16(v1[2], v1[3]);
                    *(u32x4*)(rowp + bj * HALF) = w; } }
    }
};
struct EpiMoeDown {
    static constexpr bool PERM = true;
    bf16_t* YE; bf16_t* YEP; int pm_split; size_t qstride;
    __device__ __forceinline__ void operator()(const f32x4 (&acc)[2][2][4][2], const Unit& u, int wr, int wc, int fr, int fq) const {
        const int kq1 = u.e >> 8; const int col0 = u.pn * BM + wc * 32 + 8 * fq;
        bf16_t* base = kq1 ? YEP + (size_t)(kq1 - 1) * qstride + (size_t)((u.pm - pm_split) * BM) * D : YE + (size_t)(u.pm * BM) * D;
        const int row0 = wr * 64 + fr;
#pragma unroll
        for (int ai = 0; ai < 2; ++ai)
#pragma unroll
            for (int m = 0; m < 4; ++m) { bf16_t* rowp = base + (size_t)(row0 + ai * HALF + m * 16) * D + col0;
#pragma unroll
                for (int bj = 0; bj < 2; ++bj) { const f32x4 v0 = acc[ai][bj][m][0], v1 = acc[ai][bj][m][1];
                    u32x4 w; w.x = cvt_pk_bf16(v0[0], v0[1]); w.y = cvt_pk_bf16(v0[2], v0[3]); w.z = cvt_pk_bf16(v1[0], v1[1]); w.w = cvt_pk_bf16(v1[2], v1[3]);
                    *(u32x4*)(rowp + bj * HALF) = w; } }
    }
};
struct EpiQKV {
    static constexpr bool PERM = true;
    bf16_t* O; const float* rope;
    __device__ __forceinline__ void operator()(const f32x4 (&acc)[2][2][4][2], const Unit& u, int wr, int wc, int fr, int fq) const {
        const int gt = u.pn >> 3, t = gt % 3, dsh = 2 * (gt / 3), head = 2 * (u.pn & 7) + (wc >> 1), idx0 = 32 * (wc & 1) + 8 * fq;
        const int row0 = u.pm * BM + wr * 64 + fr; bf16_t* hb = O + ((size_t)(gt * 16 + head) * MTOK) * 128 + idx0;
#pragma unroll
        for (int ai = 0; ai < 2; ++ai)
#pragma unroll
            for (int m = 0; m < 4; ++m) { const int row = row0 + ai * HALF + m * 16; const int sq = row & (SEQ - 1);
                bf16_t* rowp = hb + (size_t)((row & ~(SEQ - 1)) + (sq & ((1 << dsh) - 1)) * (SEQ >> dsh) + (sq >> dsh)) * 128;
                f32x4 l0 = acc[ai][0][m][0], l1 = acc[ai][0][m][1], h0 = acc[ai][1][m][0], h1 = acc[ai][1][m][1];
                if (t < 2) { const float* cp = rope + (size_t)(row & (SEQ - 1)) * 64 + idx0; const float* sp = cp + SEQ * 64;
                    const f32x4 c0 = *(const f32x4*)cp, c1 = *(const f32x4*)(cp + 4), s0 = *(const f32x4*)sp, s1 = *(const f32x4*)(sp + 4);
                    const f32x4 a0 = l0 * c0 - h0 * s0, a1 = l1 * c1 - h1 * s1, b0 = h0 * c0 + l0 * s0, b1 = h1 * c1 + l1 * s1;
                    l0 = a0; l1 = a1; h0 = b0; h1 = b1; }
                u32x4 w; w.x = cvt_pk_bf16(l0[0], l0[1]); w.y = cvt_pk_bf16(l0[2], l0[3]); w.z = cvt_pk_bf16(l1[0], l1[1]); w.w = cvt_pk_bf16(l1[2], l1[3]);
                *(u32x4*)rowp = w;
                w.x = cvt_pk_bf16(h0[0], h0[1]); w.y = cvt_pk_bf16(h0[2], h0[3]); w.z = cvt_pk_bf16(h1[0], h1[1]); w.w = cvt_pk_bf16(h1[2], h1[3]);
                *(u32x4*)(rowp + 64) = w; }
    }
};
struct EpiSwiGLU {
    static constexpr bool PERM = true;
    bf16_t* O; int ldc;
    __device__ __forceinline__ void operator()(const f32x4 (&acc)[2][2][4][2], const Unit& u, int wr, int wc, int fr, int fq) const {
        const int row0 = u.pm * BM + wr * 64 + fr; const int col0 = u.pn * HALF + wc * 32 + 8 * fq;
#pragma unroll
        for (int ai = 0; ai < 2; ++ai)
#pragma unroll
            for (int m = 0; m < 4; ++m) { bf16_t* rowp = O + (size_t)(row0 + ai * HALF + m * 16) * ldc + col0;
                float r[8];
#pragma unroll
                for (int n = 0; n < 2; ++n)
#pragma unroll
                    for (int j = 0; j < 4; ++j) { const float a = acc[ai][0][m][n][j], b = acc[ai][1][m][n][j];
                        const float sg = __builtin_amdgcn_rcpf(1.0f + __builtin_amdgcn_exp2f(-1.4426950408889634f * a)); r[n * 4 + j] = a * sg * b; }
                u32x4 w; w.x = cvt_pk_bf16(r[0], r[1]); w.y = cvt_pk_bf16(r[2], r[3]); w.z = cvt_pk_bf16(r[4], r[5]); w.w = cvt_pk_bf16(r[6], r[7]);
                *(u32x4*)rowp = w; }
    }
};
template <bool F32OUT> struct EpiRes {
    static constexpr bool PERM = true;
    const bf16_t* res; void* Y; int ldc; float alpha;
    __device__ __forceinline__ void operator()(const f32x4 (&acc)[2][2][4][2], const Unit& u, int wr, int wc, int fr, int fq) const {
        const int row0 = u.pm * BM + wr * 64 + fr, col0 = u.pn * BM + wc * 32 + 8 * fq;
#pragma unroll
        for (int ai = 0; ai < 2; ++ai)
#pragma unroll
            for (int m = 0; m < 4; ++m) { const size_t off = (size_t)(row0 + ai * HALF + m * 16) * ldc + col0;
#pragma unroll
                for (int bj = 0; bj < 2; ++bj) { const u32x4 rw = *(const u32x4*)(res + off + bj * HALF);
                    f32x4 v0 = acc[ai][bj][m][0], v1 = acc[ai][bj][m][1];
                    v0[0] += alpha * bf_lo(rw.x); v0[1] += alpha * bf_hi(rw.x); v0[2] += alpha * bf_lo(rw.y); v0[3] += alpha * bf_hi(rw.y);
                    v1[0] += alpha * bf_lo(rw.z); v1[1] += alpha * bf_hi(rw.z); v1[2] += alpha * bf_lo(rw.w); v1[3] += alpha * bf_hi(rw.w);
                    if constexpr (F32OUT) { float* yp = (float*)Y + off + bj * HALF; *(f32x4*)yp = v0; *(f32x4*)(yp + 4) = v1; }
                    else { u32x4 w; w.x = cvt_pk_bf16(v0[0], v0[1]); w.y = cvt_pk_bf16(v0[2], v0[3]); w.z = cvt_pk_bf16(v1[0], v1[1]); w.w = cvt_pk_bf16(v1[2], v1[3]); *(u32x4*)((bf16_t*)Y + off + bj * HALF) = w; } }
                if (m == 3) asm volatile("" ::: "memory"); }
    }
};
struct EpiPle {
    static constexpr bool PERM = true;
    const bf16_t* x; const bf16_t* pp; const float* bias; float* outF; bf16_t* outB; int ldc;
    __device__ __forceinline__ void operator()(const f32x4 (&acc)[2][2][4][2], const Unit& u, int wr, int wc, int fr, int fq) const {
        const int row0 = u.pm * BM + wr * 64 + fr, col0 = u.pn * BM + wc * 32 + 8 * fq;
        f32x4 bv[2][2];
#pragma unroll
        for (int bj = 0; bj < 2; ++bj)
#pragma unroll
            for (int n = 0; n < 2; ++n) bv[bj][n] = *(const f32x4*)(bias + col0 + bj * HALF + 4 * n);
#pragma unroll
        for (int ai = 0; ai < 2; ++ai)
#pragma unroll
            for (int m = 0; m < 4; ++m) { const size_t off = (size_t)(row0 + ai * HALF + m * 16) * ldc + col0;
#pragma unroll
                for (int bj = 0; bj < 2; ++bj) { const size_t o2 = off + bj * HALF;
                    const u32x4 xw = *(const u32x4*)(x + o2), pw = *(const u32x4*)(pp + o2);
                    float o[8];
#pragma unroll
                    for (int e = 0; e < 4; ++e) { const int n = e >> 1, j = (e & 1) * 2;
                        const float v0 = acc[ai][bj][m][n][j] + bv[bj][n][j], v1 = acc[ai][bj][m][n][j + 1] + bv[bj][n][j + 1];
                        o[2 * e] = bf_lo(xw[e]) + bf_lo(pw[e]) * __builtin_amdgcn_rcpf(1.0f + __builtin_amdgcn_exp2f(-1.4426950408889634f * v0));
                        o[2 * e + 1] = bf_hi(xw[e]) + bf_hi(pw[e]) * __builtin_amdgcn_rcpf(1.0f + __builtin_amdgcn_exp2f(-1.4426950408889634f * v1)); }
                    if (outF) { float* yp = outF + o2; *(f32x4*)yp = (f32x4){o[0], o[1], o[2], o[3]}; *(f32x4*)(yp + 4) = (f32x4){o[4], o[5], o[6], o[7]}; }
                    else { u32x4 w; w.x = cvt_pk_bf16(o[0], o[1]); w.y = cvt_pk_bf16(o[2], o[3]); w.z = cvt_pk_bf16(o[4], o[5]); w.w = cvt_pk_bf16(o[6], o[7]); *(u32x4*)(outB + o2) = w; } }
                if (m & 1) asm volatile("" ::: "memory"); }
    }
};

constexpr int IDX_LDS_OFF = 131072 + 1024;
template <class Epi, class Sched, bool ALIGN_EPI = true, bool SP2 = true, bool STAMP = false, bool GATHER = false>
__device__ __forceinline__ void gemm_phase(PG8_LAS unsigned char* lds, const Gemm g, const Sched& S, const Epi& E, unsigned long long* stp = nullptr) {
    const int tid = threadIdx.x, wid = __builtin_amdgcn_readfirstlane(tid >> 6), lane = tid & 63, wr = wid >> 2, wc = wid & 3, fr = lane & 15, fq = lane >> 4;
    unsigned voffA[2], voffB[2]; int gR[2], gC[2];
#pragma unroll
    for (int i = 0; i < 2; ++i) { int R, C; stage_rc(tid * 16 + i * 8192, R, C); const int Rb = Epi::PERM ? ((R & ~31) + perm32(R & 31)) : R; gR[i] = R; gC[i] = C;
        voffA[i] = (unsigned)(R * g.lda + C) * 2u; voffB[i] = (unsigned)(Rb * g.ldb + C) * 2u; }
    const size_t kstep = (size_t)(BK * 2);
    const size_t hstepA = (size_t)HALF * g.lda * 2, hstepB = (size_t)HALF * g.ldb * 2;
    const PG8_LAS unsigned short* gidx = (const PG8_LAS unsigned short*)(lds + IDX_LDS_OFF);
    unsigned cvo[2][2], nvo[2][2];
#define PG8_GOFF(dst, ui_) do { _Pragma("unroll") for (int _h = 0; _h < 2; ++_h) _Pragma("unroll") for (int _i = 0; _i < 2; ++_i) \
        dst[_h][_i] = GATHER ? ((unsigned)gidx[(ui_) * 256 + _h * HALF + gR[_i]] * (unsigned)(g.lda * 2) + (unsigned)(gC[_i] * 2)) : (voffA[_i] + (unsigned)(_h * hstepA)); } while (0)
    PG8_GOFF(cvo, 0);
#pragma unroll
    for (int _h = 0; _h < 2; ++_h)
#pragma unroll
        for (int _i = 0; _i < 2; ++_i) nvo[_h][_i] = cvo[_h][_i];
    const unsigned ldsw = (unsigned)wid * 1024u;
    const int aoff = lds_byte(wr * 64 + fr, fq * 8), boff = lds_byte(wc * 32 + fr, fq * 8);
#define PG8_SA(b, h) (((b) * 2 + (h)) * HTB)
#define PG8_SB(b, h) ((4 + (b) * 2 + (h)) * HTB)
#define PG8_STAGE(bufoff, gbase, voff) do { _Pragma("unroll") for (int _i = 0; _i < 2; ++_i) \
        __builtin_amdgcn_global_load_lds((const unsigned*)((const char*)(gbase) + (voff)[_i]), (PG8_LAS unsigned*)(lds + (bufoff) + ldsw + _i * 8192), 16, 0, 0); } while (0)
#define PG8_LDA(dst, b, h) do { _Pragma("unroll") for (int m = 0; m < 4; ++m) _Pragma("unroll") for (int k = 0; k < 2; ++k) dst[m][k] = *(const PG8_LAS bf16x8*)(lds + PG8_SA(b, h) + aoff + m * 2048 + k * 1024); } while (0)
#define PG8_LDB(dst, b, h) do { _Pragma("unroll") for (int n = 0; n < 2; ++n) _Pragma("unroll") for (int k = 0; k < 2; ++k) dst[n][k] = *(const PG8_LAS bf16x8*)(lds + PG8_SB(b, h) + boff + n * 2048 + k * 1024); } while (0)
#define PG8_MMA(ai, bj, At, Bt) do { __builtin_amdgcn_s_setprio(1); _Pragma("unroll") for (int m = 0; m < 4; ++m) _Pragma("unroll") for (int n = 0; n < 2; ++n) _Pragma("unroll") for (int k = 0; k < 2; ++k) \
        acc[ai][bj][m][n] = __builtin_amdgcn_mfma_f32_16x16x32_bf16(Bt[n][k], At[m][k], acc[ai][bj][m][n], 0, 0, 0); __builtin_amdgcn_s_setprio(0); } while (0)
#define PG8_WAIT_V(n) asm volatile("s_waitcnt vmcnt(" #n ")" ::: "memory")
#define PG8_WAIT_L(n) asm volatile("s_waitcnt lgkmcnt(" #n ")" ::: "memory")
#define PG8_BAR __builtin_amdgcn_s_barrier()
#define PG8_SCHED __builtin_amdgcn_sched_barrier(0)
    Unit cur, nxt; int ui = 0;
    if (!S.next(0, cur)) return;
    long long st_c0 = 0, st_w0 = 0, st_k = 0, st_e = 0, st_t = 0; if (STAMP) { st_c0 = clock64(); st_w0 = wall_clock64(); }
    f32x4 acc[2][2][4][2];
#pragma unroll
    for (int a = 0; a < 2; ++a)
#pragma unroll
        for (int b = 0; b < 2; ++b)
#pragma unroll
            for (int m = 0; m < 4; ++m)
#pragma unroll
                for (int n = 0; n < 2; ++n) acc[a][b][m][n] = (f32x4){0.f, 0.f, 0.f, 0.f};
    bf16x8 At[4][2], B0[2][2], B1[2][2];
    const char* cA = S.a_ptr(g, cur); const char* cB = S.b_ptr(g, cur);
    if constexpr (SP2) {
        PG8_STAGE(PG8_SB(0, 0), cB, voffB); PG8_STAGE(PG8_SB(0, 1), cB + hstepB, voffB); PG8_STAGE(PG8_SA(0, 0), cA, cvo[0]); PG8_STAGE(PG8_SA(0, 1), cA, cvo[1]);
        if (wr == 1) PG8_BAR;
        PG8_WAIT_V(2); PG8_BAR;
        PG8_STAGE(PG8_SB(1, 0), cB + kstep, voffB); PG8_STAGE(PG8_SA(1, 0), cA + kstep, cvo[0]); PG8_STAGE(PG8_SB(1, 1), cB + hstepB + kstep, voffB);
        PG8_WAIT_V(6); PG8_BAR;
    } else {
        PG8_STAGE(PG8_SB(0, 0), cB, voffB); PG8_STAGE(PG8_SA(0, 0), cA, cvo[0]); PG8_STAGE(PG8_SB(0, 1), cB + hstepB, voffB); PG8_STAGE(PG8_SA(0, 1), cA, cvo[1]);
        if (wr == 1) PG8_BAR;
        PG8_WAIT_V(4); PG8_BAR;
        PG8_STAGE(PG8_SB(1, 0), cB + kstep, voffB); PG8_STAGE(PG8_SA(1, 0), cA + kstep, cvo[0]); PG8_STAGE(PG8_SB(1, 1), cB + hstepB + kstep, voffB);
        PG8_WAIT_V(6); PG8_BAR;
    }
    for (;;) {
        const bool has_next = S.next(ui + 1, nxt);
        const char* nA = has_next ? S.a_ptr(g, nxt) : cA; const char* nB = has_next ? S.b_ptr(g, nxt) : cB;
        const int nt = S.unit_nt(g, cur);
        if (GATHER && has_next) PG8_GOFF(nvo, ui + 1);
        if (STAMP) st_t = clock64();
        for (int t = 0; t < nt; t += 2) {
            const bool last = (t == nt - 2);
            const char* a1 = cA + (size_t)(t + 1) * kstep;
            const char* a2 = last ? nA : cA + (size_t)(t + 2) * kstep; const char* b2 = last ? nB : cB + (size_t)(t + 2) * kstep;
            const char* a3 = a2 + kstep; const char* b3 = b2 + kstep;
            unsigned xvo[2][2];
#pragma unroll
            for (int _h = 0; _h < 2; ++_h)
#pragma unroll
                for (int _i = 0; _i < 2; ++_i) xvo[_h][_i] = (GATHER && last) ? nvo[_h][_i] : cvo[_h][_i];
            if constexpr (SP2) {
            PG8_LDB(B0, 0, 0); PG8_LDB(B1, 0, 1); PG8_SCHED; PG8_LDA(At, 0, 0); PG8_STAGE(PG8_SA(1, 1), a1, cvo[1]);
            PG8_WAIT_V(8); PG8_WAIT_L(0); PG8_BAR; PG8_MMA(0, 0, At, B0); PG8_MMA(0, 1, At, B1); PG8_BAR; PG8_SCHED;
            PG8_LDA(At, 0, 1); PG8_STAGE(PG8_SB(0, 0), b2, voffB); PG8_STAGE(PG8_SB(0, 1), b2 + hstepB, voffB); PG8_STAGE(PG8_SA(0, 0), a2, xvo[0]);
            PG8_WAIT_V(8); PG8_WAIT_L(0); PG8_BAR; PG8_MMA(1, 0, At, B0); PG8_MMA(1, 1, At, B1); PG8_BAR; PG8_SCHED;
            PG8_LDB(B0, 1, 0); PG8_LDB(B1, 1, 1); PG8_SCHED; PG8_LDA(At, 1, 0); PG8_STAGE(PG8_SA(0, 1), a2, xvo[1]);
            PG8_WAIT_V(8); PG8_WAIT_L(0); PG8_BAR; PG8_MMA(0, 0, At, B0); PG8_MMA(0, 1, At, B1); PG8_BAR; PG8_SCHED;
            PG8_LDA(At, 1, 1); PG8_STAGE(PG8_SB(1, 0), b3, voffB); PG8_STAGE(PG8_SB(1, 1), b3 + hstepB, voffB); PG8_STAGE(PG8_SA(1, 0), a3, xvo[0]);
            PG8_WAIT_V(8); PG8_WAIT_L(0); PG8_BAR; PG8_MMA(1, 0, At, B0); PG8_MMA(1, 1, At, B1); PG8_BAR; PG8_SCHED;
            } else {
            PG8_LDB(B0, 0, 0); PG8_SCHED; PG8_LDA(At, 0, 0); PG8_STAGE(PG8_SA(1, 1), a1, cvo[1]);
            PG8_WAIT_L(8); PG8_BAR; PG8_WAIT_L(0); PG8_MMA(0, 0, At, B0); PG8_BAR; PG8_SCHED;
            PG8_LDB(B1, 0, 1); PG8_STAGE(PG8_SB(0, 0), b2, voffB);
            PG8_BAR; PG8_WAIT_L(0); PG8_MMA(0, 1, At, B1); PG8_BAR;
            PG8_LDA(At, 0, 1); PG8_STAGE(PG8_SA(0, 0), a2, xvo[0]);
            PG8_BAR; PG8_WAIT_L(0); PG8_MMA(1, 0, At, B0); PG8_BAR; PG8_SCHED;
            PG8_STAGE(PG8_SB(0, 1), b2 + hstepB, voffB);
            PG8_WAIT_V(6); PG8_BAR; PG8_MMA(1, 1, At, B1); PG8_BAR;
            PG8_LDB(B0, 1, 0); PG8_SCHED; PG8_LDA(At, 1, 0); PG8_STAGE(PG8_SA(0, 1), a2, xvo[1]);
            PG8_WAIT_L(8); PG8_BAR; PG8_WAIT_L(0); PG8_MMA(0, 0, At, B0); PG8_BAR; PG8_SCHED;
            PG8_LDB(B1, 1, 1); PG8_STAGE(PG8_SB(1, 0), b3, voffB);
            PG8_BAR; PG8_WAIT_L(0); PG8_MMA(0, 1, At, B1); PG8_BAR;
            PG8_LDA(At, 1, 1); PG8_STAGE(PG8_SA(1, 0), a3, xvo[0]);
            PG8_BAR; PG8_WAIT_L(0); PG8_MMA(1, 0, At, B0); PG8_BAR; PG8_SCHED;
            PG8_STAGE(PG8_SB(1, 1), b3 + hstepB, voffB);
            PG8_WAIT_V(6); PG8_BAR; PG8_MMA(1, 1, At, B1); PG8_BAR;
            }
        }
        if (STAMP) { const long long c = clock64(); st_k += c - st_t; st_t = c; }
        if constexpr (ALIGN_EPI) { if (wr == 0) PG8_BAR; }
        E(acc, cur, wr, wc, fr, fq);
        if (STAMP) { const long long c = clock64(); st_e += c - st_t; }
        S.after_unit(ui);
        if (!has_next) break;
#pragma unroll
        for (int a = 0; a < 2; ++a)
#pragma unroll
            for (int b = 0; b < 2; ++b)
#pragma unroll
                for (int m = 0; m < 4; ++m)
#pragma unroll
                    for (int n = 0; n < 2; ++n) acc[a][b][m][n] = (f32x4){0.f, 0.f, 0.f, 0.f};
        cur = nxt; cA = nA; cB = nB; ++ui;
        if (GATHER) {
#pragma unroll
            for (int _h = 0; _h < 2; ++_h)
#pragma unroll
                for (int _i = 0; _i < 2; ++_i) cvo[_h][_i] = nvo[_h][_i]; }
        if constexpr (ALIGN_EPI) { if (wr == 1) PG8_BAR; }
    }
    PG8_WAIT_V(0);
    if constexpr (!ALIGN_EPI) { if (wr == 0) PG8_BAR; }
    PG8_BAR;
    if (STAMP) { if (blockIdx.x == 0 && tid == 0) { const long long c1 = clock64(), w1 = wall_clock64(); stp[0] = (unsigned long long)((c1 - st_c0) * 100 / (w1 - st_w0)); stp[1] = (unsigned long long)(st_k / ((ui + 1) * (g.K / BK))); stp[2] = (unsigned long long)(st_e / (10 * (ui + 1))); } }
#undef PG8_GOFF
#undef PG8_SA
#undef PG8_SB
#undef PG8_STAGE
#undef PG8_LDA
#undef PG8_LDB
#undef PG8_MMA
#undef PG8_WAIT_V
#undef PG8_WAIT_L
#undef PG8_BAR
#undef PG8_SCHED
}
}

#define XB_TMO      128
#define XB_XCNT(j)  (256  + 64 * (j))
#define XB_XSUB(j)  (1280 + 64 * (j))
#define XB_XGEN(j)  (2304 + 64 * (j))
#define XB_TOP      3328
#define XB_TOPGEN   3392
#define XCD_BAR_WORDS 3456
#define XB_SPIN_CAP (1u << 18)

__device__ __forceinline__ unsigned xb_ld(unsigned* p)              { return __hip_atomic_load(p, __ATOMIC_RELAXED, __HIP_MEMORY_SCOPE_AGENT); }
__device__ __forceinline__ unsigned xb_add(unsigned* p, unsigned v) { return __hip_atomic_fetch_add(p, v, __ATOMIC_RELAXED, __HIP_MEMORY_SCOPE_AGENT); }
__device__ __forceinline__ unsigned xb_xcc_id() { return (unsigned)__builtin_amdgcn_s_getreg((3 << 11) | 20) & 0xFu; }
#define XB_SPIN(cond, bar) do { unsigned _sp = 0; while (cond) { __builtin_amdgcn_s_sleep(1); \
    if ((++_sp & 255u) == 0u) { if (xb_ld(&(bar)[XB_TMO])) break; if (_sp > XB_SPIN_CAP) { atomicAdd(&(bar)[XB_TMO], 1u); break; } } } } while (0)

struct XcdBarrier { unsigned* bar; unsigned x; volatile LAS unsigned* st; };

__device__ __forceinline__ XcdBarrier xcd_barrier_post(unsigned* bar, volatile LAS unsigned* st) {
    XcdBarrier b; b.bar = bar; b.x = xb_xcc_id(); b.st = st;
    if (threadIdx.x == 0) (void)xb_add(&bar[XB_XCNT(b.x)], 1u);
    return b;
}
__device__ __forceinline__ void xcd_barrier_complete(unsigned* bar, unsigned x, unsigned& nloc, unsigned& nx) {
    const unsigned G = gridDim.x * gridDim.y * gridDim.z;
    unsigned sum, cnt, mine, sp = 0u;
    for (;;) {
        sum = 0u; cnt = 0u; mine = 0u;
#pragma unroll
        for (unsigned j = 0; j < 16; ++j) { const unsigned c = xb_ld(&bar[XB_XCNT(j)]); sum += c; cnt += (c > 0u) ? 1u : 0u; mine = (j == x) ? c : mine; }
        if (sum == G) break;
        __builtin_amdgcn_s_sleep(1);
        if ((++sp & 255u) == 0u) { if (xb_ld(&bar[XB_TMO])) break; if (sp > XB_SPIN_CAP) { atomicAdd(&bar[XB_TMO], 1u); break; } }
    }
    nloc = mine > 0u ? mine : 1u; nx = cnt > 0u ? cnt : 1u;
}
__device__ __forceinline__ void xcd_barrier(const XcdBarrier& b) {
    asm volatile("s_waitcnt vmcnt(0)" ::: "memory");
    __syncthreads();
    if (threadIdx.x == 0) {
        unsigned* bar = b.bar;
        __builtin_amdgcn_s_waitcnt(0);
        unsigned nloc = b.st[0], nx = b.st[1];
        if (nloc == 0u) { xcd_barrier_complete(bar, b.x, nloc, nx); b.st[0] = nloc; b.st[1] = nx; }
        const unsigned old = xb_add(&bar[XB_XSUB(b.x)], 1u);
        const unsigned gen = old / nloc;
        if (old + 1u == (gen + 1u) * nloc) {
            __builtin_amdgcn_fence(__ATOMIC_RELEASE, "agent");
            asm volatile("s_waitcnt vmcnt(0)" ::: "memory");
            const unsigned og = xb_add(&bar[XB_TOP], 1u);
            const unsigned tg = og / nx;
            if (og + 1u == (tg + 1u) * nx) xb_add(&bar[XB_TOPGEN], 1u);
            else XB_SPIN(xb_ld(&bar[XB_TOPGEN]) == tg, bar);
            __builtin_amdgcn_fence(__ATOMIC_ACQUIRE, "agent");
            xb_add(&bar[XB_XGEN(b.x)], 1u);
            asm volatile("s_waitcnt vmcnt(0)" ::: "memory");
        } else {
            XB_SPIN(xb_ld(&bar[XB_XGEN(b.x)]) == gen, bar);
            __builtin_amdgcn_fence(__ATOMIC_ACQUIRE, "agent");
            asm volatile("s_waitcnt vmcnt(0)" ::: "memory");
        }
    }
    __syncthreads();
}

struct Frame {
    LAS unsigned char* lds;
    int tid, lane, wave, vcu, G;
    unsigned char* ws;
};
struct Args { const float* in[22]; float* out; unsigned char* ws; int ph_lo, ph_hi; };

__device__ __forceinline__ void cvt_tile(const float* W, size_t ldw, int k0, int n0, bf16* WT, size_t ldt, int dst_row0, int lane) {
    const int kb = lane >> 3, nb = lane & 7;
    const float* src = W + (size_t)(k0 + 8 * kb) * ldw + n0 + 4 * nb;
    f32x4 v[8];
#pragma unroll
    for (int j = 0; j < 8; ++j) v[j] = *(const f32x4*)(src + (size_t)j * ldw);
#pragma unroll
    for (int jn = 0; jn < 4; ++jn) { u32x4 o; o.x = cvt_pk_bf16(v[0][jn], v[1][jn]); o.y = cvt_pk_bf16(v[2][jn], v[3][jn]); o.z = cvt_pk_bf16(v[4][jn], v[5][jn]); o.w = cvt_pk_bf16(v[6][jn], v[7][jn]);
        *(u32x4*)(WT + (size_t)(dst_row0 + 4 * nb + jn) * ldt + k0 + 8 * kb) = o; }
}
struct MapId { __device__ __forceinline__ int operator()(int n) const { return n; } };
struct MapQKV { __device__ __forceinline__ int operator()(int n) const { const int gt = n >> 11, head = (n >> 7) & 15, d = n & 127; return (gt * 8 + (head >> 1)) * 256 + 128 * (d >> 6) + 64 * (head & 1) + (d & 63); } };
struct MapGU { int which; __device__ __forceinline__ int operator()(int n) const { return 256 * (n >> 7) + 128 * which + (n & 127); } };
template <class Map> __device__ __forceinline__ void cvt_matrix(const float* W, int K, int N, bf16* WT, size_t ldt, Map map, int& it0, int gw, int NGW, int lane) {
    const int nblk = N / 32, items = (K / 64) * nblk;
    int it = gw - it0; if (it < 0) it += ((-it + NGW - 1) / NGW) * NGW;
    for (; it < items; it += 2 * NGW) { const int it2 = it + NGW; const bool two = it2 < items;
        const int kb = it / nblk, nb = it - kb * nblk, kb2 = two ? it2 / nblk : kb, nb2 = two ? it2 - kb2 * nblk : nb;
        const int q8 = lane >> 3, n8 = lane & 7;
        const float* sa = W + (size_t)(64 * kb + 8 * q8) * N + 32 * nb + 4 * n8; const float* sb = W + (size_t)(64 * kb2 + 8 * q8) * N + 32 * nb2 + 4 * n8;
        f32x4 va[8], vb[8];
#pragma unroll
        for (int j = 0; j < 8; ++j) va[j] = *(const f32x4*)(sa + (size_t)j * N);
#pragma unroll
        for (int j = 0; j < 8; ++j) vb[j] = *(const f32x4*)(sb + (size_t)j * N);
        const int da = map(32 * nb), db = map(32 * nb2);
#pragma unroll
        for (int jn = 0; jn < 4; ++jn) { u32x4 o; o.x = cvt_pk_bf16(va[0][jn], va[1][jn]); o.y = cvt_pk_bf16(va[2][jn], va[3][jn]); o.z = cvt_pk_bf16(va[4][jn], va[5][jn]); o.w = cvt_pk_bf16(va[6][jn], va[7][jn]);
            *(u32x4*)(WT + (size_t)(da + 4 * n8 + jn) * ldt + 64 * kb + 8 * q8) = o; }
        if (two) {
#pragma unroll
            for (int jn = 0; jn < 4; ++jn) { u32x4 o; o.x = cvt_pk_bf16(vb[0][jn], vb[1][jn]); o.y = cvt_pk_bf16(vb[2][jn], vb[3][jn]); o.z = cvt_pk_bf16(vb[4][jn], vb[5][jn]); o.w = cvt_pk_bf16(vb[6][jn], vb[7][jn]);
                *(u32x4*)(WT + (size_t)(db + 4 * n8 + jn) * ldt + 64 * kb2 + 8 * q8) = o; } }
    }
    it0 = (it0 + items) % NGW;
}
__device__ __forceinline__ void cvt_flat(const float* s, bf16* d, size_t n, int gw, int NGW, int lane) {
    for (size_t i = ((size_t)gw * 64 + lane) * 8; i < n; i += (size_t)NGW * 64 * 8) { const f32x4 a = *(const f32x4*)(s + i), b = *(const f32x4*)(s + i + 4);
        u32x4 o; o.x = cvt_pk_bf16(a[0], a[1]); o.y = cvt_pk_bf16(a[2], a[3]); o.z = cvt_pk_bf16(b[0], b[1]); o.w = cvt_pk_bf16(b[2], b[3]); *(u32x4*)(d + i) = o; }
}

constexpr int MOE_ITEMS_PER_E = 3 * 5632, MOE_ITEMS = NE * MOE_ITEMS_PER_E;
struct MoeItem { const float* src; bf16* dst; int ldw, ldt; };
__device__ __forceinline__ MoeItem moe_item(const float* w1, const float* w3, const float* w2, bf16* W13, bf16* W2, int it, int kb8, int nb8) {
    const int e = it / MOE_ITEMS_PER_E, r = it - e * MOE_ITEMS_PER_E, which = r / 5632, r2 = r - which * 5632; MoeItem m;
    if (which < 2) { const int kb = r2 / 176, nb = r2 - kb * 176, k0 = 64 * kb, n0 = 32 * nb, drow = 256 * (n0 >> 7) + 128 * which + (n0 & 127);
        m.src = (which ? w3 : w1) + (size_t)e * D * FF + (size_t)(k0 + 8 * kb8) * FF + n0 + 4 * nb8; m.ldw = FF; m.dst = W13 + (size_t)e * FF2 * D + (size_t)(drow + 4 * nb8) * D + k0 + 8 * kb8; m.ldt = D; }
    else { const int kb = r2 >> 6, nb = r2 & 63, k0 = 64 * kb, n0 = 32 * nb;
        m.src = w2 + (size_t)e * FF * D + (size_t)(k0 + 8 * kb8) * D + n0 + 4 * nb8; m.ldw = D; m.dst = W2 + (size_t)e * D * FF + (size_t)(n0 + 4 * nb8) * FF + k0 + 8 * kb8; m.ldt = FF; }
    return m;
}
__device__ __forceinline__ void moe_convert_share(const float* w1, const float* w3, const float* w2, bf16* W13, bf16* W2, int c, int nshare, int wave, int lane) {
    const int per = (MOE_ITEMS + nshare - 1) / nshare; const int lo = c * per, hi = (lo + per < MOE_ITEMS) ? lo + per : MOE_ITEMS;
    const int kb8 = lane >> 3, nb8 = lane & 7;
    for (int it = lo + wave; it < hi; it += 32) {
        MoeItem m[4]; f32x4 v[4][8];
#pragma unroll
        for (int q = 0; q < 4; ++q) { const int iq = (it + 8 * q < hi) ? it + 8 * q : it; m[q] = moe_item(w1, w3, w2, W13, W2, iq, kb8, nb8);
#pragma unroll
            for (int j = 0; j < 8; ++j) v[q][j] = __builtin_nontemporal_load((const f32x4*)(m[q].src + (size_t)j * m[q].ldw)); }
#pragma unroll
        for (int q = 0; q < 4; ++q) if (q == 0 || it + 8 * q < hi) {
#pragma unroll
            for (int jn = 0; jn < 4; ++jn) { u32x4 o; o.x = cvt_pk_bf16(v[q][0][jn], v[q][1][jn]); o.y = cvt_pk_bf16(v[q][2][jn], v[q][3][jn]); o.z = cvt_pk_bf16(v[q][4][jn], v[q][5][jn]); o.w = cvt_pk_bf16(v[q][6][jn], v[q][7][jn]);
                *(u32x4*)(m[q].dst + (size_t)jn * m[q].ldt) = o; } }
    }
}
namespace pg8 {
struct HostOrder : StaticOrder {
    const float *w1, *w3, *w2; bf16_t *W13, *W2; int slot, share, nshare;
    __device__ __forceinline__ void after_unit(int ui) const {
        if (ui == slot) moe_convert_share(w1, w3, w2, W13, W2, share, nshare, __builtin_amdgcn_readfirstlane(threadIdx.x >> 6), threadIdx.x & 63);
    }
};
}
__device__ __forceinline__ void p0_prologue(Frame& F, const Args& a) {
    const int gw = F.vcu * 8 + F.wave, NGW = F.G * 8, lane = F.lane; unsigned char* ws = F.ws; int it0 = 0;
    cvt_matrix(a.in[2], D, NQKV, (bf16*)(ws + WS_WQKV), D, MapQKV{}, it0, gw, NGW, lane);
    cvt_matrix(a.in[3], D, D, (bf16*)(ws + WS_WO), D, MapId{}, it0, gw, NGW, lane);
    cvt_matrix(a.in[12], D, FF, (bf16*)(ws + WS_W13), D, MapGU{0}, it0, gw, NGW, lane);
    cvt_matrix(a.in[13], D, FF, (bf16*)(ws + WS_W13), D, MapGU{1}, it0, gw, NGW, lane);
    cvt_matrix(a.in[14], FF, D, (bf16*)(ws + WS_W2), FF, MapId{}, it0, gw, NGW, lane);
    cvt_matrix(a.in[20], D, D, (bf16*)(ws + WS_WGATE), D, MapId{}, it0, gw, NGW, lane);
    cvt_matrix(a.in[20] + (size_t)D * D, D, D, (bf16*)(ws + WS_WGATE) + (size_t)D * D, D, MapId{}, it0, gw, NGW, lane);
    cvt_matrix(a.in[19], PLE, D, (bf16*)(ws + WS_WPROJ), PLE, MapId{}, it0, gw, NGW, lane);
    cvt_matrix(a.in[19] + (size_t)PLE * D, PLE, D, (bf16*)(ws + WS_WPROJ) + (size_t)D * PLE, PLE, MapId{}, it0, gw, NGW, lane);
    cvt_matrix(a.in[4], D, D, (bf16*)(ws + WS_WIN), D, MapId{}, it0, gw, NGW, lane);
    cvt_matrix(a.in[7], D, D, (bf16*)(ws + WS_WO2), D, MapId{}, it0, gw, NGW, lane);
    { const float* wg = a.in[5]; const float* sc = a.in[6]; bf16* o = (bf16*)(ws + WS_WGS);
      for (size_t i = ((size_t)gw * 64 + lane) * 8; i < (size_t)4 * 512 * 512; i += (size_t)NGW * 64 * 8) { const int g = (int)(i >> 18), d = (int)(i & 511);
          const f32x4 x0 = *(const f32x4*)(wg + i), x1 = *(const f32x4*)(wg + i + 4), s0 = *(const f32x4*)(sc + g * 512 + d), s1 = *(const f32x4*)(sc + g * 512 + d + 4);
          const f32x4 y0 = x0 * s0, y1 = x1 * s1; u32x4 w; w.x = cvt_pk_bf16(y0[0], y0[1]); w.y = cvt_pk_bf16(y0[2], y0[3]); w.z = cvt_pk_bf16(y1[0], y1[1]); w.w = cvt_pk_bf16(y1[2], y1[3]); *(u32x4*)(o + i) = w; } }
    cvt_flat(a.in[0], (bf16*)(ws + WS_XB0), (size_t)MTOK * D, gw, NGW, lane);
    cvt_flat(a.in[1], (bf16*)(ws + WS_PB), (size_t)2 * MTOK * PLE, gw, NGW, lane);
    { float* ct = (float*)(ws + WS_ROPE); float* st = ct + SEQ * 64;
      for (int i = gw * 64 + lane; i < SEQ * 64; i += NGW * 64) { const int pos = i >> 6, j = i & 63;
          const double inv = exp2(-(double)j * (13.287712379549449 / 64.0));
          const double ang = (double)pos * inv; ct[i] = (float)cos(ang); st[i] = (float)sin(ang); } }
}

__device__ __forceinline__ void attn_load_block(const bf16* hp, int blk, LAS unsigned char* slot, bool isV, int w, int lane) {
#pragma unroll
    for (int i = 0; i < 4; ++i) {
        const int idx = i * 8 + w, row = idx * 4 + (lane >> 4), cs = lane & 15;
        const int c = cs ^ (isV ? (((row & 3) << 2) | ((row >> 2) & 3)) : (row & 7));
        const bf16* rp = hp + (size_t)(128 * blk + row) * 128 + c * 8;
        __builtin_amdgcn_global_load_lds((const unsigned*)rp, (LAS unsigned*)(slot + idx * 1024), 16, 0, 0);
    }
}
__device__ __forceinline__ void attn_phase(Frame& F) {
    const bf16* QKV = (const bf16*)(F.ws + WS_QKV); bf16* OG = (bf16*)(F.ws + WS_OG); float* LSE = (float*)(F.ws + WS_LSE);
    LAS unsigned char* Kl = F.lds; LAS unsigned char* Vl = F.lds + 98304;
    volatile LAS unsigned* MISCw = (volatile LAS unsigned*)(F.lds + MISC_OFF);
    const unsigned keep0 = MISCw[8], keep1 = MISCw[9];
    const int w = F.wave, lane = F.lane, q16 = lane & 15, g4 = lane >> 4, sw = ((g4 & 1) << 1) | (g4 >> 1);
    const int pi16 = (q16 & 3) | ((q16 & 4) << 1) | ((q16 & 8) >> 1);
    const int qq = q16 >> 2, pp = q16 & 3;
    bf16x8 bqn[4];
#pragma unroll
    for (int ks = 0; ks < 4; ++ks) bqn[ks] = (bf16x8){0, 0, 0, 0, 0, 0, 0, 0};
    __syncthreads();
    for (int i = F.tid; i < LDS_BYTES / 16; i += 512) *(LAS u32x4*)(F.lds + i * 16) = (u32x4){0u, 0u, 0u, 0u};
    for (int p = F.vcu; p < 768; p += F.G) {
        const int b = 3 - p / 192, pr = p % 192, g = pr >> 6, h = (pr & 63) >> 2, qs = pr & 3;
        const int dsh = 2 * g, dil = 1 << dsh, nb = 32 >> dsh;
        const bf16* planeQ = QKV + ((size_t)((g * 3 + 0) * 16 + h) * MTOK) * 128; const bf16* planeK = planeQ + (size_t)16 * MTOK * 128; const bf16* planeV = planeK + (size_t)16 * MTOK * 128;
        for (int u = 0; u < 8; ++u) {
            int r, n;
            if (g == 0) { r = 0; n = qs * 8 + u; } else if (g == 1) { r = qs; n = u; } else { r = qs * 4 + (u >> 1); n = u & 1; }
            const bool first = (u == 0) || (n == 0), cont = (u < 7) && (n + 1 < nb);
            const size_t tok0 = (size_t)b * SEQ + r; const size_t crow = (size_t)b * SEQ + (size_t)r * (SEQ >> dsh);
            const bf16* hQ = planeQ + crow * 128; const bf16* hK = planeK + crow * 128; const bf16* hV = planeV + crow * 128;
            const int par = n & 1, k3 = n % 3, kp3 = (n + 2) % 3, kn3 = (n + 1) % 3;
            const size_t qtok = tok0 + (size_t)(128 * n + 16 * w + q16) * dil;
            bf16x8 bq[4];
            if (first) {
                __syncthreads();
                attn_load_block(hK, n, Kl + k3 * 32768, false, w, lane);
                attn_load_block(hV, n, Vl + par * 32768, true, w, lane);
                if (n > 0) { attn_load_block(hK, n - 1, Kl + kp3 * 32768, false, w, lane);
                             attn_load_block(hV, n - 1, Vl + (par ^ 1) * 32768, true, w, lane); }
#pragma unroll
                for (int ks = 0; ks < 4; ++ks) bq[ks] = *(const bf16x8*)(hQ + (size_t)(128 * n + 16 * w + q16) * 128 + 32 * ks + 8 * g4);
            } else {
#pragma unroll
                for (int ks = 0; ks < 4; ++ks) bq[ks] = bqn[ks];
            }
            if (first) asm volatile("s_waitcnt vmcnt(0)" ::: "memory"); else asm volatile("s_waitcnt vmcnt(4)" ::: "memory");
            __syncthreads();
            if (!first) attn_load_block(hV, n, Vl + par * 32768, true, w, lane);
            if (cont) attn_load_block(hK, n + 1, Kl + kn3 * 32768, false, w, lane);
            f32x4 s[9];
            {
                bf16x8 ka[2][4];
#define ATT_LDK(buf, ti_) do { const int _kt = w + (ti_); const int _row = ((_kt >> 3) ? k3 : kp3) * 128 + (_kt & 7) * 16 + pi16; \
                    _Pragma("unroll") for (int _ks = 0; _ks < 4; ++_ks) ka[buf][_ks] = *(const LAS bf16x8*)(Kl + _row * 256 + (((4 * _ks + g4) ^ (_row & 7)) << 4)); } while (0)
                ATT_LDK(0, 0);
#pragma unroll
                for (int ti = 0; ti < 9; ++ti) {
                    if (ti < 8) ATT_LDK((ti + 1) & 1, ti + 1);
                    __builtin_amdgcn_sched_barrier(0);
                    f32x4 acc = (f32x4){0.f, 0.f, 0.f, 0.f};
#pragma unroll
                    for (int ks = 0; ks < 4; ++ks) acc = __builtin_amdgcn_mfma_f32_16x16x32_bf16(ka[ti & 1][ks], bq[ks], acc, 0, 0, 0);
                    s[ti] = acc;
                }
#undef ATT_LDK
            }
            const float C2 = 0.08838834764831845f * 1.4426950408889634f; const float NEG = -__builtin_inff();
            float mx = NEG;
#pragma unroll
            for (int ti = 0; ti < 9; ++ti) {
                const bool tile_ok = (n > 0 || w + ti >= 8);
#pragma unroll
                for (int i = 0; i < 4; ++i) { const int kk = 4 * sw + i; bool ok = tile_ok;
                    if (ti == 0) ok = ok && (kk >= q16);
                    if (ti == 8) ok = ok && (kk <= q16);
                    const float v = ok ? s[ti][i] * C2 : NEG; s[ti][i] = v; mx = fmaxf(mx, v); }
            }
            mx = fmaxf(mx, __shfl_xor(mx, 16)); mx = fmaxf(mx, __shfl_xor(mx, 32));
            float l = 0.f;
#pragma unroll
            for (int ti = 0; ti < 9; ++ti)
#pragma unroll
                for (int i = 0; i < 4; ++i) { const float pv = __builtin_amdgcn_exp2f(s[ti][i] - mx); s[ti][i] = pv; l += pv; }
            l += __shfl_xor(l, 16); l += __shfl_xor(l, 32);
            bf16x8 pf[5];
#pragma unroll
            for (int uu = 0; uu < 5; ++uu) { u32x4 wv; wv.x = cvt_pk_bf16(s[2 * uu][0], s[2 * uu][1]); wv.y = cvt_pk_bf16(s[2 * uu][2], s[2 * uu][3]);
                if (uu < 4) { wv.z = cvt_pk_bf16(s[2 * uu + 1][0], s[2 * uu + 1][1]); wv.w = cvt_pk_bf16(s[2 * uu + 1][2], s[2 * uu + 1][3]); } else { wv.z = 0u; wv.w = 0u; }
                pf[uu] = __builtin_bit_cast(bf16x8, wv); }
            if (cont) asm volatile("s_waitcnt vmcnt(4)" ::: "memory"); else asm volatile("s_waitcnt vmcnt(0)" ::: "memory");
            __syncthreads();
            if (cont) {
#pragma unroll
                for (int ks = 0; ks < 4; ++ks) bqn[ks] = *(const bf16x8*)(hQ + (size_t)(128 * (n + 1) + 16 * w + q16) * 128 + 32 * ks + 8 * g4);
            }
            const float rl = 1.0f / l;
            const size_t orow = (size_t)g * MTOK * D + qtok * D + h * 128;
            {
                s16x4 va[2][9];
#define ATT_TRV(r_, ch_) __builtin_bit_cast(s16x4, __builtin_amdgcn_ds_read_tr16_b64_v4i16((LAS s16x4*)(Vl + 256 * (r_) + 16 * ((ch_) ^ ((((r_) & 3) << 2) | (((r_) >> 2) & 3))) + 8 * (pp & 1))))
#define ATT_LDV(buf, dt_) do { const int _ch = 2 * (dt_) + (pp >> 1); \
                    _Pragma("unroll") for (int _u = 0; _u < 5; ++_u) { const int _kt0 = w + 2 * _u; const int _r0 = (par ^ 1 ^ (_kt0 >> 3)) * 128 + (_kt0 & 7) * 16 + 4 * sw + qq; va[buf][_u] = ATT_TRV(_r0, _ch); \
                        if (_u < 4) { const int _kt1 = _kt0 + 1; const int _r1 = (par ^ 1 ^ (_kt1 >> 3)) * 128 + (_kt1 & 7) * 16 + 4 * sw + qq; va[buf][5 + _u] = ATT_TRV(_r1, _ch); } } } while (0)
                ATT_LDV(0, 0);
#pragma unroll
                for (int dt = 0; dt < 8; ++dt) {
                    if (dt < 7) ATT_LDV((dt + 1) & 1, dt + 1);
                    __builtin_amdgcn_sched_barrier(0);
                    f32x4 o = (f32x4){0.f, 0.f, 0.f, 0.f};
#pragma unroll
                    for (int uu = 0; uu < 5; ++uu) { const s16x4 lo = va[dt & 1][uu]; const s16x4 hi = (uu < 4) ? va[dt & 1][5 + uu] : (s16x4){0, 0, 0, 0};
                        bf16x8 av; av[0] = lo[0]; av[1] = lo[1]; av[2] = lo[2]; av[3] = lo[3]; av[4] = hi[0]; av[5] = hi[1]; av[6] = hi[2]; av[7] = hi[3];
                        o = __builtin_amdgcn_mfma_f32_16x16x32_bf16(av, pf[uu], o, 0, 0, 0); }
                    o = o * rl;
                    u32x2 wv; wv.x = cvt_pk_bf16(o[0], o[1]); wv.y = cvt_pk_bf16(o[2], o[3]);
                    *(u32x2*)(OG + orow + 16 * dt + 4 * g4) = wv;
                }
#undef ATT_LDV
#undef ATT_TRV
            }
            if (g4 == 0) LSE[((size_t)g * MTOK + qtok) * NH + h] = mx * 0.6931471805599453f + __logf(l);
        }
    }
    __syncthreads();
    if (F.tid == 0) { MISCw[8] = keep0; MISCw[9] = keep1; }
    __syncthreads();
}

__device__ __forceinline__ void combine_phase(Frame& F) {
    const bf16* OG = (const bf16*)(F.ws + WS_OG); const float* LSE = (const float*)(F.ws + WS_LSE); bf16* ATT = (bf16*)(F.ws + WS_ATT);
    const int gw = F.vcu * 8 + F.wave, NGW = F.G * 8, lane = F.lane;
    for (int m = gw; m < MTOK; m += NGW) {
#pragma unroll
        for (int j = 0; j < 4; ++j) { const int c = lane + 64 * j, h = c >> 4;
            const float l0 = LSE[(size_t)m * NH + h], l1 = LSE[((size_t)MTOK + m) * NH + h], l2 = LSE[((size_t)2 * MTOK + m) * NH + h];
            const float mx = fmaxf(l0, fmaxf(l1, l2)); float w0 = __expf(l0 - mx), w1 = __expf(l1 - mx), w2 = __expf(l2 - mx); const float rs = 1.0f / (w0 + w1 + w2); w0 *= rs; w1 *= rs; w2 *= rs;
            const u32x4 a = *(const u32x4*)(OG + (size_t)m * D + c * 8), b = *(const u32x4*)(OG + ((size_t)MTOK + m) * D + c * 8), d = *(const u32x4*)(OG + ((size_t)2 * MTOK + m) * D + c * 8);
            u32x4 o;
#pragma unroll
            for (int e = 0; e < 4; ++e) { const float lo = w0 * bf_lo(a[e]) + w1 * bf_lo(b[e]) + w2 * bf_lo(d[e]), hi = w0 * bf_hi(a[e]) + w1 * bf_hi(b[e]) + w2 * bf_hi(d[e]); o[e] = cvt_pk_bf16(lo, hi); }
            *(u32x4*)(ATT + (size_t)m * D + c * 8) = o; }
    }
}
__device__ __forceinline__ void moe_convert_phase(Frame& F, const Args& a) {
    const int gw = F.vcu * 8 + F.wave, NGW = F.G * 8, lane = F.lane; int it0 = 0;
    bf16* W13 = (bf16*)(F.ws + WS_MW13); bf16* W2 = (bf16*)(F.ws + WS_MW2);
    for (int e = 0; e < NE; ++e) {
        cvt_matrix(a.in[16] + (size_t)e * D * FF, D, FF, W13 + (size_t)e * FF2 * D, D, MapGU{0}, it0, gw, NGW, lane);
        cvt_matrix(a.in[17] + (size_t)e * D * FF, D, FF, W13 + (size_t)e * FF2 * D, D, MapGU{1}, it0, gw, NGW, lane);
        cvt_matrix(a.in[18] + (size_t)e * FF * D, FF, D, W2 + (size_t)e * D * FF, FF, MapId{}, it0, gw, NGW, lane);
    }
}

__device__ __forceinline__ void ln_core(f32x4 (&v)[8], const f32x4 (&gg)[8], const f32x4 (&bb)[8]) {
    float s = 0.f;
#pragma unroll
    for (int j = 0; j < 8; ++j) s += (v[j][0] + v[j][1]) + (v[j][2] + v[j][3]);
    const float mean = wave_sum(s) * (1.f / D); float s2 = 0.f;
#pragma unroll
    for (int j = 0; j < 8; ++j) { v[j] = v[j] - mean; s2 += (v[j][0] * v[j][0] + v[j][1] * v[j][1]) + (v[j][2] * v[j][2] + v[j][3] * v[j][3]); }
    const float rstd = 1.0f / sqrtf(wave_sum(s2) * (1.f / D) + LN_EPS);
#pragma unroll
    for (int j = 0; j < 8; ++j) v[j] = v[j] * rstd * gg[j] + bb[j];
}
__device__ __forceinline__ void ln_store(const f32x4 (&v)[8], bf16* xb, int lane) {
#pragma unroll
    for (int j = 0; j < 8; ++j) { u32x2 w; w.x = cvt_pk_bf16(v[j][0], v[j][1]); w.y = cvt_pk_bf16(v[j][2], v[j][3]); *(u32x2*)(xb + 4 * lane + 256 * j) = w; }
}
__device__ __forceinline__ void ln_load_gb8(const float* gam, const float* bet, f32x4 (&gg)[8], f32x4 (&bb)[8], int lane) {
#pragma unroll
    for (int j = 0; j < 4; ++j) { const int c = (lane + 64 * j) * 8; gg[2 * j] = *(const f32x4*)(gam + c); gg[2 * j + 1] = *(const f32x4*)(gam + c + 4); bb[2 * j] = *(const f32x4*)(bet + c); bb[2 * j + 1] = *(const f32x4*)(bet + c + 4); }
}
__device__ __forceinline__ void ln_store8(const f32x4 (&v)[8], bf16* xb, int lane) {
#pragma unroll
    for (int j = 0; j < 4; ++j) { u32x4 w; w.x = cvt_pk_bf16(v[2 * j][0], v[2 * j][1]); w.y = cvt_pk_bf16(v[2 * j][2], v[2 * j][3]); w.z = cvt_pk_bf16(v[2 * j + 1][0], v[2 * j + 1][1]); w.w = cvt_pk_bf16(v[2 * j + 1][2], v[2 * j + 1][3]);
        *(u32x4*)(xb + (lane + 64 * j) * 8) = w; }
}
__device__ __forceinline__ void ln_unpack8(const u32x4 (&w)[4], f32x4 (&v)[8]) {
#pragma unroll
    for (int j = 0; j < 4; ++j) { v[2 * j] = (f32x4){bf_lo(w[j].x), bf_hi(w[j].x), bf_lo(w[j].y), bf_hi(w[j].y)}; v[2 * j + 1] = (f32x4){bf_lo(w[j].z), bf_hi(w[j].z), bf_lo(w[j].w), bf_hi(w[j].w)}; }
}
__device__ __forceinline__ void ln_phase(Frame& F, const bf16* YB, const float* gam, const float* bet, bf16* XB) {
    const int gw = F.vcu * 8 + F.wave, NGW = F.G * 8, lane = F.lane;
    f32x4 gg[8], bb[8]; ln_load_gb8(gam, bet, gg, bb, lane);
    for (int m = gw; m < MTOK; m += 2 * NGW) {
        const int m2 = m + NGW; const bool has2 = m2 < MTOK;
        u32x4 wa[4], wb[4];
#pragma unroll
        for (int j = 0; j < 4; ++j) wa[j] = *(const u32x4*)(YB + (size_t)m * D + (lane + 64 * j) * 8);
#pragma unroll
        for (int j = 0; j < 4; ++j) wb[j] = *(const u32x4*)(YB + (size_t)(has2 ? m2 : m) * D + (lane + 64 * j) * 8);
        f32x4 v[8];
        ln_unpack8(wa, v); ln_core(v, gg, bb); ln_store8(v, XB + (size_t)m * D, lane);
        if (has2) { ln_unpack8(wb, v); ln_core(v, gg, bb); ln_store8(v, XB + (size_t)m2 * D, lane); }
    }
}
template <int J> __device__ __forceinline__ void pool_chunk8(const bf16* U, bf16* MIX, int m0, int t0, int lane) {
    constexpr int W = 2 << J, NR = W + 7;
    const int c = lane + 64 * J;
    u32x4 x[NR];
#pragma unroll
    for (int i = 0; i < NR; ++i) { const int dt = i - (W - 1); x[i] = *(const u32x4*)(U + (size_t)(m0 + ((t0 + dt >= 0) ? dt : 0)) * D + c * 8); }
    float sum[8];
#pragma unroll
    for (int e = 0; e < 8; ++e) sum[e] = 0.f;
#pragma unroll
    for (int i = 0; i < W - 1; ++i) { const float k = (t0 + i - (W - 1) >= 0) ? 1.f : 0.f;
#pragma unroll
        for (int e = 0; e < 4; ++e) { sum[2 * e] += k * bf_lo(x[i][e]); sum[2 * e + 1] += k * bf_hi(x[i][e]); } }
#pragma unroll
    for (int rr = 0; rr < 8; ++rr) {
        const int t = t0 + rr; const u32x4 cur = x[W - 1 + rr];
#pragma unroll
        for (int e = 0; e < 4; ++e) { sum[2 * e] += bf_lo(cur[e]); sum[2 * e + 1] += bf_hi(cur[e]); }
        const int cnt = (t + 1 < W) ? t + 1 : W; const float rc = 1.0f / (float)cnt; u32x4 o;
#pragma unroll
        for (int e = 0; e < 4; ++e) o[e] = cvt_pk_bf16(sum[2 * e] * rc - bf_lo(cur[e]), sum[2 * e + 1] * rc - bf_hi(cur[e]));
        *(u32x4*)(MIX + (size_t)(m0 + rr) * D + c * 8) = o;
        const float k = (t - (W - 1) >= 0) ? 1.f : 0.f;
#pragma unroll
        for (int e = 0; e < 4; ++e) { sum[2 * e] -= k * bf_lo(x[rr][e]); sum[2 * e + 1] -= k * bf_hi(x[rr][e]); }
    }
}
__device__ __forceinline__ void pool_phase(Frame& F) {
    const bf16* U = (const bf16*)(F.ws + WS_U); bf16* MIX = (bf16*)(F.ws + WS_MIX);
    const int gw = F.vcu * 8 + F.wave, NGW = F.G * 8, lane = F.lane;
    for (int m0 = gw * 8; m0 < MTOK; m0 += NGW * 8) { const int t0 = m0 & (SEQ - 1);
        pool_chunk8<0>(U, MIX, m0, t0, lane); pool_chunk8<1>(U, MIX, m0, t0, lane); pool_chunk8<2>(U, MIX, m0, t0, lane); pool_chunk8<3>(U, MIX, m0, t0, lane); }
}
__device__ __forceinline__ void ln_router_phase(Frame& F, const float* Y, const float* gam, const float* bet, const float* wrt, bf16* XB) {
    const int gw = F.vcu * 8 + F.wave, NGW = F.G * 8, lane = F.lane, tid = F.tid;
    LAS float* WR = (LAS float*)F.lds;
    LAS int* cntl = (LAS int*)(F.lds + 65536);
    LAS int* info = (LAS int*)(F.lds + 65536 + 64);
    int* LIST = (int*)(F.ws + WS_LIST); int* TOK = (int*)(F.ws + WS_TOK); unsigned* gcnt = (unsigned*)(F.ws + WS_CTL) + CW_CNT;
    __syncthreads();
    for (int i = tid; i < D * NE; i += 512) { const int c = i >> 3, e = i & 7; WR[e * D + c] = wrt[i]; }
    if (tid < 16) cntl[tid] = 0;
    __syncthreads();
    f32x4 gg[8], bb[8];
#pragma unroll
    for (int j = 0; j < 8; ++j) { gg[j] = *(const f32x4*)(gam + 4 * lane + 256 * j); bb[j] = *(const f32x4*)(bet + 4 * lane + 256 * j); }
    int k = 0;
    f32x4 vn[8];
#pragma unroll
    for (int j = 0; j < 8; ++j) vn[j] = *(const f32x4*)(Y + (size_t)(gw < MTOK ? gw : 0) * D + 4 * lane + 256 * j);
    for (int m = gw; m < MTOK; m += NGW, ++k) {
        f32x4 v[8];
#pragma unroll
        for (int j = 0; j < 8; ++j) v[j] = vn[j];
        { const int mn = (m + NGW < MTOK) ? m + NGW : m;
#pragma unroll
          for (int j = 0; j < 8; ++j) vn[j] = *(const f32x4*)(Y + (size_t)mn * D + 4 * lane + 256 * j); }
        ln_core(v, gg, bb); ln_store(v, XB + (size_t)m * D, lane);
        float lg[8];
#pragma unroll
        for (int e = 0; e < 8; ++e) { float s = 0.f;
#pragma unroll
            for (int j = 0; j < 8; ++j) { const f32x4 wv = *(const LAS f32x4*)(WR + e * D + 4 * lane + 256 * j); s += (v[j][0] * wv[0] + v[j][1] * wv[1]) + (v[j][2] * wv[2] + v[j][3] * wv[3]); }
            lg[e] = wave_sum(s); }
        int e1 = 0; float v1 = lg[0];
#pragma unroll
        for (int e = 1; e < 8; ++e) if (lg[e] > v1) { v1 = lg[e]; e1 = e; }
        int e2 = -1; float v2 = -__builtin_inff();
#pragma unroll
        for (int e = 0; e < 8; ++e) if (e != e1 && lg[e] > v2) { v2 = lg[e]; e2 = e; }
        if (lane == 0 && k < 8) { const float ex = __expf(v2 - v1), g1 = 1.0f / (1.0f + ex), g2 = ex * g1;
            const int ls1 = atomicAdd((int*)&cntl[e1], 1), ls2 = atomicAdd((int*)&cntl[e2], 1);
            LAS int* q = info + (F.wave * 8 + k) * 8; q[0] = m; q[1] = e1; q[2] = e2; q[3] = ls1; q[4] = ls2; q[5] = __float_as_int(g1); q[6] = __float_as_int(g2); }
    }
    const int nrows = k < 8 ? k : 8;
    if (lane == 0) info[512 + F.wave] = nrows;
    __syncthreads();
    if (tid < 8) cntl[8 + tid] = (int)__hip_atomic_fetch_add(gcnt + 64 * tid, (unsigned)cntl[tid], __ATOMIC_RELAXED, __HIP_MEMORY_SCOPE_AGENT);
    __syncthreads();
    if (tid < 64) { const int wv = tid >> 3, kk = tid & 7;
        if (kk < info[512 + wv]) { const LAS int* q = info + tid * 8; const int m = q[0], e1 = q[1], e2 = q[2], s1 = cntl[8 + e1] + q[3], s2 = cntl[8 + e2] + q[4];
            LIST[e1 * MTOK + s1] = m; LIST[e2 * MTOK + s2] = m;
            int* t = TOK + (size_t)m * 8; t[0] = e1; t[1] = s1; t[2] = q[5]; t[3] = e2; t[4] = s2; t[5] = q[6]; } }
    __syncthreads();
}
__device__ __forceinline__ void moe_prefix(Frame& F, int (&tb)[9], int (&cnt)[8]) {
    const unsigned* gcnt = (const unsigned*)(F.ws + WS_CTL) + CW_CNT; tb[0] = 0;
#pragma unroll
    for (int e = 0; e < 8; ++e) { cnt[e] = (int)__builtin_amdgcn_readfirstlane(gcnt[64 * e]); tb[e + 1] = tb[e] + ((cnt[e] + 255) >> 8); }
}
__device__ __forceinline__ void moe_fill_idx(Frame& F, const pg8::MoeOrder& S, const int (&tb)[9], const int (&cnt)[8]) {
    LAS unsigned short* idx = (LAS unsigned short*)(F.lds + pg8::IDX_LDS_OFF); const int* LIST = (const int*)(F.ws + WS_LIST);
    const int row = F.tid & 255, sub = F.tid >> 8;
    for (int ui = 0; ui < 30; ui += 2) {
        pg8::Unit u0; if (!S.next(ui, u0)) break;
        pg8::Unit u; const int uu = ui + sub;
        if (S.next(uu, u)) { int base = 0, ce = 0;
#pragma unroll
            for (int j = 0; j < 8; ++j) if (j == u.e) { base = tb[j]; ce = cnt[j]; }
            const int sidx = (u.pm - base) * 256 + row; const int tok = LIST[u.e * MTOK + (sidx < ce ? sidx : 0)];
            idx[uu * 256 + row] = (unsigned short)tok; }
    }
    __syncthreads();
}
__device__ __forceinline__ int gather_src(const int (&tb)[9], const int (&cnt)[8], const int* LIST, int rr) {
    const int tile = rr >> 8; int e = 0;
#pragma unroll
    for (int j = 1; j < 8; ++j) e += (tile >= tb[j]) ? 1 : 0;
    int base = 0, ce = 0;
#pragma unroll
    for (int j = 0; j < 8; ++j) if (j == e) { base = tb[j] * 256; ce = cnt[j]; }
    const int sidx = rr - base; return (sidx < ce) ? LIST[e * MTOK + sidx] : -1;
}
__device__ __forceinline__ void gather_phase(Frame& F) {
    const int gw = F.vcu * 8 + F.wave, NGW = F.G * 8, lane = F.lane;
    int tb[9], cnt[8]; moe_prefix(F, tb, cnt);
    const int* LIST = (const int*)(F.ws + WS_LIST); const bf16* XB = (const bf16*)(F.ws + WS_XB0); bf16* XG = (bf16*)(F.ws + WS_XG);
    const int rows = tb[8] * 256;
    for (int rr = gw; rr < rows; rr += 4 * NGW) {
        int tk[4];
#pragma unroll
        for (int k = 0; k < 4; ++k) { const int r = rr + k * NGW; tk[k] = (r < rows) ? gather_src(tb, cnt, LIST, r) : -2; }
        u32x4 v[4][4];
#pragma unroll
        for (int k = 0; k < 4; ++k)
#pragma unroll
            for (int j = 0; j < 4; ++j) v[k][j] = (tk[k] >= 0) ? *(const u32x4*)(XB + (size_t)tk[k] * D + (lane + 64 * j) * 8) : (u32x4){0u, 0u, 0u, 0u};
#pragma unroll
        for (int k = 0; k < 4; ++k) if (tk[k] != -2) {
#pragma unroll
            for (int j = 0; j < 4; ++j) *(u32x4*)(XG + (size_t)(rr + k * NGW) * D + (lane + 64 * j) * 8) = v[k][j]; }
    }
}
struct MoeRow { int r1, r2; float g1, g2; };
__device__ __forceinline__ MoeRow moe_row_info(const int* TOK, const int (&tb)[9], int m) {
    const int* t = TOK + (size_t)m * 8; const int e1 = t[0], s1 = t[1], e2 = t[3], s2 = t[4]; MoeRow r; r.g1 = __int_as_float(t[2]); r.g2 = __int_as_float(t[5]);
    int b1 = 0, b2 = 0;
#pragma unroll
    for (int j = 0; j < 8; ++j) { if (j == e1) b1 = tb[j] * 256; if (j == e2) b2 = tb[j] * 256; }
    r.r1 = b1 + s1; r.r2 = b2 + s2; return r;
}
__device__ __forceinline__ void ln_moe_phase(Frame& F, const bf16* X4, const float* gam, const float* bet, bf16* XB) {
    const int gw = F.vcu * 8 + F.wave, NGW = F.G * 8, lane = F.lane;
    int tb[9], cnt[8]; moe_prefix(F, tb, cnt);
    const int* TOK = (const int*)(F.ws + WS_TOK); const bf16* YE = (const bf16*)(F.ws + WS_XG); const bf16* YEP = (const bf16*)(F.ws + WS_YEP); constexpr size_t QSTR = (size_t)8 * 256 * D;
    const int split0 = (((8 * tb[8]) / F.G) * F.G >> 3) * 256;
    f32x4 gg[8], bb[8]; ln_load_gb8(gam, bet, gg, bb, lane);
    for (int m0 = gw; m0 < MTOK; m0 += 2 * NGW) {
        const bool has2 = (m0 + NGW) < MTOK; const int mm[2] = {m0, has2 ? m0 + NGW : m0};
        MoeRow ri[2]; ri[0] = moe_row_info(TOK, tb, mm[0]); ri[1] = moe_row_info(TOK, tb, mm[1]);
        u32x4 xw[2][4], aw[2][4], bw[2][4]; const bf16* y1[2]; const bf16* y2[2]; bool p1[2], p2[2];
#pragma unroll
        for (int q = 0; q < 2; ++q) { p1[q] = ri[q].r1 >= split0; p2[q] = ri[q].r2 >= split0;
            y1[q] = p1[q] ? YEP + (size_t)(ri[q].r1 - split0) * D : YE + (size_t)ri[q].r1 * D; y2[q] = p2[q] ? YEP + (size_t)(ri[q].r2 - split0) * D : YE + (size_t)ri[q].r2 * D;
#pragma unroll
            for (int j = 0; j < 4; ++j) { const int c = (lane + 64 * j) * 8; xw[q][j] = *(const u32x4*)(X4 + (size_t)mm[q] * D + c); aw[q][j] = *(const u32x4*)(y1[q] + c); bw[q][j] = *(const u32x4*)(y2[q] + c); } }
#pragma unroll
        for (int q = 0; q < 2; ++q) { if (q == 1 && !has2) break;
            const float g1 = ri[q].g1, g2 = ri[q].g2; f32x4 v[8];
#pragma unroll
            for (int j = 0; j < 4; ++j) { const int c = (lane + 64 * j) * 8; const u32x4 x = xw[q][j], a = aw[q][j], b = bw[q][j];
                float fa[8], fb[8];
#pragma unroll
                for (int e = 0; e < 4; ++e) { fa[2 * e] = bf_lo(a[e]); fa[2 * e + 1] = bf_hi(a[e]); fb[2 * e] = bf_lo(b[e]); fb[2 * e + 1] = bf_hi(b[e]); }
                if (p1[q]) {
#pragma unroll
                    for (int kq = 1; kq < 4; ++kq) { const u32x4 t4 = *(const u32x4*)(y1[q] + (size_t)kq * QSTR + c);
#pragma unroll
                        for (int e = 0; e < 4; ++e) { fa[2 * e] += bf_lo(t4[e]); fa[2 * e + 1] += bf_hi(t4[e]); } } }
                if (p2[q]) {
#pragma unroll
                    for (int kq = 1; kq < 4; ++kq) { const u32x4 t4 = *(const u32x4*)(y2[q] + (size_t)kq * QSTR + c);
#pragma unroll
                        for (int e = 0; e < 4; ++e) { fb[2 * e] += bf_lo(t4[e]); fb[2 * e + 1] += bf_hi(t4[e]); } } }
#pragma unroll
                for (int e = 0; e < 4; ++e) { const float lo = DN_ALPHA * bf_lo(x[e]) + g1 * fa[2 * e] + g2 * fb[2 * e], hi = DN_ALPHA * bf_hi(x[e]) + g1 * fa[2 * e + 1] + g2 * fb[2 * e + 1];
                    v[2 * j + (e >> 1)][(e & 1) * 2] = lo; v[2 * j + (e >> 1)][(e & 1) * 2 + 1] = hi; } }
            ln_core(v, gg, bb); ln_store8(v, XB + (size_t)mm[q] * D, lane);
        }
    }
}

constexpr int NPHASE = 19;
__global__ void __launch_bounds__(512, 2) fwd_kernel(Args args) {
    extern __shared__ __attribute__((aligned(16))) unsigned char lds[];
    Frame F; F.lds = (LAS unsigned char*)lds; F.tid = threadIdx.x; F.lane = F.tid & 63; F.wave = __builtin_amdgcn_readfirstlane(F.tid >> 6);
    F.G = gridDim.x; { const int bx = blockIdx.x; F.vcu = (F.G % 8 == 0) ? (bx % 8) * (F.G / 8) + bx / 8 : bx; }
    F.ws = args.ws; unsigned char* ws = args.ws;
    volatile LAS unsigned* MISC = (volatile LAS unsigned*)(F.lds + MISC_OFF);
    for (int u = F.tid; u < (LDS_BYTES - LDSCTL_OFF) / 4; u += 512) ((LAS unsigned*)(F.lds + LDSCTL_OFF))[u] = 0u;
    __syncthreads();
    XcdBarrier bar; bar.bar = (unsigned*)(ws + WS_CTL) + CW_BAR; bar.x = 0; bar.st = nullptr;
    if (args.ph_hi - args.ph_lo > 1) bar = xcd_barrier_post((unsigned*)(ws + WS_CTL) + CW_BAR, MISC + 8);
    const int lo = args.ph_lo, hi = args.ph_hi;
#define IN(k) (lo <= (k) && (k) < hi)
    long long pht0 = 0, pht1 = 0; if (PHT_SEL == 0) pht0 = wall_clock64();
#define SEAM(k) do { if (IN(k) && IN((k) + 1)) xcd_barrier(bar); if (PHT_SEL == (k) + 1) pht0 = wall_clock64(); if (PHT_SEL == (k)) pht1 = wall_clock64(); } while (0)
    LAS unsigned char* ring = F.lds;
    const int bx = (int)blockIdx.x;
    bf16* XB0 = (bf16*)(ws + WS_XB0); bf16* XB1 = (bf16*)(ws + WS_XB1); bf16* YB = (bf16*)(ws + WS_YB); float* Y = args.out;

    if (IN(0)) { p0_prologue(F, args); }
    if constexpr ((DUP_MASK >> 0) & 1u) { if (IN(0)) { p0_prologue(F, args); } }
    SEAM(0);
    if (IN(1)) {
        { pg8::Gemm g{XB0, (const bf16*)(ws + WS_WQKV), D, D, D}; pg8::StaticOrder S; S.init(MTOK, NQKV, F.G, bx);
          pg8::EpiQKV E{(bf16*)(ws + WS_QKV), (const float*)(ws + WS_ROPE)}; pg8::gemm_phase(ring, g, S, E); }
        { pg8::Gemm g{(const bf16*)(ws + WS_PB), (const bf16*)(ws + WS_WPROJ), PLE, PLE, PLE}; pg8::BatchOrder S; S.init(MTOK, D, 2, (size_t)MTOK * PLE, (size_t)D * PLE, F.G, bx);
          pg8::EpiBf16 E{(bf16*)(ws + WS_PPROJ), D, (size_t)MTOK * D, 0}; pg8::gemm_phase(ring, g, S, E); }
        {
          pg8::Gemm g{(const bf16*)(ws + WS_WO2), (const bf16*)(ws + WS_WGS), 512, D, 512}; pg8::BatchOrder S; S.init(D, 512, 4, (size_t)512, (size_t)512 * 512, F.G, bx);
          pg8::EpiBf16 E{(bf16*)(ws + WS_WCOMB), D, (size_t)0, 512}; pg8::gemm_phase(ring, g, S, E); }
    }
    if constexpr ((DUP_MASK >> 1) & 1u) { if (IN(1)) {
        { pg8::Gemm g{XB0, (const bf16*)(ws + WS_WQKV), D, D, D}; pg8::StaticOrder S; S.init(MTOK, NQKV, F.G, bx);
          pg8::EpiQKV E{(bf16*)(ws + WS_QKV), (const float*)(ws + WS_ROPE)}; pg8::gemm_phase(ring, g, S, E); }
        { pg8::Gemm g{(const bf16*)(ws + WS_PB), (const bf16*)(ws + WS_WPROJ), PLE, PLE, PLE}; pg8::BatchOrder S; S.init(MTOK, D, 2, (size_t)MTOK * PLE, (size_t)D * PLE, F.G, bx);
          pg8::EpiBf16 E{(bf16*)(ws + WS_PPROJ), D, (size_t)MTOK * D, 0}; pg8::gemm_phase(ring, g, S, E); }
        {
          pg8::Gemm g{(const bf16*)(ws + WS_WO2), (const bf16*)(ws + WS_WGS), 512, D, 512}; pg8::BatchOrder S; S.init(D, 512, 4, (size_t)512, (size_t)512 * 512, F.G, bx);
          pg8::EpiBf16 E{(bf16*)(ws + WS_WCOMB), D, (size_t)0, 512}; pg8::gemm_phase(ring, g, S, E); }
    } }
    SEAM(1);
    if (IN(2)) { attn_phase(F); }
    if constexpr ((DUP_MASK >> 2) & 1u) { if (IN(2)) { attn_phase(F); } }
    SEAM(2);
    if (IN(3)) { combine_phase(F); }
    if constexpr ((DUP_MASK >> 3) & 1u) { if (IN(3)) { combine_phase(F); } }
    SEAM(3);
    if (IN(4)) { pg8::Gemm g{(const bf16*)(ws + WS_ATT), (const bf16*)(ws + WS_WO), D, D, D}; pg8::StaticOrder S; S.init(MTOK, D, F.G, bx);
        pg8::EpiRes<false> E{XB0, YB, D, DN_ALPHA}; pg8::gemm_phase(ring, g, S, E); }
    if constexpr ((DUP_MASK >> 4) & 1u) { if (IN(4)) { pg8::Gemm g{(const bf16*)(ws + WS_ATT), (const bf16*)(ws + WS_WO), D, D, D}; pg8::StaticOrder S; S.init(MTOK, D, F.G, bx);
        pg8::EpiRes<false> E{XB0, YB, D, DN_ALPHA}; pg8::gemm_phase(ring, g, S, E); } }
    SEAM(4);
    if (IN(5)) { ln_phase(F, YB, args.in[8], args.in[9], XB0); }
    if constexpr ((DUP_MASK >> 5) & 1u) { if (IN(5)) { ln_phase(F, YB, args.in[8], args.in[9], XB0); } }
    SEAM(5);
    if (IN(6)) { pg8::Gemm g{XB0, (const bf16*)(ws + WS_W13), D, D, D}; pg8::HostOrder S; S.init(MTOK, FF2, F.G, bx);
        S.w1 = args.in[16]; S.w3 = args.in[17]; S.w2 = args.in[18]; S.W13 = (bf16*)(ws + WS_MW13); S.W2 = (bf16*)(ws + WS_MW2); S.slot = F.vcu % 11; S.share = F.vcu; S.nshare = F.G;
        pg8::EpiSwiGLU E{(bf16*)(ws + WS_H), FF}; pg8::gemm_phase<pg8::EpiSwiGLU, pg8::HostOrder, true, true, (STAMP_SEL != 0)>(ring, g, S, E, (unsigned long long*)(ws + WS_CTL + 512 * 1024)); }
    if constexpr ((DUP_MASK >> 6) & 1u) { if (IN(6)) { pg8::Gemm g{XB0, (const bf16*)(ws + WS_W13), D, D, D}; pg8::StaticOrder S; S.init(MTOK, FF2, F.G, bx);
        pg8::EpiSwiGLU E{(bf16*)(ws + WS_H), FF}; pg8::gemm_phase(ring, g, S, E); } }
    SEAM(6);
    if (IN(7)) { pg8::Gemm g{(const bf16*)(ws + WS_H), (const bf16*)(ws + WS_W2), FF, FF, FF}; pg8::StaticOrder S; S.init(MTOK, D, F.G, bx);
        pg8::EpiRes<false> E{XB0, YB, D, DN_ALPHA}; pg8::gemm_phase(ring, g, S, E); }
    if constexpr ((DUP_MASK >> 7) & 1u) { if (IN(7)) { pg8::Gemm g{(const bf16*)(ws + WS_H), (const bf16*)(ws + WS_W2), FF, FF, FF}; pg8::StaticOrder S; S.init(MTOK, D, F.G, bx);
        pg8::EpiRes<false> E{XB0, YB, D, DN_ALPHA}; pg8::gemm_phase(ring, g, S, E); } }
    SEAM(7);
    if (IN(8)) { ln_phase(F, YB, args.in[10], args.in[11], XB0); }
    if constexpr ((DUP_MASK >> 8) & 1u) { if (IN(8)) { ln_phase(F, YB, args.in[10], args.in[11], XB0); } }
    SEAM(8);
    if (IN(9)) { pg8::Gemm g{XB0, (const bf16*)(ws + WS_WGATE), D, D, D}; pg8::StaticOrder S; S.init(MTOK, D, F.G, bx);
        pg8::EpiPle E{XB0, (const bf16*)(ws + WS_PPROJ), args.in[21], nullptr, XB1, D}; pg8::gemm_phase(ring, g, S, E); }
    if constexpr ((DUP_MASK >> 9) & 1u) { if (IN(9)) { pg8::Gemm g{XB0, (const bf16*)(ws + WS_WGATE), D, D, D}; pg8::StaticOrder S; S.init(MTOK, D, F.G, bx);
        pg8::EpiPle E{XB0, (const bf16*)(ws + WS_PPROJ), args.in[21], nullptr, XB1, D}; pg8::gemm_phase(ring, g, S, E); } }
    SEAM(9);
    if (IN(10)) { pg8::Gemm g{XB1, (const bf16*)(ws + WS_WIN), D, D, D}; pg8::StaticOrder S; S.init(MTOK, D, F.G, bx);
        pg8::EpiBf16 E{(bf16*)(ws + WS_U), D, (size_t)0, 0}; pg8::gemm_phase(ring, g, S, E); }
    if constexpr ((DUP_MASK >> 10) & 1u) { if (IN(10)) { pg8::Gemm g{XB1, (const bf16*)(ws + WS_WIN), D, D, D}; pg8::StaticOrder S; S.init(MTOK, D, F.G, bx);
        pg8::EpiBf16 E{(bf16*)(ws + WS_U), D, (size_t)0, 0}; pg8::gemm_phase(ring, g, S, E); } }
    SEAM(10);
    if (IN(11)) { pool_phase(F); }
    if constexpr ((DUP_MASK >> 11) & 1u) { if (IN(11)) { pool_phase(F); } }
    SEAM(11);
    if (IN(12)) { pg8::Gemm g{(const bf16*)(ws + WS_MIX), (const bf16*)(ws + WS_WCOMB), D, D, D}; pg8::StaticOrder S; S.init(MTOK, D, F.G, bx);
        pg8::EpiRes<true> E{XB1, Y, D, DN_ALPHA}; pg8::gemm_phase(ring, g, S, E); }
    if constexpr ((DUP_MASK >> 12) & 1u) { if (IN(12)) { pg8::Gemm g{(const bf16*)(ws + WS_MIX), (const bf16*)(ws + WS_WCOMB), D, D, D}; pg8::StaticOrder S; S.init(MTOK, D, F.G, bx);
        pg8::EpiRes<true> E{XB1, Y, D, DN_ALPHA}; pg8::gemm_phase(ring, g, S, E); } }
    SEAM(12);
    if (IN(13)) { ln_router_phase(F, Y, args.in[8] + D, args.in[9] + D, args.in[15], XB0); }
    if constexpr ((DUP_MASK >> 13) & 1u) { if (IN(13)) { ln_router_phase(F, Y, args.in[8] + D, args.in[9] + D, args.in[15], XB0); } }
    SEAM(13);
    if (PHT_SEL == 15) pht0 = wall_clock64();
    if (IN(15)) { int tb[9], cnt[8]; moe_prefix(F, tb, cnt);
        pg8::Gemm g{XB0, (const bf16*)(ws + WS_MW13), D, D, D}; pg8::MoeOrder S; S.nM = tb[8]; S.nN = FF2 / 256; S.nwg = S.nM * S.nN; S.G = F.G; S.c = bx; S.sB = (size_t)FF2 * D; S.gather = true;
#pragma unroll
        for (int j = 0; j < 9; ++j) S.tb[j] = tb[j];
        moe_fill_idx(F, S, tb, cnt);
        pg8::EpiSwiGLU E{(bf16*)(ws + WS_HM), FF}; pg8::gemm_phase<pg8::EpiSwiGLU, pg8::MoeOrder, true, true, false, true>(ring, g, S, E); }
    if constexpr ((DUP_MASK >> 15) & 1u) { if (IN(15)) { int tb[9], cnt[8]; moe_prefix(F, tb, cnt);
        pg8::Gemm g{XB0, (const bf16*)(ws + WS_MW13), D, D, D}; pg8::MoeOrder S; S.nM = tb[8]; S.nN = FF2 / 256; S.nwg = S.nM * S.nN; S.G = F.G; S.c = bx; S.sB = (size_t)FF2 * D; S.gather = true;
#pragma unroll
        for (int j = 0; j < 9; ++j) S.tb[j] = tb[j];
        moe_fill_idx(F, S, tb, cnt);
        pg8::EpiSwiGLU E{(bf16*)(ws + WS_HM), FF}; pg8::gemm_phase<pg8::EpiSwiGLU, pg8::MoeOrder, true, true, false, true>(ring, g, S, E); } }
    SEAM(15);
    if (IN(16)) { int tb[9], cnt[8]; moe_prefix(F, tb, cnt);
        pg8::Gemm g{(const bf16*)(ws + WS_HM), (const bf16*)(ws + WS_MW2), FF, FF, FF}; pg8::MoeDownOrder S; S.nM = tb[8]; S.G = F.G; S.c = F.vcu; S.nfull = ((8 * tb[8]) / F.G) * F.G; S.kq_elems = FF / 4; S.kq_nt = FF / 4 / 64; S.sB = (size_t)D * FF;
#pragma unroll
        for (int j = 0; j < 9; ++j) S.tb[j] = tb[j];
        pg8::EpiMoeDown E{(bf16*)(ws + WS_XG), (bf16*)(ws + WS_YEP), S.nfull >> 3, (size_t)8 * 256 * D}; pg8::gemm_phase(ring, g, S, E); }
    if constexpr ((DUP_MASK >> 16) & 1u) { if (IN(16)) { int tb[9], cnt[8]; moe_prefix(F, tb, cnt);
        pg8::Gemm g{(const bf16*)(ws + WS_HM), (const bf16*)(ws + WS_MW2), FF, FF, FF}; pg8::MoeDownOrder S; S.nM = tb[8]; S.G = F.G; S.c = F.vcu; S.nfull = ((8 * tb[8]) / F.G) * F.G; S.kq_elems = FF / 4; S.kq_nt = FF / 4 / 64; S.sB = (size_t)D * FF;
#pragma unroll
        for (int j = 0; j < 9; ++j) S.tb[j] = tb[j];
        pg8::EpiMoeDown E{(bf16*)(ws + WS_XG), (bf16*)(ws + WS_YEP), S.nfull >> 3, (size_t)8 * 256 * D}; pg8::gemm_phase(ring, g, S, E); } }
    SEAM(16);
    if (IN(17)) { ln_moe_phase(F, XB0, args.in[10] + D, args.in[11] + D, XB1); }
    if constexpr ((DUP_MASK >> 17) & 1u) { if (IN(17)) { ln_moe_phase(F, XB0, args.in[10] + D, args.in[11] + D, XB1); } }
    SEAM(17);
    if (IN(18)) { pg8::Gemm g{XB1, (const bf16*)(ws + WS_WGATE) + (size_t)D * D, D, D, D}; pg8::StaticOrder S; S.init(MTOK, D, F.G, bx);
        pg8::EpiPle E{XB1, (const bf16*)(ws + WS_PPROJ) + (size_t)MTOK * D, args.in[21] + D, args.out, nullptr, D}; pg8::gemm_phase(ring, g, S, E); }
    if constexpr ((DUP_MASK >> 18) & 1u) { if (IN(18)) { pg8::Gemm g{XB1, (const bf16*)(ws + WS_WGATE) + (size_t)D * D, D, D, D}; pg8::StaticOrder S; S.init(MTOK, D, F.G, bx);
        pg8::EpiPle E{XB1, (const bf16*)(ws + WS_PPROJ) + (size_t)MTOK * D, args.in[21] + D, args.out, nullptr, D}; pg8::gemm_phase(ring, g, S, E); } }
    if (STAMP_SEL != 0 && blockIdx.x == 0 && F.tid == 0 && hi == NPHASE) { const unsigned long long us = ((volatile unsigned long long*)(ws + WS_CTL + 512 * 1024))[STAMP_SEL - 1]; const long long w0 = wall_clock64(); while ((unsigned long long)(wall_clock64() - w0) < us * 100ull) __builtin_amdgcn_s_sleep(32); }
    if (PHT_SEL >= 0 && blockIdx.x == 0 && F.tid == 0 && hi == NPHASE) { if (PHT_SEL == NPHASE - 1) pht1 = wall_clock64(); const long long w0 = wall_clock64(); while (wall_clock64() - w0 < PHT_MULT * (pht1 - pht0)) __builtin_amdgcn_s_sleep(32); }
#undef IN
#undef SEAM
}

extern "C" void kernel_launch(void* const* d_in, const int* in_sizes, int n_in, void* d_out, int out_size, void* d_ws, size_t ws_size, hipStream_t stream) {
    static int grid = 0; static bool one_launch = true;
    if (grid == 0) {
        if (n_in != 22 || out_size != MTOK * D || ws_size < WS_END) { fprintf(stderr, "kernel_launch: unexpected shapes (n_in %d, out %d, ws %zu < %zu)\n", n_in, out_size, ws_size, (size_t)WS_END); grid = -1; return; }
        int dev = 0, cus = 0, per_cu = 0;
        if (hipGetDevice(&dev) != hipSuccess || hipDeviceGetAttribute(&cus, hipDeviceAttributeMultiprocessorCount, dev) != hipSuccess) { grid = -1; return; }
        if (hipFuncSetAttribute((const void*)fwd_kernel, hipFuncAttributeMaxDynamicSharedMemorySize, LDS_BYTES) != hipSuccess) { fprintf(stderr, "kernel_launch: hipFuncSetAttribute failed\n"); grid = -1; return; }
        if (hipOccupancyMaxActiveBlocksPerMultiprocessor(&per_cu, (const void*)fwd_kernel, 512, LDS_BYTES) != hipSuccess || per_cu < 1) { fprintf(stderr, "kernel_launch: occupancy query says %d blocks per CU\n", per_cu); }
        (void)hipGetLastError();
        grid = 256;
        one_launch = (cus >= 256);
    }
    if (grid < 0) return;
    (void)hipMemsetAsync((char*)d_ws + WS_CTL, 0, CTL_ZERO_BYTES, stream);
    Args a{};
    for (int i = 0; i < 22; ++i) a.in[i] = (const float*)d_in[i];
    a.out = (float*)d_out; a.ws = (unsigned char*)d_ws;
    if (MK_PER_PHASE || !one_launch) { for (int p = 0; p < NPHASE; ++p) { a.ph_lo = p; a.ph_hi = p + 1; hipLaunchKernelGGL(fwd_kernel, dim3(grid), dim3(512), LDS_BYTES, stream, a); } }
    else { a.ph_lo = 0; a.ph_hi = NPHASE; hipLaunchKernelGGL(fwd_kernel, dim3(grid), dim3(512), LDS_BYTES, stream, a); }
}
```

```cpp
#include <hip/hip_runtime.h>
#include <cstdio>
#include <cstdint>

#ifndef MK_PER_PHASE
#define MK_PER_PHASE 0
#endif
#ifndef STAMP_SEL
#define STAMP_SEL 0
#endif
#ifndef PHT_SEL
#define PHT_SEL -1
#endif
#define PHT_MULT 4
#ifndef DUP_MASK
#define DUP_MASK 0u
#endif

#define LAS __attribute__((address_space(3)))
#define GAS __attribute__((address_space(1)))
typedef unsigned short bf16;
typedef short bf16x8 __attribute__((ext_vector_type(8)));
typedef short s16x4 __attribute__((ext_vector_type(4)));
typedef float f32x4 __attribute__((ext_vector_type(4)));
typedef float f32x2 __attribute__((ext_vector_type(2)));
typedef unsigned u32x4 __attribute__((ext_vector_type(4)));
typedef unsigned u32x2 __attribute__((ext_vector_type(2)));
typedef GAS unsigned gu32;

constexpr int D = 2048, BATCH = 4, SEQ = 4096, MTOK = BATCH * SEQ;
constexpr int NH = 16, HD = 128, NQKV = 3 * 3 * D;
constexpr int FF = 5632, FF2 = 2 * FF;
constexpr int NE = 8, PLE = 256;
constexpr float LN_EPS = 1e-5f;
constexpr float DN_ALPHA = 1.41421356237309515f;
constexpr int MOE_ROWS = 2 * MTOK + NE * 256;

constexpr size_t MiB = 1u << 20;
constexpr size_t WS_CTL = 0, CTL_ZERO_BYTES = 1 * MiB;
constexpr size_t WS_LIST = 1 * MiB;
constexpr size_t WS_TOK = 2 * MiB;
constexpr size_t WS_LSE = 3 * MiB;
constexpr size_t WS_ROPE = 6 * MiB;
constexpr size_t WS_WGATE = 8 * MiB;
constexpr size_t WS_WPROJ = 24 * MiB;
constexpr size_t WS_WIN = 26 * MiB;
constexpr size_t WS_WCOMB = 34 * MiB;
constexpr size_t WS_WO2 = 42 * MiB;
constexpr size_t WS_WGS = 50 * MiB;
constexpr size_t WS_PB = 52 * MiB;
constexpr size_t WS_PPROJ = 68 * MiB;
constexpr size_t WS_XB0 = 196 * MiB;
constexpr size_t WS_YB = 260 * MiB;
constexpr size_t WS_WQKV = 516 * MiB;
constexpr size_t WS_WO = 588 * MiB;
constexpr size_t WS_W13 = 596 * MiB;
constexpr size_t WS_W2 = 640 * MiB;
constexpr size_t WS_QKV = 662 * MiB;
constexpr size_t WS_OG = 1238 * MiB;
constexpr size_t WS_ATT = 1430 * MiB;
constexpr size_t WS_MW13 = 662 * MiB;
constexpr size_t WS_MW2 = 1014 * MiB;
constexpr size_t WS_H = 1238 * MiB;
constexpr size_t WS_XB1 = 1430 * MiB;
constexpr size_t WS_U = 1190 * MiB;
constexpr size_t WS_MIX = 1254 * MiB;
constexpr size_t WS_HM = 1190 * MiB;
constexpr size_t WS_XG = 516 * MiB;
constexpr size_t WS_YEP = 324 * MiB;
constexpr size_t WS_END = 1564 * MiB;
static_assert(WS_MW2 + (size_t)NE * D * FF * 2 <= WS_U && WS_HM + (size_t)MOE_ROWS * FF * 2 <= WS_END && WS_XG + (size_t)MOE_ROWS * D * 2 <= WS_QKV, "ws map");

constexpr int CW_CNT = 64;
constexpr int CW_BAR = 4096;

constexpr int RING_BYTES = 131072;
constexpr int LDSCTL_OFF = RING_BYTES, MISC_OFF = LDSCTL_OFF + 320;
constexpr int LDS_BYTES = 163840;

#define VM_WAIT() asm volatile("s_waitcnt vmcnt(0)" ::: "memory")
__device__ __forceinline__ unsigned cvt_pk_bf16(float lo, float hi) { unsigned r; asm volatile("v_cvt_pk_bf16_f32 %0, %1, %2" : "=v"(r) : "v"(lo), "v"(hi)); return r; }
__device__ __forceinline__ float bf_lo(unsigned w) { return __uint_as_float(w << 16); }
__device__ __forceinline__ float bf_hi(unsigned w) { return __uint_as_float(w & 0xffff0000u); }
__device__ __forceinline__ float wave_sum(float v) {
#pragma unroll
    for (int o = 1; o < 64; o <<= 1) v += __shfl_xor(v, o);
    return v;
}

namespace pg8 {
#define PG8_LAS __attribute__((address_space(3)))
typedef unsigned short bf16_t;
constexpr int BM = 256, BK = 64, HALF = 128, HTB = HALF * BK * 2, STAGE_BYTES = 8 * HTB, NXCD = 8, WGM = 8;

__host__ __device__ __forceinline__ int lds_byte(int r, int c) { const int st = (r >> 4) * 2 + (c >> 5), rr = r & 15, cc = c & 31, ob = rr * 64 + cc * 2; return st * 1024 + (ob ^ (((ob >> 9) & 1) << 5)); }
__host__ __device__ __forceinline__ void stage_rc(int b, int& R, int& C) { const int st = b / 1024, sb = b % 1024, swz = sb ^ (((sb >> 9) & 1) << 5); R = (st >> 1) * 16 + swz / 64; C = (st & 1) * 32 + (swz % 64) / 2; }
__host__ __device__ __forceinline__ int perm32(int rho) { const int n = rho >> 4, i = rho & 15; return 8 * (i >> 2) + 4 * n + (i & 3); }

struct Unit { int pm, pn, e; };
struct Gemm { const bf16_t* A; const bf16_t* Bt; int K, lda, ldb; };

__device__ __forceinline__ void tile_of(int wgid, int nM, int nN, int& pm, int& pn) {
    const int nwg = nM * nN;
    { const int q = nwg / NXCD, r = nwg % NXCD, xcd = wgid % NXCD, off = wgid / NXCD; wgid = (xcd < r ? xcd * (q + 1) : r * (q + 1) + (xcd - r) * q) + off; }
    const int nig = WGM * nN, gid = wgid / nig, fm = gid * WGM, gsz = (nM - fm) < WGM ? (nM - fm) : WGM;
    pm = fm + ((wgid % nig) % gsz); pn = (wgid % nig) / gsz;
}
struct StaticOrder {
    int nM, nN, nwg, G, c;
    __device__ __forceinline__ void init(int M, int N, int G_, int c_) { nM = M / BM; nN = N / BM; nwg = nM * nN; G = G_; c = c_; }
    __device__ __forceinline__ bool next(int i, Unit& u) const {
        const long L = (long)i * G + c; if (L >= nwg) return false;
        tile_of((int)L, nM, nN, u.pm, u.pn); u.e = 0; return true;
    }
    __device__ __forceinline__ const char* a_ptr(const Gemm& g, const Unit& u) const { return (const char*)g.A + (size_t)u.pm * BM * g.lda * 2; }
    __device__ __forceinline__ const char* b_ptr(const Gemm& g, const Unit& u) const { return (const char*)g.Bt + (size_t)u.pn * BM * g.ldb * 2; }
    __device__ __forceinline__ int unit_nt(const Gemm& g, const Unit&) const { return g.K / BK; }
};
struct BatchOrder {
    int nM, nN, nwg, nb, G, c; size_t sA, sB;
    __device__ __forceinline__ void init(int M, int N, int nb_, size_t sA_, size_t sB_, int G_, int c_) { nM = M / BM; nN = N / BM; nwg = nM * nN; nb = nb_; sA = sA_; sB = sB_; G = G_; c = c_; }
    __device__ __forceinline__ bool next(int i, Unit& u) const {
        const long L = (long)i * G + c; if (L >= (long)nwg * nb) return false;
        u.e = (int)(L / nwg); tile_of((int)(L % nwg), nM, nN, u.pm, u.pn); return true;
    }
    __device__ __forceinline__ const char* a_ptr(const Gemm& g, const Unit& u) const { return (const char*)(g.A + (size_t)u.e * sA) + (size_t)u.pm * BM * g.lda * 2; }
    __device__ __forceinline__ const char* b_ptr(const Gemm& g, const Unit& u) const { return (const char*)(g.Bt + (size_t)u.e * sB) + (size_t)u.pn * BM * g.ldb * 2; }
    __device__ __forceinline__ int unit_nt(const Gemm& g, const Unit&) const { return g.K / BK; }
};
struct MoeOrder {
    int nM, nN, nwg, G, c; size_t sB; int tb[9]; bool gather;
    __device__ __forceinline__ bool next(int i, Unit& u) const {
        const long L = (long)i * G + c; if (L >= nwg) return false;
        tile_of((int)L, nM, nN, u.pm, u.pn);
        int e = 0;
#pragma unroll
        for (int j = 1; j < 8; ++j) e += (u.pm >= tb[j]) ? 1 : 0;
        u.e = e; return true;
    }
    __device__ __forceinline__ const char* a_ptr(const Gemm& g, const Unit& u) const { return (const char*)g.A + (gather ? (size_t)0 : (size_t)u.pm * BM * g.lda * 2); }
    __device__ __forceinline__ const char* b_ptr(const Gemm& g, const Unit& u) const { return (const char*)(g.Bt + (size_t)u.e * sB) + (size_t)u.pn * BM * g.ldb * 2; }
    __device__ __forceinline__ int unit_nt(const Gemm& g, const Unit&) const { return g.K / BK; }
};

struct MoeDownOrder {
    int nM, G, c, nfull, kq_elems, kq_nt; size_t sB; int tb[9];
    __device__ __forceinline__ bool next(int i, Unit& u) const {
        const long L = (long)i * G + c; int kq1 = 0, uu;
        if (L < nfull) uu = (int)L;
        else { const long L2 = L - nfull; if (L2 >= 4l * (8 * nM - nfull)) return false; uu = nfull + (int)(L2 >> 2); kq1 = (int)(L2 & 3) + 1; }
        u.pm = uu >> 3; u.pn = uu & 7;
        int e = 0;
#pragma unroll
        for (int j = 1; j < 8; ++j) e += (u.pm >= tb[j]) ? 1 : 0;
        u.e = e | (kq1 << 8); return true;
    }
    __device__ __forceinline__ const char* a_ptr(const Gemm& g, const Unit& u) const { const int kq1 = u.e >> 8; return (const char*)g.A + ((size_t)u.pm * BM * g.lda + (size_t)(kq1 ? (kq1 - 1) * kq_elems : 0)) * 2; }
    __device__ __forceinline__ const char* b_ptr(const Gemm& g, const Unit& u) const { const int kq1 = u.e >> 8; return (const char*)(g.Bt + (size_t)(u.e & 255) * sB) + ((size_t)u.pn * BM * g.ldb + (size_t)(kq1 ? (kq1 - 1) * kq_elems : 0)) * 2; }
    __device__ __forceinline__ int unit_nt(const Gemm& g, const Unit& u) const { return (u.e >> 8) ? kq_nt : g.K / BK; }
};


struct EpiBf16 {
    static constexpr bool PERM = true;
    bf16_t* O; int ldc; size_t estride; int ecol;
    __device__ __forceinline__ void operator()(const f32x4 (&acc)[2][2][4][2], const Unit& u, int wr, int wc, int fr, int fq) const {
        const int row0 = u.pm * BM + wr * 64 + fr; const int col0 = u.pn * BM + wc * 32 + 8 * fq + u.e * ecol;
        bf16_t* base = O + (size_t)u.e * estride;
#pragma unroll
        for (int ai = 0; ai < 2; ++ai)
#pragma unroll
            for (int m = 0; m < 4; ++m) { bf16_t* rowp = base + (size_t)(row0 + ai * HALF + m * 16) * ldc + col0;
#pragma unroll
                for (int bj = 0; bj < 2; ++bj) { const f32x4 v0 = acc[ai][bj][m][0], v1 = acc[ai][bj][m][1];
                    u32x4 w; w.x = cvt_pk_bf16(v0[0], v0[1]); w.y = cvt_pk_bf16(v0[2], v0[3]); w.z = cvt_pk_bf16(v1[0], v1[1]); w.w = cvt_pk_bf16(v1[2], v1[3]);
                    *(u32x4*)(rowp + bj * HALF) = w; } }
    }
};
struct EpiMoeDown {
    static constexpr bool PERM = true;
    bf16_t* YE; bf16_t* YEP; int pm_split; size_t qstride;
    __device__ __forceinline__ void operator()(const f32x4 (&acc)[2][2][4][2], const Unit& u, int wr, int wc, int fr, int fq) const {
        const int kq1 = u.e >> 8; const int col0 = u.pn * BM + wc * 32 + 8 * fq;
        bf16_t* base = kq1 ? YEP + (size_t)(kq1 - 1) * qstride + (size_t)((u.pm - pm_split) * BM) * D : YE + (size_t)(u.pm * BM) * D;
        const int row0 = wr * 64 + fr;
#pragma unroll
        for (int ai = 0; ai < 2; ++ai)
#pragma unroll
            for (int m = 0; m < 4; ++m) { bf16_t* rowp = base + (size_t)(row0 + ai * HALF + m * 16) * D + col0;
#pragma unroll
                for (int bj = 0; bj < 2; ++bj) { const f32x4 v0 = acc[ai][bj][m][0], v1 = acc[ai][bj][m][1];
                    u32x4 w; w.x = cvt_pk_bf16(v0[0], v0[1]); w.y = cvt_pk_bf16(v0[2], v0[3]); w.z = cvt_pk_bf16(v1[0], v1[1]); w.w = cvt_pk_bf16(v1[2], v1[3]);
                    *(u32x4*)(rowp + bj * HALF) = w; } }
    }
};
struct EpiQKV {
    static constexpr bool PERM = true;
    bf16_t* O; const float* rope;
    __device__ __forceinline__ void operator()(const f32x4 (&acc)[2][2][4][2], const Unit& u, int wr, int wc, int fr, int fq) const {
        const int gt = u.pn >> 3, t = gt % 3, dsh = 2 * (gt / 3), head = 2 * (u.pn & 7) + (wc >> 1), idx0 = 32 * (wc & 1) + 8 * fq;
        const int row0 = u.pm * BM + wr * 64 + fr; bf16_t* hb = O + ((size_t)(gt * 16 + head) * MTOK) * 128 + idx0;
#pragma unroll
        for (int ai = 0; ai < 2; ++ai)
#pragma unroll
            for (int m = 0; m < 4; ++m) { const int row = row0 + ai * HALF + m * 16; const int sq = row & (SEQ - 1);
                bf16_t* rowp = hb + (size_t)((row & ~(SEQ - 1)) + (sq & ((1 << dsh) - 1)) * (SEQ >> dsh) + (sq >> dsh)) * 128;
                f32x4 l0 = acc[ai][0][m][0], l1 = acc[ai][0][m][1], h0 = acc[ai][1][m][0], h1 = acc[ai][1][m][1];
                if (t < 2) { const float* cp = rope + (size_t)(row & (SEQ - 1)) * 64 + idx0; const float* sp = cp + SEQ * 64;
                    const f32x4 c0 = *(const f32x4*)cp, c1 = *(const f32x4*)(cp + 4), s0 = *(const f32x4*)sp, s1 = *(const f32x4*)(sp + 4);
                    const f32x4 a0 = l0 * c0 - h0 * s0, a1 = l1 * c1 - h1 * s1, b0 = h0 * c0 + l0 * s0, b1 = h1 * c1 + l1 * s1;
                    l0 = a0; l1 = a1; h0 = b0; h1 = b1; }
                u32x4 w; w.x = cvt_pk_bf16(l0[0], l0[1]); w.y = cvt_pk_bf16(l0[2], l0[3]); w.z = cvt_pk_bf16(l1[0], l1[1]); w.w = cvt_pk_bf16(l1[2], l1[3]);
                *(u32x4*)rowp = w;
                w.x = cvt_pk_bf16(h0[0], h0[1]); w.y = cvt_pk_bf16(h0[2], h0[3]); w.z = cvt_pk_bf16(h1[0], h1[1]); w.w = cvt_pk_bf16(h1[2], h1[3]);
                *(u32x4*)(rowp + 64) = w; }
    }
};
struct EpiSwiGLU {
    static constexpr bool PERM = true;
    bf16_t* O; int ldc;
    __device__ __forceinline__ void operator()(const f32x4 (&acc)[2][2][4][2], const Unit& u, int wr, int wc, int fr, int fq) const {
        const int row0 = u.pm * BM + wr * 64 + fr; const int col0 = u.pn * HALF + wc * 32 + 8 * fq;
#pragma unroll
        for (int ai = 0; ai < 2; ++ai)
#pragma unroll
            for (int m = 0; m < 4; ++m) { bf16_t* rowp = O + (size_t)(row0 + ai * HALF + m * 16) * ldc + col0;
                float r[8];
#pragma unroll
                for (int n = 0; n < 2; ++n)
#pragma unroll
                    for (int j = 0; j < 4; ++j) { const float a = acc[ai][0][m][n][j], b = acc[ai][1][m][n][j];
                        const float sg = __builtin_amdgcn_rcpf(1.0f + __builtin_amdgcn_exp2f(-1.4426950408889634f * a)); r[n * 4 + j] = a * sg * b; }
                u32x4 w; w.x = cvt_pk_bf16(r[0], r[1]); w.y = cvt_pk_bf16(r[2], r[3]); w.z = cvt_pk_bf16(r[4], r[5]); w.w = cvt_pk_bf16(r[6], r[7]);
                *(u32x4*)rowp = w; }
    }
};
template <bool F32OUT> struct EpiRes {
    static constexpr bool PERM = true;
    const bf16_t* res; void* Y; int ldc; float alpha;
    __device__ __forceinline__ void operator()(const f32x4 (&acc)[2][2][4][2], const Unit& u, int wr, int wc, int fr, int fq) const {
        const int row0 = u.pm * BM + wr * 64 + fr, col0 = u.pn * BM + wc * 32 + 8 * fq;
#pragma unroll
        for (int ai = 0; ai < 2; ++ai)
#pragma unroll
            for (int m = 0; m < 4; ++m) { const size_t off = (size_t)(row0 + ai * HALF + m * 16) * ldc + col0;
#pragma unroll
                for (int bj = 0; bj < 2; ++bj) { const u32x4 rw = *(const u32x4*)(res + off + bj * HALF);
                    f32x4 v0 = acc[ai][bj][m][0], v1 = acc[ai][bj][m][1];
                    v0[0] += alpha * bf_lo(rw.x); v0[1] += alpha * bf_hi(rw.x); v0[2] += alpha * bf_lo(rw.y); v0[3] += alpha * bf_hi(rw.y);
                    v1[0] += alpha * bf_lo(rw.z); v1[1] += alpha * bf_hi(rw.z); v1[2] += alpha * bf_lo(rw.w); v1[3] += alpha * bf_hi(rw.w);
                    if constexpr (F32OUT) { float* yp = (float*)Y + off + bj * HALF; *(f32x4*)yp = v0; *(f32x4*)(yp + 4) = v1; }
                    else { u32x4 w; w.x = cvt_pk_bf16(v0[0], v0[1]); w.y = cvt_pk_bf16(v0[2], v0[3]); w.z = cvt_pk_bf16(v1[0], v1[1]); w.w = cvt_pk_bf16(v1[2], v1[3]); *(u32x4*)((bf16_t*)Y + off + bj * HALF) = w; } }
                if (m == 3) asm volatile("" ::: "memory"); }
    }
};
struct EpiPle {
    static constexpr bool PERM = true;
    const bf16_t* x; const bf16_t* pp; const float* bias; float* outF; bf16_t* outB; int ldc;
    __device__ __forceinline__ void operator()(const f32x4 (&acc)[2][2][4][2], const Unit& u, int wr, int wc, int fr, int fq) const {
        const int row0 = u.pm * BM + wr * 64 + fr, col0 = u.pn * BM + wc * 32 + 8 * fq;
        f32x4 bv[2][2];
#pragma unroll
        for (int bj = 0; bj < 2; ++bj)
#pragma unroll
            for (int n = 0; n < 2; ++n) bv[bj][n] = *(const f32x4*)(bias + col0 + bj * HALF + 4 * n);
#pragma unroll
        for (int ai = 0; ai < 2; ++ai)
#pragma unroll
            for (int m = 0; m < 4; ++m) { const size_t off = (size_t)(row0 + ai * HALF + m * 16) * ldc + col0;
#pragma unroll
                for (int bj = 0; bj < 2; ++bj) { const size_t o2 = off + bj * HALF;
                    const u32x4 xw = *(const u32x4*)(x + o2), pw = *(const u32x4*)(pp + o2);
                    float o[8];
#pragma unroll
                    for (int e = 0; e < 4; ++e) { const int n = e >> 1, j = (e & 1) * 2;
                        const float v0 = acc[ai][bj][m][n][j] + bv[bj][n][j], v1 = acc[ai][bj][m][n][j + 1] + bv[bj][n][j + 1];
                        o[2 * e] = bf_lo(xw[e]) + bf_lo(pw[e]) * __builtin_amdgcn_rcpf(1.0f + __builtin_amdgcn_exp2f(-1.4426950408889634f * v0));
                        o[2 * e + 1] = bf_hi(xw[e]) + bf_hi(pw[e]) * __builtin_amdgcn_rcpf(1.0f + __builtin_amdgcn_exp2f(-1.4426950408889634f * v1)); }
                    if (outF) { float* yp = outF + o2; *(f32x4*)yp = (f32x4){o[0], o[1], o[2], o[3]}; *(f32x4*)(yp + 4) = (f32x4){o[4], o[5], o[6], o[7]}; }
                    else { u32x4 w; w.x = cvt_pk_bf16(o[0], o[1]); w.y = cvt_pk_bf16(o[2], o[3]); w.z = cvt_pk_bf16(o[4], o[5]); w.w = cvt_pk_bf16(o[6], o[7]); *(u32x4*)(outB + o2) = w; } }
                if (m & 1) asm volatile("" ::: "memory"); }
    }
};

constexpr int IDX_LDS_OFF = 131072 + 1024;
template <class Epi, class Sched, bool ALIGN_EPI = true, bool SP2 = true, bool STAMP = false, bool GATHER = false>
__device__ __forceinline__ void gemm_phase(PG8_LAS unsigned char* lds, const Gemm g, const Sched& S, const Epi& E, unsigned long long* stp = nullptr) {
    const int tid = threadIdx.x, wid = __builtin_amdgcn_readfirstlane(tid >> 6), lane = tid & 63, wr = wid >> 2, wc = wid & 3, fr = lane & 15, fq = lane >> 4;
    unsigned voffA[2], voffB[2]; int gR[2], gC[2];
#pragma unroll
    for (int i = 0; i < 2; ++i) { int R, C; stage_rc(tid * 16 + i * 8192, R, C); const int Rb = Epi::PERM ? ((R & ~31) + perm32(R & 31)) : R; gR[i] = R; gC[i] = C;
        voffA[i] = (unsigned)(R * g.lda + C) * 2u; voffB[i] = (unsigned)(Rb * g.ldb + C) * 2u; }
    const size_t kstep = (size_t)(BK * 2);
    const size_t hstepA = (size_t)HALF * g.lda * 2, hstepB = (size_t)HALF * g.ldb * 2;
    const PG8_LAS unsigned short* gidx = (const PG8_LAS unsigned short*)(lds + IDX_LDS_OFF);
    unsigned cvo[2][2], nvo[2][2];
#define PG8_GOFF(dst, ui_) do { _Pragma("unroll") for (int _h = 0; _h < 2; ++_h) _Pragma("unroll") for (int _i = 0; _i < 2; ++_i) \
        dst[_h][_i] = GATHER ? ((unsigned)gidx[(ui_) * 256 + _h * HALF + gR[_i]] * (unsigned)(g.lda * 2) + (unsigned)(gC[_i] * 2)) : (voffA[_i] + (unsigned)(_h * hstepA)); } while (0)
    PG8_GOFF(cvo, 0);
#pragma unroll
    for (int _h = 0; _h < 2; ++_h)
#pragma unroll
        for (int _i = 0; _i < 2; ++_i) nvo[_h][_i] = cvo[_h][_i];
    const unsigned ldsw = (unsigned)wid * 1024u;
    const int aoff = lds_byte(wr * 64 + fr, fq * 8), boff = lds_byte(wc * 32 + fr, fq * 8);
#define PG8_SA(b, h) (((b) * 2 + (h)) * HTB)
#define PG8_SB(b, h) ((4 + (b) * 2 + (h)) * HTB)
#define PG8_STAGE(bufoff, gbase, voff) do { _Pragma("unroll") for (int _i = 0; _i < 2; ++_i) \
        __builtin_amdgcn_global_load_lds((const unsigned*)((const char*)(gbase) + (voff)[_i]), (PG8_LAS unsigned*)(lds + (bufoff) + ldsw + _i * 8192), 16, 0, 0); } while (0)
#define PG8_LDA(dst, b, h) do { _Pragma("unroll") for (int m = 0; m < 4; ++m) _Pragma("unroll") for (int k = 0; k < 2; ++k) dst[m][k] = *(const PG8_LAS bf16x8*)(lds + PG8_SA(b, h) + aoff + m * 2048 + k * 1024); } while (0)
#define PG8_LDB(dst, b, h) do { _Pragma("unroll") for (int n = 0; n < 2; ++n) _Pragma("unroll") for (int k = 0; k < 2; ++k) dst[n][k] = *(const PG8_LAS bf16x8*)(lds + PG8_SB(b, h) + boff + n * 2048 + k * 1024); } while (0)
#define PG8_MMA(ai, bj, At, Bt) do { __builtin_amdgcn_s_setprio(1); _Pragma("unroll") for (int m = 0; m < 4; ++m) _Pragma("unroll") for (int n = 0; n < 2; ++n) _Pragma("unroll") for (int k = 0; k < 2; ++k) \
        acc[ai][bj][m][n] = __builtin_amdgcn_mfma_f32_16x16x32_bf16(Bt[n][k], At[m][k], acc[ai][bj][m][n], 0, 0, 0); __builtin_amdgcn_s_setprio(0); } while (0)
#define PG8_WAIT_V(n) asm volatile("s_waitcnt vmcnt(" #n ")" ::: "memory")
#define PG8_WAIT_L(n) asm volatile("s_waitcnt lgkmcnt(" #n ")" ::: "memory")
#define PG8_BAR __builtin_amdgcn_s_barrier()
#define PG8_SCHED __builtin_amdgcn_sched_barrier(0)
    Unit cur, nxt; int ui = 0;
    if (!S.next(0, cur)) return;
    long long st_c0 = 0, st_w0 = 0, st_k = 0, st_e = 0, st_t = 0; if (STAMP) { st_c0 = clock64(); st_w0 = wall_clock64(); }
    f32x4 acc[2][2][4][2];
#pragma unroll
    for (int a = 0; a < 2; ++a)
#pragma unroll
        for (int b = 0; b < 2; ++b)
#pragma unroll
            for (int m = 0; m < 4; ++m)
#pragma unroll
                for (int n = 0; n < 2; ++n) acc[a][b][m][n] = (f32x4){0.f, 0.f, 0.f, 0.f};
    bf16x8 At[4][2], B0[2][2], B1[2][2];
    const char* cA = S.a_ptr(g, cur); const char* cB = S.b_ptr(g, cur);
    if constexpr (SP2) {
        PG8_STAGE(PG8_SB(0, 0), cB, voffB); PG8_STAGE(PG8_SB(0, 1), cB + hstepB, voffB); PG8_STAGE(PG8_SA(0, 0), cA, cvo[0]); PG8_STAGE(PG8_SA(0, 1), cA, cvo[1]);
        if (wr == 1) PG8_BAR;
        PG8_WAIT_V(2); PG8_BAR;
        PG8_STAGE(PG8_SB(1, 0), cB + kstep, voffB); PG8_STAGE(PG8_SA(1, 0), cA + kstep, cvo[0]); PG8_STAGE(PG8_SB(1, 1), cB + hstepB + kstep, voffB);
        PG8_WAIT_V(6); PG8_BAR;
    } else {
        PG8_STAGE(PG8_SB(0, 0), cB, voffB); PG8_STAGE(PG8_SA(0, 0), cA, cvo[0]); PG8_STAGE(PG8_SB(0, 1), cB + hstepB, voffB); PG8_STAGE(PG8_SA(0, 1), cA, cvo[1]);
        if (wr == 1) PG8_BAR;
        PG8_WAIT_V(4); PG8_BAR;
        PG8_STAGE(PG8_SB(1, 0), cB + kstep, voffB); PG8_STAGE(PG8_SA(1, 0), cA + kstep, cvo[0]); PG8_STAGE(PG8_SB(1, 1), cB + hstepB + kstep, voffB);
        PG8_WAIT_V(6); PG8_BAR;
    }
    for (;;) {
        const bool has_next = S.next(ui + 1, nxt);
        const char* nA = has_next ? S.a_ptr(g, nxt) : cA; const char* nB = has_next ? S.b_ptr(g, nxt) : cB;
        const int nt = S.unit_nt(g, cur);
        if (GATHER && has_next) PG8_GOFF(nvo, ui + 1);
        if (STAMP) st_t = clock64();
        for (int t = 0; t < nt; t += 2) {
            const bool last = (t == nt - 2);
            const char* a1 = cA + (size_t)(t + 1) * kstep;
            const char* a2 = last ? nA : cA + (size_t)(t + 2) * kstep; const char* b2 = last ? nB : cB + (size_t)(t + 2) * kstep;
            const char* a3 = a2 + kstep; const char* b3 = b2 + kstep;
            unsigned xvo[2][2];
#pragma unroll
            for (int _h = 0; _h < 2; ++_h)
#pragma unroll
                for (int _i = 0; _i < 2; ++_i) xvo[_h][_i] = (GATHER && last) ? nvo[_h][_i] : cvo[_h][_i];
            if constexpr (SP2) {
            PG8_LDB(B0, 0, 0); PG8_LDB(B1, 0, 1); PG8_SCHED; PG8_LDA(At, 0, 0); PG8_STAGE(PG8_SA(1, 1), a1, cvo[1]);
            PG8_WAIT_V(8); PG8_WAIT_L(0); PG8_BAR; PG8_MMA(0, 0, At, B0); PG8_MMA(0, 1, At, B1); PG8_BAR; PG8_SCHED;
            PG8_LDA(At, 0, 1); PG8_STAGE(PG8_SB(0, 0), b2, voffB); PG8_STAGE(PG8_SB(0, 1), b2 + hstepB, voffB); PG8_STAGE(PG8_SA(0, 0), a2, xvo[0]);
            PG8_WAIT_V(8); PG8_WAIT_L(0); PG8_BAR; PG8_MMA(1, 0, At, B0); PG8_MMA(1, 1, At, B1); PG8_BAR; PG8_SCHED;
            PG8_LDB(B0, 1, 0); PG8_LDB(B1, 1, 1); PG8_SCHED; PG8_LDA(At, 1, 0); PG8_STAGE(PG8_SA(0, 1), a2, xvo[1]);
            PG8_WAIT_V(8); PG8_WAIT_L(0); PG8_BAR; PG8_MMA(0, 0, At, B0); PG8_MMA(0, 1, At, B1); PG8_BAR; PG8_SCHED;
            PG8_LDA(At, 1, 1); PG8_STAGE(PG8_SB(1, 0), b3, voffB); PG8_STAGE(PG8_SB(1, 1), b3 + hstepB, voffB); PG8_STAGE(PG8_SA(1, 0), a3, xvo[0]);
            PG8_WAIT_V(8); PG8_WAIT_L(0); PG8_BAR; PG8_MMA(1, 0, At, B0); PG8_MMA(1, 1, At, B1); PG8_BAR; PG8_SCHED;
            } else {
            PG8_LDB(B0, 0, 0); PG8_SCHED; PG8_LDA(At, 0, 0); PG8_STAGE(PG8_SA(1, 1), a1, cvo[1]);
            PG8_WAIT_L(8); PG8_BAR; PG8_WAIT_L(0); PG8_MMA(0, 0, At, B0); PG8_BAR; PG8_SCHED;
            PG8_LDB(B1, 0, 1); PG8_STAGE(PG8_SB(0, 0), b2, voffB);
            PG8_BAR; PG8_WAIT_L(0); PG8_MMA(0, 1, At, B1); PG8_BAR;
            PG8_LDA(At, 0, 1); PG8_STAGE(PG8_SA(0, 0), a2, xvo[0]);
            PG8_BAR; PG8_WAIT_L(0); PG8_MMA(1, 0, At, B0); PG8_BAR; PG8_SCHED;
            PG8_STAGE(PG8_SB(0, 1), b2 + hstepB, voffB);
            PG8_WAIT_V(6); PG8_BAR; PG8_MMA(1, 1, At, B1); PG8_BAR;
            PG8_LDB(B0, 1, 0); PG8_SCHED; PG8_LDA(At, 1, 0); PG8_STAGE(PG8_SA(0, 1), a2, xvo[1]);
            PG8_WAIT_L(8); PG8_BAR; PG8_WAIT_L(0); PG8_MMA(0, 0, At, B0); PG8_BAR; PG8_SCHED;
            PG8_LDB(B1, 1, 1); PG8_STAGE(PG8_SB(1, 0), b3, voffB);
            PG8_BAR; PG8_WAIT_L(0); PG8_MMA(0, 1, At, B1); PG8_BAR;
            PG8_LDA(At, 1, 1); PG8_STAGE(PG8_SA(1, 0), a3, xvo[0]);
            PG8_BAR; PG8_WAIT_L(0); PG8_MMA(1, 0, At, B0); PG8_BAR; PG8_SCHED;
            PG8_STAGE(PG8_SB(1, 1), b3 + hstepB, voffB);
            PG8_WAIT_V(6); PG8_BAR; PG8_MMA(1, 1, At, B1); PG8_BAR;
            }
        }
        if (STAMP) { const long long c = clock64(); st_k += c - st_t; st_t = c; }
        if constexpr (ALIGN_EPI) { if (wr == 0) PG8_BAR; }
        E(acc, cur, wr, wc, fr, fq);
        if (STAMP) { const long long c = clock64(); st_e += c - st_t; }
        if (!has_next) break;
#pragma unroll
        for (int a = 0; a < 2; ++a)
#pragma unroll
            for (int b = 0; b < 2; ++b)
#pragma unroll
                for (int m = 0; m < 4; ++m)
#pragma unroll
                    for (int n = 0; n < 2; ++n) acc[a][b][m][n] = (f32x4){0.f, 0.f, 0.f, 0.f};
        cur = nxt; cA = nA; cB = nB; ++ui;
        if (GATHER) {
#pragma unroll
            for (int _h = 0; _h < 2; ++_h)
#pragma unroll
                for (int _i = 0; _i < 2; ++_i) cvo[_h][_i] = nvo[_h][_i]; }
        if constexpr (ALIGN_EPI) { if (wr == 1) PG8_BAR; }
    }
    PG8_WAIT_V(0);
    if constexpr (!ALIGN_EPI) { if (wr == 0) PG8_BAR; }
    PG8_BAR;
    if (STAMP) { if (blockIdx.x == 0 && tid == 0) { const long long c1 = clock64(), w1 = wall_clock64(); stp[0] = (unsigned long long)((c1 - st_c0) * 100 / (w1 - st_w0)); stp[1] = (unsigned long long)(st_k / ((ui + 1) * (g.K / BK))); stp[2] = (unsigned long long)(st_e / (10 * (ui + 1))); } }
#undef PG8_GOFF
#undef PG8_SA
#undef PG8_SB
#undef PG8_STAGE
#undef PG8_LDA
#undef PG8_LDB
#undef PG8_MMA
#undef PG8_WAIT_V
#undef PG8_WAIT_L
#undef PG8_BAR
#undef PG8_SCHED
}
}

#define XB_TMO      128
#define XB_XCNT(j)  (256  + 64 * (j))
#define XB_XSUB(j)  (1280 + 64 * (j))
#define XB_XGEN(j)  (2304 + 64 * (j))
#define XB_TOP      3328
#define XB_TOPGEN   3392
#define XCD_BAR_WORDS 3456
#define XB_SPIN_CAP (1u << 18)

__device__ __forceinline__ unsigned xb_ld(unsigned* p)              { return __hip_atomic_load(p, __ATOMIC_RELAXED, __HIP_MEMORY_SCOPE_AGENT); }
__device__ __forceinline__ unsigned xb_add(unsigned* p, unsigned v) { return __hip_atomic_fetch_add(p, v, __ATOMIC_RELAXED, __HIP_MEMORY_SCOPE_AGENT); }
__device__ __forceinline__ unsigned xb_xcc_id() { return (unsigned)__builtin_amdgcn_s_getreg((3 << 11) | 20) & 0xFu; }
#define XB_SPIN(cond, bar) do { unsigned _sp = 0; while (cond) { __builtin_amdgcn_s_sleep(1); \
    if ((++_sp & 255u) == 0u) { if (xb_ld(&(bar)[XB_TMO])) break; if (_sp > XB_SPIN_CAP) { atomicAdd(&(bar)[XB_TMO], 1u); break; } } } } while (0)

struct XcdBarrier { unsigned* bar; unsigned x; volatile LAS unsigned* st; };

__device__ __forceinline__ XcdBarrier xcd_barrier_post(unsigned* bar, volatile LAS unsigned* st) {
    XcdBarrier b; b.bar = bar; b.x = xb_xcc_id(); b.st = st;
    if (threadIdx.x == 0) (void)xb_add(&bar[XB_XCNT(b.x)], 1u);
    return b;
}
__device__ __forceinline__ void xcd_barrier_complete(unsigned* bar, unsigned x, unsigned& nloc, unsigned& nx) {
    const unsigned G = gridDim.x * gridDim.y * gridDim.z;
    unsigned sum, cnt, mine, sp = 0u;
    for (;;) {
        sum = 0u; cnt = 0u; mine = 0u;
#pragma unroll
        for (unsigned j = 0; j < 16; ++j) { const unsigned c = xb_ld(&bar[XB_XCNT(j)]); sum += c; cnt += (c > 0u) ? 1u : 0u; mine = (j == x) ? c : mine; }
        if (sum == G) break;
        __builtin_amdgcn_s_sleep(1);
        if ((++sp & 255u) == 0u) { if (xb_ld(&bar[XB_TMO])) break; if (sp > XB_SPIN_CAP) { atomicAdd(&bar[XB_TMO], 1u); break; } }
    }
    nloc = mine > 0u ? mine : 1u; nx = cnt > 0u ? cnt : 1u;
}
__device__ __forceinline__ void xcd_barrier(const XcdBarrier& b) {
    asm volatile("s_waitcnt vmcnt(0)" ::: "memory");
    __syncthreads();
    if (threadIdx.x == 0) {
        unsigned* bar = b.bar;
        __builtin_amdgcn_s_waitcnt(0);
        unsigned nloc = b.st[0], nx = b.st[1];
        if (nloc == 0u) { xcd_barrier_complete(bar, b.x, nloc, nx); b.st[0] = nloc; b.st[1] = nx; }
        const unsigned old = xb_add(&bar[XB_XSUB(b.x)], 1u);
        const unsigned gen = old / nloc;
        if (old + 1u == (gen + 1u) * nloc) {
            __builtin_amdgcn_fence(__ATOMIC_RELEASE, "agent");
            asm volatile("s_waitcnt vmcnt(0)" ::: "memory");
            const unsigned og = xb_add(&bar[XB_TOP], 1u);
            const unsigned tg = og / nx;
            if (og + 1u == (tg + 1u) * nx) xb_add(&bar[XB_TOPGEN], 1u);
            else XB_SPIN(xb_ld(&bar[XB_TOPGEN]) == tg, bar);
            __builtin_amdgcn_fence(__ATOMIC_ACQUIRE, "agent");
            xb_add(&bar[XB_XGEN(b.x)], 1u);
            asm volatile("s_waitcnt vmcnt(0)" ::: "memory");
        } else {
            XB_SPIN(xb_ld(&bar[XB_XGEN(b.x)]) == gen, bar);
            __builtin_amdgcn_fence(__ATOMIC_ACQUIRE, "agent");
            asm volatile("s_waitcnt vmcnt(0)" ::: "memory");
        }
    }
    __syncthreads();
}

struct Frame {
    LAS unsigned char* lds;
    int tid, lane, wave, vcu, G;
    unsigned char* ws;
};
struct Args { const float* in[22]; float* out; unsigned char* ws; int ph_lo, ph_hi; };

__device__ __forceinline__ void cvt_tile(const float* W, size_t ldw, int k0, int n0, bf16* WT, size_t ldt, int dst_row0, int lane) {
    const int kb = lane >> 3, nb = lane & 7;
    const float* src = W + (size_t)(k0 + 8 * kb) * ldw + n0 + 4 * nb;
    f32x4 v[8];
#pragma unroll
    for (int j = 0; j < 8; ++j) v[j] = *(const f32x4*)(src + (size_t)j * ldw);
#pragma unroll
    for (int jn = 0; jn < 4; ++jn) { u32x4 o; o.x = cvt_pk_bf16(v[0][jn], v[1][jn]); o.y = cvt_pk_bf16(v[2][jn], v[3][jn]); o.z = cvt_pk_bf16(v[4][jn], v[5][jn]); o.w = cvt_pk_bf16(v[6][jn], v[7][jn]);
        *(u32x4*)(WT + (size_t)(dst_row0 + 4 * nb + jn) * ldt + k0 + 8 * kb) = o; }
}
struct MapId { __device__ __forceinline__ int operator()(int n) const { return n; } };
struct MapQKV { __device__ __forceinline__ int operator()(int n) const { const int gt = n >> 11, head = (n >> 7) & 15, d = n & 127; return (gt * 8 + (head >> 1)) * 256 + 128 * (d >> 6) + 64 * (head & 1) + (d & 63); } };
struct MapGU { int which; __device__ __forceinline__ int operator()(int n) const { return 256 * (n >> 7) + 128 * which + (n & 127); } };
template <class Map> __device__ __forceinline__ void cvt_matrix(const float* W, int K, int N, bf16* WT, size_t ldt, Map map, int& it0, int gw, int NGW, int lane) {
    const int nblk = N / 32, items = (K / 64) * nblk;
    int it = gw - it0; if (it < 0) it += ((-it + NGW - 1) / NGW) * NGW;
    for (; it < items; it += 2 * NGW) { const int it2 = it + NGW; const bool two = it2 < items;
        const int kb = it / nblk, nb = it - kb * nblk, kb2 = two ? it2 / nblk : kb, nb2 = two ? it2 - kb2 * nblk : nb;
        const int q8 = lane >> 3, n8 = lane & 7;
        const float* sa = W + (size_t)(64 * kb + 8 * q8) * N + 32 * nb + 4 * n8; const float* sb = W + (size_t)(64 * kb2 + 8 * q8) * N + 32 * nb2 + 4 * n8;
        f32x4 va[8], vb[8];
#pragma unroll
        for (int j = 0; j < 8; ++j) va[j] = *(const f32x4*)(sa + (size_t)j * N);
#pragma unroll
        for (int j = 0; j < 8; ++j) vb[j] = *(const f32x4*)(sb + (size_t)j * N);
        const int da = map(32 * nb), db = map(32 * nb2);
#pragma unroll
        for (int jn = 0; jn < 4; ++jn) { u32x4 o; o.x = cvt_pk_bf16(va[0][jn], va[1][jn]); o.y = cvt_pk_bf16(va[2][jn], va[3][jn]); o.z = cvt_pk_bf16(va[4][jn], va[5][jn]); o.w = cvt_pk_bf16(va[6][jn], va[7][jn]);
            *(u32x4*)(WT + (size_t)(da + 4 * n8 + jn) * ldt + 64 * kb + 8 * q8) = o; }
        if (two) {
#pragma unroll
            for (int jn = 0; jn < 4; ++jn) { u32x4 o; o.x = cvt_pk_bf16(vb[0][jn], vb[1][jn]); o.y = cvt_pk_bf16(vb[2][jn], vb[3][jn]); o.z = cvt_pk_bf16(vb[4][jn], vb[5][jn]); o.w = cvt_pk_bf16(vb[6][jn], vb[7][jn]);
                *(u32x4*)(WT + (size_t)(db + 4 * n8 + jn) * ldt + 64 * kb2 + 8 * q8) = o; } }
    }
    it0 = (it0 + items) % NGW;
}
__device__ __forceinline__ void cvt_flat(const float* s, bf16* d, size_t n, int gw, int NGW, int lane) {
    for (size_t i = ((size_t)gw * 64 + lane) * 8; i < n; i += (size_t)NGW * 64 * 8) { const f32x4 a = *(const f32x4*)(s + i), b = *(const f32x4*)(s + i + 4);
        u32x4 o; o.x = cvt_pk_bf16(a[0], a[1]); o.y = cvt_pk_bf16(a[2], a[3]); o.z = cvt_pk_bf16(b[0], b[1]); o.w = cvt_pk_bf16(b[2], b[3]); *(u32x4*)(d + i) = o; }
}

__device__ __forceinline__ void p0_prologue(Frame& F, const Args& a) {
    const int gw = F.vcu * 8 + F.wave, NGW = F.G * 8, lane = F.lane; unsigned char* ws = F.ws; int it0 = 0;
    cvt_matrix(a.in[2], D, NQKV, (bf16*)(ws + WS_WQKV), D, MapQKV{}, it0, gw, NGW, lane);
    cvt_matrix(a.in[3], D, D, (bf16*)(ws + WS_WO), D, MapId{}, it0, gw, NGW, lane);
    cvt_matrix(a.in[12], D, FF, (bf16*)(ws + WS_W13), D, MapGU{0}, it0, gw, NGW, lane);
    cvt_matrix(a.in[13], D, FF, (bf16*)(ws + WS_W13), D, MapGU{1}, it0, gw, NGW, lane);
    cvt_matrix(a.in[14], FF, D, (bf16*)(ws + WS_W2), FF, MapId{}, it0, gw, NGW, lane);
    cvt_matrix(a.in[20], D, D, (bf16*)(ws + WS_WGATE), D, MapId{}, it0, gw, NGW, lane);
    cvt_matrix(a.in[20] + (size_t)D * D, D, D, (bf16*)(ws + WS_WGATE) + (size_t)D * D, D, MapId{}, it0, gw, NGW, lane);
    cvt_matrix(a.in[19], PLE, D, (bf16*)(ws + WS_WPROJ), PLE, MapId{}, it0, gw, NGW, lane);
    cvt_matrix(a.in[19] + (size_t)PLE * D, PLE, D, (bf16*)(ws + WS_WPROJ) + (size_t)D * PLE, PLE, MapId{}, it0, gw, NGW, lane);
    cvt_matrix(a.in[4], D, D, (bf16*)(ws + WS_WIN), D, MapId{}, it0, gw, NGW, lane);
    cvt_matrix(a.in[7], D, D, (bf16*)(ws + WS_WO2), D, MapId{}, it0, gw, NGW, lane);
    { const float* wg = a.in[5]; const float* sc = a.in[6]; bf16* o = (bf16*)(ws + WS_WGS);
      for (size_t i = ((size_t)gw * 64 + lane) * 8; i < (size_t)4 * 512 * 512; i += (size_t)NGW * 64 * 8) { const int g = (int)(i >> 18), d = (int)(i & 511);
          const f32x4 x0 = *(const f32x4*)(wg + i), x1 = *(const f32x4*)(wg + i + 4), s0 = *(const f32x4*)(sc + g * 512 + d), s1 = *(const f32x4*)(sc + g * 512 + d + 4);
          const f32x4 y0 = x0 * s0, y1 = x1 * s1; u32x4 w; w.x = cvt_pk_bf16(y0[0], y0[1]); w.y = cvt_pk_bf16(y0[2], y0[3]); w.z = cvt_pk_bf16(y1[0], y1[1]); w.w = cvt_pk_bf16(y1[2], y1[3]); *(u32x4*)(o + i) = w; } }
    cvt_flat(a.in[0], (bf16*)(ws + WS_XB0), (size_t)MTOK * D, gw, NGW, lane);
    cvt_flat(a.in[1], (bf16*)(ws + WS_PB), (size_t)2 * MTOK * PLE, gw, NGW, lane);
    { float* ct = (float*)(ws + WS_ROPE); float* st = ct + SEQ * 64;
      for (int i = gw * 64 + lane; i < SEQ * 64; i += NGW * 64) { const int pos = i >> 6, j = i & 63;
          const double inv = exp2(-(double)j * (13.287712379549449 / 64.0));
          const double ang = (double)pos * inv; ct[i] = (float)cos(ang); st[i] = (float)sin(ang); } }
}

__device__ __forceinline__ void attn_load_block(const bf16* hp, int blk, LAS unsigned char* slot, bool isV, int w, int lane) {
#pragma unroll
    for (int i = 0; i < 4; ++i) {
        const int idx = i * 8 + w, row = idx * 4 + (lane >> 4), cs = lane & 15;
        const int c = cs ^ (isV ? (((row & 3) << 2) | ((row >> 2) & 3)) : (row & 7));
        const bf16* rp = hp + (size_t)(128 * blk + row) * 128 + c * 8;
        __builtin_amdgcn_global_load_lds((const unsigned*)rp, (LAS unsigned*)(slot + idx * 1024), 16, 0, 0);
    }
}
__device__ __forceinline__ void attn_phase(Frame& F) {
    const bf16* QKV = (const bf16*)(F.ws + WS_QKV); bf16* OG = (bf16*)(F.ws + WS_OG); float* LSE = (float*)(F.ws + WS_LSE);
    LAS unsigned char* Kl = F.lds; LAS unsigned char* Vl = F.lds + 98304;
    volatile LAS unsigned* MISCw = (volatile LAS unsigned*)(F.lds + MISC_OFF);
    const unsigned keep0 = MISCw[8], keep1 = MISCw[9];
    const int w = F.wave, lane = F.lane, q16 = lane & 15, g4 = lane >> 4, sw = ((g4 & 1) << 1) | (g4 >> 1);
    const int pi16 = (q16 & 3) | ((q16 & 4) << 1) | ((q16 & 8) >> 1);
    const int qq = q16 >> 2, pp = q16 & 3;
    bf16x8 bqn[4];
#pragma unroll
    for (int ks = 0; ks < 4; ++ks) bqn[ks] = (bf16x8){0, 0, 0, 0, 0, 0, 0, 0};
    __syncthreads();
    for (int i = F.tid; i < LDS_BYTES / 16; i += 512) *(LAS u32x4*)(F.lds + i * 16) = (u32x4){0u, 0u, 0u, 0u};
    for (int p = F.vcu; p < 768; p += F.G) {
        const int b = 3 - p / 192, pr = p % 192, g = pr >> 6, h = (pr & 63) >> 2, qs = pr & 3;
        const int dsh = 2 * g, dil = 1 << dsh, nb = 32 >> dsh;
        const bf16* planeQ = QKV + ((size_t)((g * 3 + 0) * 16 + h) * MTOK) * 128; const bf16* planeK = planeQ + (size_t)16 * MTOK * 128; const bf16* planeV = planeK + (size_t)16 * MTOK * 128;
        for (int u = 0; u < 8; ++u) {
            int r, n;
            if (g == 0) { r = 0; n = qs * 8 + u; } else if (g == 1) { r = qs; n = u; } else { r = qs * 4 + (u >> 1); n = u & 1; }
            const bool first = (u == 0) || (n == 0), cont = (u < 7) && (n + 1 < nb);
            const size_t tok0 = (size_t)b * SEQ + r; const size_t crow = (size_t)b * SEQ + (size_t)r * (SEQ >> dsh);
            const bf16* hQ = planeQ + crow * 128; const bf16* hK = planeK + crow * 128; const bf16* hV = planeV + crow * 128;
            const int par = n & 1, k3 = n % 3, kp3 = (n + 2) % 3, kn3 = (n + 1) % 3;
            const size_t qtok = tok0 + (size_t)(128 * n + 16 * w + q16) * dil;
            bf16x8 bq[4];
            if (first) {
                __syncthreads();
                attn_load_block(hK, n, Kl + k3 * 32768, false, w, lane);
                attn_load_block(hV, n, Vl + par * 32768, true, w, lane);
                if (n > 0) { attn_load_block(hK, n - 1, Kl + kp3 * 32768, false, w, lane);
                             attn_load_block(hV, n - 1, Vl + (par ^ 1) * 32768, true, w, lane); }
#pragma unroll
                for (int ks = 0; ks < 4; ++ks) bq[ks] = *(const bf16x8*)(hQ + (size_t)(128 * n + 16 * w + q16) * 128 + 32 * ks + 8 * g4);
            } else {
#pragma unroll
                for (int ks = 0; ks < 4; ++ks) bq[ks] = bqn[ks];
            }
            if (first) asm volatile("s_waitcnt vmcnt(0)" ::: "memory"); else asm volatile("s_waitcnt vmcnt(4)" ::: "memory");
            __syncthreads();
            if (!first) attn_load_block(hV, n, Vl + par * 32768, true, w, lane);
            if (cont) attn_load_block(hK, n + 1, Kl + kn3 * 32768, false, w, lane);
            f32x4 s[9];
            {
                bf16x8 ka[2][4];
#define ATT_LDK(buf, ti_) do { const int _kt = w + (ti_); const int _row = ((_kt >> 3) ? k3 : kp3) * 128 + (_kt & 7) * 16 + pi16; \
                    _Pragma("unroll") for (int _ks = 0; _ks < 4; ++_ks) ka[buf][_ks] = *(const LAS bf16x8*)(Kl + _row * 256 + (((4 * _ks + g4) ^ (_row & 7)) << 4)); } while (0)
                ATT_LDK(0, 0);
#pragma unroll
                for (int ti = 0; ti < 9; ++ti) {
                    if (ti < 8) ATT_LDK((ti + 1) & 1, ti + 1);
                    __builtin_amdgcn_sched_barrier(0);
                    f32x4 acc = (f32x4){0.f, 0.f, 0.f, 0.f};
#pragma unroll
                    for (int ks = 0; ks < 4; ++ks) acc = __builtin_amdgcn_mfma_f32_16x16x32_bf16(ka[ti & 1][ks], bq[ks], acc, 0, 0, 0);
                    s[ti] = acc;
                }
#undef ATT_LDK
            }
            const float C2 = 0.08838834764831845f * 1.4426950408889634f; const float NEG = -__builtin_inff();
            float mx = NEG;
#pragma unroll
            for (int ti = 0; ti < 9; ++ti) {
                const bool tile_ok = (n > 0 || w + ti >= 8);
#pragma unroll
                for (int i = 0; i < 4; ++i) { const int kk = 4 * sw + i; bool ok = tile_ok;
                    if (ti == 0) ok = ok && (kk >= q16);
                    if (ti == 8) ok = ok && (kk <= q16);
                    const float v = ok ? s[ti][i] * C2 : NEG; s[ti][i] = v; mx = fmaxf(mx, v); }
            }
            mx = fmaxf(mx, __shfl_xor(mx, 16)); mx = fmaxf(mx, __shfl_xor(mx, 32));
            float l = 0.f;
#pragma unroll
            for (int ti = 0; ti < 9; ++ti)
#pragma unroll
                for (int i = 0; i < 4; ++i) { const float pv = __builtin_amdgcn_exp2f(s[ti][i] - mx); s[ti][i] = pv; l += pv; }
            l += __shfl_xor(l, 16); l += __shfl_xor(l, 32);
            bf16x8 pf[5];
#pragma unroll
            for (int uu = 0; uu < 5; ++uu) { u32x4 wv; wv.x = cvt_pk_bf16(s[2 * uu][0], s[2 * uu][1]); wv.y = cvt_pk_bf16(s[2 * uu][2], s[2 * uu][3]);
                if (uu < 4) { wv.z = cvt_pk_bf16(s[2 * uu + 1][0], s[2 * uu + 1][1]); wv.w = cvt_pk_bf16(s[2 * uu + 1][2], s[2 * uu + 1][3]); } else { wv.z = 0u; wv.w = 0u; }
                pf[uu] = __builtin_bit_cast(bf16x8, wv); }
            if (cont) asm volatile("s_waitcnt vmcnt(4)" ::: "memory"); else asm volatile("s_waitcnt vmcnt(0)" ::: "memory");
            __syncthreads();
            if (cont) {
#pragma unroll
                for (int ks = 0; ks < 4; ++ks) bqn[ks] = *(const bf16x8*)(hQ + (size_t)(128 * (n + 1) + 16 * w + q16) * 128 + 32 * ks + 8 * g4);
            }
            const float rl = 1.0f / l;
            const size_t orow = (size_t)g * MTOK * D + qtok * D + h * 128;
            {
                s16x4 va[2][9];
#define ATT_TRV(r_, ch_) __builtin_bit_cast(s16x4, __builtin_amdgcn_ds_read_tr16_b64_v4i16((LAS s16x4*)(Vl + 256 * (r_) + 16 * ((ch_) ^ ((((r_) & 3) << 2) | (((r_) >> 2) & 3))) + 8 * (pp & 1))))
#define ATT_LDV(buf, dt_) do { const int _ch = 2 * (dt_) + (pp >> 1); \
                    _Pragma("unroll") for (int _u = 0; _u < 5; ++_u) { const int _kt0 = w + 2 * _u; const int _r0 = (par ^ 1 ^ (_kt0 >> 3)) * 128 + (_kt0 & 7) * 16 + 4 * sw + qq; va[buf][_u] = ATT_TRV(_r0, _ch); \
                        if (_u < 4) { const int _kt1 = _kt0 + 1; const int _r1 = (par ^ 1 ^ (_kt1 >> 3)) * 128 + (_kt1 & 7) * 16 + 4 * sw + qq; va[buf][5 + _u] = ATT_TRV(_r1, _ch); } } } while (0)
                ATT_LDV(0, 0);
#pragma unroll
                for (int dt = 0; dt < 8; ++dt) {
                    if (dt < 7) ATT_LDV((dt + 1) & 1, dt + 1);
                    __builtin_amdgcn_sched_barrier(0);
                    f32x4 o = (f32x4){0.f, 0.f, 0.f, 0.f};
#pragma unroll
                    for (int uu = 0; uu < 5; ++uu) { const s16x4 lo = va[dt & 1][uu]; const s16x4 hi = (uu < 4) ? va[dt & 1][5 + uu] : (s16x4){0, 0, 0, 0};
                        bf16x8 av; av[0] = lo[0]; av[1] = lo[1]; av[2] = lo[2]; av[3] = lo[3]; av[4] = hi[0]; av[5] = hi[1]; av[6] = hi[2]; av[7] = hi[3];
                        o = __builtin_amdgcn_mfma_f32_16x16x32_bf16(av, pf[uu], o, 0, 0, 0); }
                    o = o * rl;
                    u32x2 wv; wv.x = cvt_pk_bf16(o[0], o[1]); wv.y = cvt_pk_bf16(o[2], o[3]);
                    *(u32x2*)(OG + orow + 16 * dt + 4 * g4) = wv;
                }
#undef ATT_LDV
#undef ATT_TRV
            }
            if (g4 == 0) LSE[((size_t)g * MTOK + qtok) * NH + h] = mx * 0.6931471805599453f + __logf(l);
        }
    }
    __syncthreads();
    if (F.tid == 0) { MISCw[8] = keep0; MISCw[9] = keep1; }
    __syncthreads();
}

__device__ __forceinline__ void combine_phase(Frame& F) {
    const bf16* OG = (const bf16*)(F.ws + WS_OG); const float* LSE = (const float*)(F.ws + WS_LSE); bf16* ATT = (bf16*)(F.ws + WS_ATT);
    const int gw = F.vcu * 8 + F.wave, NGW = F.G * 8, lane = F.lane;
    for (int m = gw; m < MTOK; m += NGW) {
#pragma unroll
        for (int j = 0; j < 4; ++j) { const int c = lane + 64 * j, h = c >> 4;
            const float l0 = LSE[(size_t)m * NH + h], l1 = LSE[((size_t)MTOK + m) * NH + h], l2 = LSE[((size_t)2 * MTOK + m) * NH + h];
            const float mx = fmaxf(l0, fmaxf(l1, l2)); float w0 = __expf(l0 - mx), w1 = __expf(l1 - mx), w2 = __expf(l2 - mx); const float rs = 1.0f / (w0 + w1 + w2); w0 *= rs; w1 *= rs; w2 *= rs;
            const u32x4 a = *(const u32x4*)(OG + (size_t)m * D + c * 8), b = *(const u32x4*)(OG + ((size_t)MTOK + m) * D + c * 8), d = *(const u32x4*)(OG + ((size_t)2 * MTOK + m) * D + c * 8);
            u32x4 o;
#pragma unroll
            for (int e = 0; e < 4; ++e) { const float lo = w0 * bf_lo(a[e]) + w1 * bf_lo(b[e]) + w2 * bf_lo(d[e]), hi = w0 * bf_hi(a[e]) + w1 * bf_hi(b[e]) + w2 * bf_hi(d[e]); o[e] = cvt_pk_bf16(lo, hi); }
            *(u32x4*)(ATT + (size_t)m * D + c * 8) = o; }
    }
}
__device__ __forceinline__ void moe_convert_phase(Frame& F, const Args& a) {
    const int gw = F.vcu * 8 + F.wave, NGW = F.G * 8, lane = F.lane; int it0 = 0;
    bf16* W13 = (bf16*)(F.ws + WS_MW13); bf16* W2 = (bf16*)(F.ws + WS_MW2);
    for (int e = 0; e < NE; ++e) {
        cvt_matrix(a.in[16] + (size_t)e * D * FF, D, FF, W13 + (size_t)e * FF2 * D, D, MapGU{0}, it0, gw, NGW, lane);
        cvt_matrix(a.in[17] + (size_t)e * D * FF, D, FF, W13 + (size_t)e * FF2 * D, D, MapGU{1}, it0, gw, NGW, lane);
        cvt_matrix(a.in[18] + (size_t)e * FF * D, FF, D, W2 + (size_t)e * D * FF, FF, MapId{}, it0, gw, NGW, lane);
    }
}

__device__ __forceinline__ void ln_core(f32x4 (&v)[8], const f32x4 (&gg)[8], const f32x4 (&bb)[8]) {
    float s = 0.f;
#pragma unroll
    for (int j = 0; j < 8; ++j) s += (v[j][0] + v[j][1]) + (v[j][2] + v[j][3]);
    const float mean = wave_sum(s) * (1.f / D); float s2 = 0.f;
#pragma unroll
    for (int j = 0; j < 8; ++j) { v[j] = v[j] - mean; s2 += (v[j][0] * v[j][0] + v[j][1] * v[j][1]) + (v[j][2] * v[j][2] + v[j][3] * v[j][3]); }
    const float rstd = 1.0f / sqrtf(wave_sum(s2) * (1.f / D) + LN_EPS);
#pragma unroll
    for (int j = 0; j < 8; ++j) v[j] = v[j] * rstd * gg[j] + bb[j];
}
__device__ __forceinline__ void ln_store(const f32x4 (&v)[8], bf16* xb, int lane) {
#pragma unroll
    for (int j = 0; j < 8; ++j) { u32x2 w; w.x = cvt_pk_bf16(v[j][0], v[j][1]); w.y = cvt_pk_bf16(v[j][2], v[j][3]); *(u32x2*)(xb + 4 * lane + 256 * j) = w; }
}
__device__ __forceinline__ void ln_load_gb8(const float* gam, const float* bet, f32x4 (&gg)[8], f32x4 (&bb)[8], int lane) {
#pragma unroll
    for (int j = 0; j < 4; ++j) { const int c = (lane + 64 * j) * 8; gg[2 * j] = *(const f32x4*)(gam + c); gg[2 * j + 1] = *(const f32x4*)(gam + c + 4); bb[2 * j] = *(const f32x4*)(bet + c); bb[2 * j + 1] = *(const f32x4*)(bet + c + 4); }
}
__device__ __forceinline__ void ln_store8(const f32x4 (&v)[8], bf16* xb, int lane) {
#pragma unroll
    for (int j = 0; j < 4; ++j) { u32x4 w; w.x = cvt_pk_bf16(v[2 * j][0], v[2 * j][1]); w.y = cvt_pk_bf16(v[2 * j][2], v[2 * j][3]); w.z = cvt_pk_bf16(v[2 * j + 1][0], v[2 * j + 1][1]); w.w = cvt_pk_bf16(v[2 * j + 1][2], v[2 * j + 1][3]);
        *(u32x4*)(xb + (lane + 64 * j) * 8) = w; }
}
__device__ __forceinline__ void ln_unpack8(const u32x4 (&w)[4], f32x4 (&v)[8]) {
#pragma unroll
    for (int j = 0; j < 4; ++j) { v[2 * j] = (f32x4){bf_lo(w[j].x), bf_hi(w[j].x), bf_lo(w[j].y), bf_hi(w[j].y)}; v[2 * j + 1] = (f32x4){bf_lo(w[j].z), bf_hi(w[j].z), bf_lo(w[j].w), bf_hi(w[j].w)}; }
}
__device__ __forceinline__ void ln_phase(Frame& F, const bf16* YB, const float* gam, const float* bet, bf16* XB) {
    const int gw = F.vcu * 8 + F.wave, NGW = F.G * 8, lane = F.lane;
    f32x4 gg[8], bb[8]; ln_load_gb8(gam, bet, gg, bb, lane);
    for (int m = gw; m < MTOK; m += 2 * NGW) {
        const int m2 = m + NGW; const bool has2 = m2 < MTOK;
        u32x4 wa[4], wb[4];
#pragma unroll
        for (int j = 0; j < 4; ++j) wa[j] = *(const u32x4*)(YB + (size_t)m * D + (lane + 64 * j) * 8);
#pragma unroll
        for (int j = 0; j < 4; ++j) wb[j] = *(const u32x4*)(YB + (size_t)(has2 ? m2 : m) * D + (lane + 64 * j) * 8);
        f32x4 v[8];
        ln_unpack8(wa, v); ln_core(v, gg, bb); ln_store8(v, XB + (size_t)m * D, lane);
        if (has2) { ln_unpack8(wb, v); ln_core(v, gg, bb); ln_store8(v, XB + (size_t)m2 * D, lane); }
    }
}
template <int J> __device__ __forceinline__ void pool_chunk8(const bf16* U, bf16* MIX, int m0, int t0, int lane) {
    constexpr int W = 2 << J, NR = W + 7;
    const int c = lane + 64 * J;
    u32x4 x[NR];
#pragma unroll
    for (int i = 0; i < NR; ++i) { const int dt = i - (W - 1); x[i] = *(const u32x4*)(U + (size_t)(m0 + ((t0 + dt >= 0) ? dt : 0)) * D + c * 8); }
    float sum[8];
#pragma unroll
    for (int e = 0; e < 8; ++e) sum[e] = 0.f;
#pragma unroll
    for (int i = 0; i < W - 1; ++i) { const float k = (t0 + i - (W - 1) >= 0) ? 1.f : 0.f;
#pragma unroll
        for (int e = 0; e < 4; ++e) { sum[2 * e] += k * bf_lo(x[i][e]); sum[2 * e + 1] += k * bf_hi(x[i][e]); } }
#pragma unroll
    for (int rr = 0; rr < 8; ++rr) {
        const int t = t0 + rr; const u32x4 cur = x[W - 1 + rr];
#pragma unroll
        for (int e = 0; e < 4; ++e) { sum[2 * e] += bf_lo(cur[e]); sum[2 * e + 1] += bf_hi(cur[e]); }
        const int cnt = (t + 1 < W) ? t + 1 : W; const float rc = 1.0f / (float)cnt; u32x4 o;
#pragma unroll
        for (int e = 0; e < 4; ++e) o[e] = cvt_pk_bf16(sum[2 * e] * rc - bf_lo(cur[e]), sum[2 * e + 1] * rc - bf_hi(cur[e]));
        *(u32x4*)(MIX + (size_t)(m0 + rr) * D + c * 8) = o;
        const float k = (t - (W - 1) >= 0) ? 1.f : 0.f;
#pragma unroll
        for (int e = 0; e < 4; ++e) { sum[2 * e] -= k * bf_lo(x[rr][e]); sum[2 * e + 1] -= k * bf_hi(x[rr][e]); }
    }
}
__device__ __forceinline__ void pool_phase(Frame& F) {
    const bf16* U = (const bf16*)(F.ws + WS_U); bf16* MIX = (bf16*)(F.ws + WS_MIX);
    const int gw = F.vcu * 8 + F.wave, NGW = F.G * 8, lane = F.lane;
    for (int m0 = gw * 8; m0 < MTOK; m0 += NGW * 8) { const int t0 = m0 & (SEQ - 1);
        pool_chunk8<0>(U, MIX, m0, t0, lane); pool_chunk8<1>(U, MIX, m0, t0, lane); pool_chunk8<2>(U, MIX, m0, t0, lane); pool_chunk8<3>(U, MIX, m0, t0, lane); }
}
__device__ __forceinline__ void ln_router_phase(Frame& F, const float* Y, const float* gam, const float* bet, const float* wrt, bf16* XB) {
    const int gw = F.vcu * 8 + F.wave, NGW = F.G * 8, lane = F.lane, tid = F.tid;
    LAS float* WR = (LAS float*)F.lds;
    LAS int* cntl = (LAS int*)(F.lds + 65536);
    LAS int* info = (LAS int*)(F.lds + 65536 + 64);
    int* LIST = (int*)(F.ws + WS_LIST); int* TOK = (int*)(F.ws + WS_TOK); unsigned* gcnt = (unsigned*)(F.ws + WS_CTL) + CW_CNT;
    __syncthreads();
    for (int i = tid; i < D * NE; i += 512) { const int c = i >> 3, e = i & 7; WR[e * D + c] = wrt[i]; }
    if (tid < 16) cntl[tid] = 0;
    __syncthreads();
    f32x4 gg[8], bb[8];
#pragma unroll
    for (int j = 0; j < 8; ++j) { gg[j] = *(const f32x4*)(gam + 4 * lane + 256 * j); bb[j] = *(const f32x4*)(bet + 4 * lane + 256 * j); }
    int k = 0;
    f32x4 vn[8];
#pragma unroll
    for (int j = 0; j < 8; ++j) vn[j] = *(const f32x4*)(Y + (size_t)(gw < MTOK ? gw : 0) * D + 4 * lane + 256 * j);
    for (int m = gw; m < MTOK; m += NGW, ++k) {
        f32x4 v[8];
#pragma unroll
        for (int j = 0; j < 8; ++j) v[j] = vn[j];
        { const int mn = (m + NGW < MTOK) ? m + NGW : m;
#pragma unroll
          for (int j = 0; j < 8; ++j) vn[j] = *(const f32x4*)(Y + (size_t)mn * D + 4 * lane + 256 * j); }
        ln_core(v, gg, bb); ln_store(v, XB + (size_t)m * D, lane);
        float lg[8];
#pragma unroll
        for (int e = 0; e < 8; ++e) { float s = 0.f;
#pragma unroll
            for (int j = 0; j < 8; ++j) { const f32x4 wv = *(const LAS f32x4*)(WR + e * D + 4 * lane + 256 * j); s += (v[j][0] * wv[0] + v[j][1] * wv[1]) + (v[j][2] * wv[2] + v[j][3] * wv[3]); }
            lg[e] = wave_sum(s); }
        int e1 = 0; float v1 = lg[0];
#pragma unroll
        for (int e = 1; e < 8; ++e) if (lg[e] > v1) { v1 = lg[e]; e1 = e; }
        int e2 = -1; float v2 = -__builtin_inff();
#pragma unroll
        for (int e = 0; e < 8; ++e) if (e != e1 && lg[e] > v2) { v2 = lg[e]; e2 = e; }
        if (lane == 0 && k < 8) { const float ex = __expf(v2 - v1), g1 = 1.0f / (1.0f + ex), g2 = ex * g1;
            const int ls1 = atomicAdd((int*)&cntl[e1], 1), ls2 = atomicAdd((int*)&cntl[e2], 1);
            LAS int* q = info + (F.wave * 8 + k) * 8; q[0] = m; q[1] = e1; q[2] = e2; q[3] = ls1; q[4] = ls2; q[5] = __float_as_int(g1); q[6] = __float_as_int(g2); }
    }
    const int nrows = k < 8 ? k : 8;
    if (lane == 0) info[512 + F.wave] = nrows;
    __syncthreads();
    if (tid < 8) cntl[8 + tid] = (int)__hip_atomic_fetch_add(gcnt + 64 * tid, (unsigned)cntl[tid], __ATOMIC_RELAXED, __HIP_MEMORY_SCOPE_AGENT);
    __syncthreads();
    if (tid < 64) { const int wv = tid >> 3, kk = tid & 7;
        if (kk < info[512 + wv]) { const LAS int* q = info + tid * 8; const int m = q[0], e1 = q[1], e2 = q[2], s1 = cntl[8 + e1] + q[3], s2 = cntl[8 + e2] + q[4];
            LIST[e1 * MTOK + s1] = m; LIST[e2 * MTOK + s2] = m;
            int* t = TOK + (size_t)m * 8; t[0] = e1; t[1] = s1; t[2] = q[5]; t[3] = e2; t[4] = s2; t[5] = q[6]; } }
    __syncthreads();
}
__device__ __forceinline__ void moe_prefix(Frame& F, int (&tb)[9], int (&cnt)[8]) {
    const unsigned* gcnt = (const unsigned*)(F.ws + WS_CTL) + CW_CNT; tb[0] = 0;
#pragma unroll
    for (int e = 0; e < 8; ++e) { cnt[e] = (int)__builtin_amdgcn_readfirstlane(gcnt[64 * e]); tb[e + 1] = tb[e] + ((cnt[e] + 255) >> 8); }
}
__device__ __forceinline__ void moe_fill_idx(Frame& F, const pg8::MoeOrder& S, const int (&tb)[9], const int (&cnt)[8]) {
    LAS unsigned short* idx = (LAS unsigned short*)(F.lds + pg8::IDX_LDS_OFF); const int* LIST = (const int*)(F.ws + WS_LIST);
    const int row = F.tid & 255, sub = F.tid >> 8;
    for (int ui = 0; ui < 30; ui += 2) {
        pg8::Unit u0; if (!S.next(ui, u0)) break;
        pg8::Unit u; const int uu = ui + sub;
        if (S.next(uu, u)) { int base = 0, ce = 0;
#pragma unroll
            for (int j = 0; j < 8; ++j) if (j == u.e) { base = tb[j]; ce = cnt[j]; }
            const int sidx = (u.pm - base) * 256 + row; const int tok = LIST[u.e * MTOK + (sidx < ce ? sidx : 0)];
            idx[uu * 256 + row] = (unsigned short)tok; }
    }
    __syncthreads();
}
__device__ __forceinline__ int gather_src(const int (&tb)[9], const int (&cnt)[8], const int* LIST, int rr) {
    const int tile = rr >> 8; int e = 0;
#pragma unroll
    for (int j = 1; j < 8; ++j) e += (tile >= tb[j]) ? 1 : 0;
    int base = 0, ce = 0;
#pragma unroll
    for (int j = 0; j < 8; ++j) if (j == e) { base = tb[j] * 256; ce = cnt[j]; }
    const int sidx = rr - base; return (sidx < ce) ? LIST[e * MTOK + sidx] : -1;
}
__device__ __forceinline__ void gather_phase(Frame& F) {
    const int gw = F.vcu * 8 + F.wave, NGW = F.G * 8, lane = F.lane;
    int tb[9], cnt[8]; moe_prefix(F, tb, cnt);
    const int* LIST = (const int*)(F.ws + WS_LIST); const bf16* XB = (const bf16*)(F.ws + WS_XB0); bf16* XG = (bf16*)(F.ws + WS_XG);
    const int rows = tb[8] * 256;
    for (int rr = gw; rr < rows; rr += 4 * NGW) {
        int tk[4];
#pragma unroll
        for (int k = 0; k < 4; ++k) { const int r = rr + k * NGW; tk[k] = (r < rows) ? gather_src(tb, cnt, LIST, r) : -2; }
        u32x4 v[4][4];
#pragma unroll
        for (int k = 0; k < 4; ++k)
#pragma unroll
            for (int j = 0; j < 4; ++j) v[k][j] = (tk[k] >= 0) ? *(const u32x4*)(XB + (size_t)tk[k] * D + (lane + 64 * j) * 8) : (u32x4){0u, 0u, 0u, 0u};
#pragma unroll
        for (int k = 0; k < 4; ++k) if (tk[k] != -2) {
#pragma unroll
            for (int j = 0; j < 4; ++j) *(u32x4*)(XG + (size_t)(rr + k * NGW) * D + (lane + 64 * j) * 8) = v[k][j]; }
    }
}
struct MoeRow { int r1, r2; float g1, g2; };
__device__ __forceinline__ MoeRow moe_row_info(const int* TOK, const int (&tb)[9], int m) {
    const int* t = TOK + (size_t)m * 8; const int e1 = t[0], s1 = t[1], e2 = t[3], s2 = t[4]; MoeRow r; r.g1 = __int_as_float(t[2]); r.g2 = __int_as_float(t[5]);
    int b1 = 0, b2 = 0;
#pragma unroll
    for (int j = 0; j < 8; ++j) { if (j == e1) b1 = tb[j] * 256; if (j == e2) b2 = tb[j] * 256; }
    r.r1 = b1 + s1; r.r2 = b2 + s2; return r;
}
__device__ __forceinline__ void ln_moe_phase(Frame& F, const bf16* X4, const float* gam, const float* bet, bf16* XB) {
    const int gw = F.vcu * 8 + F.wave, NGW = F.G * 8, lane = F.lane;
    int tb[9], cnt[8]; moe_prefix(F, tb, cnt);
    const int* TOK = (const int*)(F.ws + WS_TOK); const bf16* YE = (const bf16*)(F.ws + WS_XG); const bf16* YEP = (const bf16*)(F.ws + WS_YEP); constexpr size_t QSTR = (size_t)8 * 256 * D;
    const int split0 = (((8 * tb[8]) / F.G) * F.G >> 3) * 256;
    f32x4 gg[8], bb[8]; ln_load_gb8(gam, bet, gg, bb, lane);
    for (int m0 = gw; m0 < MTOK; m0 += 2 * NGW) {
        const bool has2 = (m0 + NGW) < MTOK; const int mm[2] = {m0, has2 ? m0 + NGW : m0};
        MoeRow ri[2]; ri[0] = moe_row_info(TOK, tb, mm[0]); ri[1] = moe_row_info(TOK, tb, mm[1]);
        u32x4 xw[2][4], aw[2][4], bw[2][4]; const bf16* y1[2]; const bf16* y2[2]; bool p1[2], p2[2];
#pragma unroll
        for (int q = 0; q < 2; ++q) { p1[q] = ri[q].r1 >= split0; p2[q] = ri[q].r2 >= split0;
            y1[q] = p1[q] ? YEP + (size_t)(ri[q].r1 - split0) * D : YE + (size_t)ri[q].r1 * D; y2[q] = p2[q] ? YEP + (size_t)(ri[q].r2 - split0) * D : YE + (size_t)ri[q].r2 * D;
#pragma unroll
            for (int j = 0; j < 4; ++j) { const int c = (lane + 64 * j) * 8; xw[q][j] = *(const u32x4*)(X4 + (size_t)mm[q] * D + c); aw[q][j] = *(const u32x4*)(y1[q] + c); bw[q][j] = *(const u32x4*)(y2[q] + c); } }
#pragma unroll
        for (int q = 0; q < 2; ++q) { if (q == 1 && !has2) break;
            const float g1 = ri[q].g1, g2 = ri[q].g2; f32x4 v[8];
#pragma unroll
            for (int j = 0; j < 4; ++j) { const int c = (lane + 64 * j) * 8; const u32x4 x = xw[q][j], a = aw[q][j], b = bw[q][j];
                float fa[8], fb[8];
#pragma unroll
                for (int e = 0; e < 4; ++e) { fa[2 * e] = bf_lo(a[e]); fa[2 * e + 1] = bf_hi(a[e]); fb[2 * e] = bf_lo(b[e]); fb[2 * e + 1] = bf_hi(b[e]); }
                if (p1[q]) {
#pragma unroll
                    for (int kq = 1; kq < 4; ++kq) { const u32x4 t4 = *(const u32x4*)(y1[q] + (size_t)kq * QSTR + c);
#pragma unroll
                        for (int e = 0; e < 4; ++e) { fa[2 * e] += bf_lo(t4[e]); fa[2 * e + 1] += bf_hi(t4[e]); } } }
                if (p2[q]) {
#pragma unroll
                    for (int kq = 1; kq < 4; ++kq) { const u32x4 t4 = *(const u32x4*)(y2[q] + (size_t)kq * QSTR + c);
#pragma unroll
                        for (int e = 0; e < 4; ++e) { fb[2 * e] += bf_lo(t4[e]); fb[2 * e + 1] += bf_hi(t4[e]); } } }
#pragma unroll
                for (int e = 0; e < 4; ++e) { const float lo = DN_ALPHA * bf_lo(x[e]) + g1 * fa[2 * e] + g2 * fb[2 * e], hi = DN_ALPHA * bf_hi(x[e]) + g1 * fa[2 * e + 1] + g2 * fb[2 * e + 1];
                    v[2 * j + (e >> 1)][(e & 1) * 2] = lo; v[2 * j + (e >> 1)][(e & 1) * 2 + 1] = hi; } }
            ln_core(v, gg, bb); ln_store8(v, XB + (size_t)mm[q] * D, lane);
        }
    }
}

constexpr int NPHASE = 19;
__global__ void __launch_bounds__(512, 2) fwd_kernel(Args args) {
    extern __shared__ __attribute__((aligned(16))) unsigned char lds[];
    Frame F; F.lds = (LAS unsigned char*)lds; F.tid = threadIdx.x; F.lane = F.tid & 63; F.wave = __builtin_amdgcn_readfirstlane(F.tid >> 6);
    F.G = gridDim.x; { const int bx = blockIdx.x; F.vcu = (F.G % 8 == 0) ? (bx % 8) * (F.G / 8) + bx / 8 : bx; }
    F.ws = args.ws; unsigned char* ws = args.ws;
    volatile LAS unsigned* MISC = (volatile LAS unsigned*)(F.lds + MISC_OFF);
    for (int u = F.tid; u < (LDS_BYTES - LDSCTL_OFF) / 4; u += 512) ((LAS unsigned*)(F.lds + LDSCTL_OFF))[u] = 0u;
    __syncthreads();
    XcdBarrier bar; bar.bar = (unsigned*)(ws + WS_CTL) + CW_BAR; bar.x = 0; bar.st = nullptr;
    if (args.ph_hi - args.ph_lo > 1) bar = xcd_barrier_post((unsigned*)(ws + WS_CTL) + CW_BAR, MISC + 8);
    const int lo = args.ph_lo, hi = args.ph_hi;
#define IN(k) (lo <= (k) && (k) < hi)
    long long pht0 = 0, pht1 = 0; if (PHT_SEL == 0) pht0 = wall_clock64();
#define SEAM(k) do { if (IN(k) && IN((k) + 1)) xcd_barrier(bar); if (PHT_SEL == (k) + 1) pht0 = wall_clock64(); if (PHT_SEL == (k)) pht1 = wall_clock64(); } while (0)
    LAS unsigned char* ring = F.lds;
    const int bx = (int)blockIdx.x;
    bf16* XB0 = (bf16*)(ws + WS_XB0); bf16* XB1 = (bf16*)(ws + WS_XB1); bf16* YB = (bf16*)(ws + WS_YB); float* Y = args.out;

    if (IN(0)) { p0_prologue(F, args); }
    if constexpr ((DUP_MASK >> 0) & 1u) { if (IN(0)) { p0_prologue(F, args); } }
    SEAM(0);
    if (IN(1)) {
        { pg8::Gemm g{XB0, (const bf16*)(ws + WS_WQKV), D, D, D}; pg8::StaticOrder S; S.init(MTOK, NQKV, F.G, bx);
          pg8::EpiQKV E{(bf16*)(ws + WS_QKV), (const float*)(ws + WS_ROPE)}; pg8::gemm_phase(ring, g, S, E); }
        { pg8::Gemm g{(const bf16*)(ws + WS_PB), (const bf16*)(ws + WS_WPROJ), PLE, PLE, PLE}; pg8::BatchOrder S; S.init(MTOK, D, 2, (size_t)MTOK * PLE, (size_t)D * PLE, F.G, bx);
          pg8::EpiBf16 E{(bf16*)(ws + WS_PPROJ), D, (size_t)MTOK * D, 0}; pg8::gemm_phase(ring, g, S, E); }
        {
          pg8::Gemm g{(const bf16*)(ws + WS_WO2), (const bf16*)(ws + WS_WGS), 512, D, 512}; pg8::BatchOrder S; S.init(D, 512, 4, (size_t)512, (size_t)512 * 512, F.G, bx);
          pg8::EpiBf16 E{(bf16*)(ws + WS_WCOMB), D, (size_t)0, 512}; pg8::gemm_phase(ring, g, S, E); }
    }
    if constexpr ((DUP_MASK >> 1) & 1u) { if (IN(1)) {
        { pg8::Gemm g{XB0, (const bf16*)(ws + WS_WQKV), D, D, D}; pg8::StaticOrder S; S.init(MTOK, NQKV, F.G, bx);
          pg8::EpiQKV E{(bf16*)(ws + WS_QKV), (const float*)(ws + WS_ROPE)}; pg8::gemm_phase(ring, g, S, E); }
        { pg8::Gemm g{(const bf16*)(ws + WS_PB), (const bf16*)(ws + WS_WPROJ), PLE, PLE, PLE}; pg8::BatchOrder S; S.init(MTOK, D, 2, (size_t)MTOK * PLE, (size_t)D * PLE, F.G, bx);
          pg8::EpiBf16 E{(bf16*)(ws + WS_PPROJ), D, (size_t)MTOK * D, 0}; pg8::gemm_phase(ring, g, S, E); }
        {
          pg8::Gemm g{(const bf16*)(ws + WS_WO2), (const bf16*)(ws + WS_WGS), 512, D, 512}; pg8::BatchOrder S; S.init(D, 512, 4, (size_t)512, (size_t)512 * 512, F.G, bx);
          pg8::EpiBf16 E{(bf16*)(ws + WS_WCOMB), D, (size_t)0, 512}; pg8::gemm_phase(ring, g, S, E); }
    } }
    SEAM(1);
    if (IN(2)) { attn_phase(F); }
    if constexpr ((DUP_MASK >> 2) & 1u) { if (IN(2)) { attn_phase(F); } }
    SEAM(2);
    if (IN(3)) { combine_phase(F); moe_convert_phase(F, args); }
    if constexpr ((DUP_MASK >> 3) & 1u) { if (IN(3)) { combine_phase(F); moe_convert_phase(F, args); } }
    SEAM(3);
    if (IN(4)) { pg8::Gemm g{(const bf16*)(ws + WS_ATT), (const bf16*)(ws + WS_WO), D, D, D}; pg8::StaticOrder S; S.init(MTOK, D, F.G, bx);
        pg8::EpiRes<false> E{XB0, YB, D, DN_ALPHA}; pg8::gemm_phase(ring, g, S, E); }
    if constexpr ((DUP_MASK >> 4) & 1u) { if (IN(4)) { pg8::Gemm g{(const bf16*)(ws + WS_ATT), (const bf16*)(ws + WS_WO), D, D, D}; pg8::StaticOrder S; S.init(MTOK, D, F.G, bx);
        pg8::EpiRes<false> E{XB0, YB, D, DN_ALPHA}; pg8::gemm_phase(ring, g, S, E); } }
    SEAM(4);
    if (IN(5)) { ln_phase(F, YB, args.in[8], args.in[9], XB0); }
    if constexpr ((DUP_MASK >> 5) & 1u) { if (IN(5)) { ln_phase(F, YB, args.in[8], args.in[9], XB0); } }
    SEAM(5);
    if (IN(6)) { pg8::Gemm g{XB0, (const bf16*)(ws + WS_W13), D, D, D}; pg8::StaticOrder S; S.init(MTOK, FF2, F.G, bx);
        pg8::EpiSwiGLU E{(bf16*)(ws + WS_H), FF}; pg8::gemm_phase<pg8::EpiSwiGLU, pg8::StaticOrder, true, true, (STAMP_SEL != 0)>(ring, g, S, E, (unsigned long long*)(ws + WS_CTL + 512 * 1024)); }
    if constexpr ((DUP_MASK >> 6) & 1u) { if (IN(6)) { pg8::Gemm g{XB0, (const bf16*)(ws + WS_W13), D, D, D}; pg8::StaticOrder S; S.init(MTOK, FF2, F.G, bx);
        pg8::EpiSwiGLU E{(bf16*)(ws + WS_H), FF}; pg8::gemm_phase(ring, g, S, E); } }
    SEAM(6);
    if (IN(7)) { pg8::Gemm g{(const bf16*)(ws + WS_H), (const bf16*)(ws + WS_W2), FF, FF, FF}; pg8::StaticOrder S; S.init(MTOK, D, F.G, bx);
        pg8::EpiRes<false> E{XB0, YB, D, DN_ALPHA}; pg8::gemm_phase(ring, g, S, E); }
    if constexpr ((DUP_MASK >> 7) & 1u) { if (IN(7)) { pg8::Gemm g{(const bf16*)(ws + WS_H), (const bf16*)(ws + WS_W2), FF, FF, FF}; pg8::StaticOrder S; S.init(MTOK, D, F.G, bx);
        pg8::EpiRes<false> E{XB0, YB, D, DN_ALPHA}; pg8::gemm_phase(ring, g, S, E); } }
    SEAM(7);
    if (IN(8)) { ln_phase(F, YB, args.in[10], args.in[11], XB0); }
    if constexpr ((DUP_MASK >> 8) & 1u) { if (IN(8)) { ln_phase(F, YB, args.in[10], args.in[11], XB0); } }
    SEAM(8);
    if (IN(9)) { pg8::Gemm g{XB0, (const bf16*)(ws + WS_WGATE), D, D, D}; pg8::StaticOrder S; S.init(MTOK, D, F.G, bx);
        pg8::EpiPle E{XB0, (const bf16*)(ws + WS_PPROJ), args.in[21], nullptr, XB1, D}; pg8::gemm_phase(ring, g, S, E); }
    if constexpr ((DUP_MASK >> 9) & 1u) { if (IN(9)) { pg8::Gemm g{XB0, (const bf16*)(ws + WS_WGATE), D, D, D}; pg8::StaticOrder S; S.init(MTOK, D, F.G, bx);
        pg8::EpiPle E{XB0, (const bf16*)(ws + WS_PPROJ), args.in[21], nullptr, XB1, D}; pg8::gemm_phase(ring, g, S, E); } }
    SEAM(9);
    if (IN(10)) { pg8::Gemm g{XB1, (const bf16*)(ws + WS_WIN), D, D, D}; pg8::StaticOrder S; S.init(MTOK, D, F.G, bx);
        pg8::EpiBf16 E{(bf16*)(ws + WS_U), D, (size_t)0, 0}; pg8::gemm_phase(ring, g, S, E); }
    if constexpr ((DUP_MASK >> 10) & 1u) { if (IN(10)) { pg8::Gemm g{XB1, (const bf16*)(ws + WS_WIN), D, D, D}; pg8::StaticOrder S; S.init(MTOK, D, F.G, bx);
        pg8::EpiBf16 E{(bf16*)(ws + WS_U), D, (size_t)0, 0}; pg8::gemm_phase(ring, g, S, E); } }
    SEAM(10);
    if (IN(11)) { pool_phase(F); }
    if constexpr ((DUP_MASK >> 11) & 1u) { if (IN(11)) { pool_phase(F); } }
    SEAM(11);
    if (IN(12)) { pg8::Gemm g{(const bf16*)(ws + WS_MIX), (const bf16*)(ws + WS_WCOMB), D, D, D}; pg8::StaticOrder S; S.init(MTOK, D, F.G, bx);
        pg8::EpiRes<true> E{XB1, Y, D, DN_ALPHA}; pg8::gemm_phase(ring, g, S, E); }
    if constexpr ((DUP_MASK >> 12) & 1u) { if (IN(12)) { pg8::Gemm g{(const bf16*)(ws + WS_MIX), (const bf16*)(ws + WS_WCOMB), D, D, D}; pg8::StaticOrder S; S.init(MTOK, D, F.G, bx);
        pg8::EpiRes<true> E{XB1, Y, D, DN_ALPHA}; pg8::gemm_phase(ring, g, S, E); } }
    SEAM(12);
    if (IN(13)) { ln_router_phase(F, Y, args.in[8] + D, args.in[9] + D, args.in[15], XB0); }
    if constexpr ((DUP_MASK >> 13) & 1u) { if (IN(13)) { ln_router_phase(F, Y, args.in[8] + D, args.in[9] + D, args.in[15], XB0); } }
    SEAM(13);
    if (PHT_SEL == 15) pht0 = wall_clock64();
    if (IN(15)) { int tb[9], cnt[8]; moe_prefix(F, tb, cnt);
        pg8::Gemm g{XB0, (const bf16*)(ws + WS_MW13), D, D, D}; pg8::MoeOrder S; S.nM = tb[8]; S.nN = FF2 / 256; S.nwg = S.nM * S.nN; S.G = F.G; S.c = bx; S.sB = (size_t)FF2 * D; S.gather = true;
#pragma unroll
        for (int j = 0; j < 9; ++j) S.tb[j] = tb[j];
        moe_fill_idx(F, S, tb, cnt);
        pg8::EpiSwiGLU E{(bf16*)(ws + WS_HM), FF}; pg8::gemm_phase<pg8::EpiSwiGLU, pg8::MoeOrder, true, true, false, true>(ring, g, S, E); }
    if constexpr ((DUP_MASK >> 15) & 1u) { if (IN(15)) { int tb[9], cnt[8]; moe_prefix(F, tb, cnt);
        pg8::Gemm g{XB0, (const bf16*)(ws + WS_MW13), D, D, D}; pg8::MoeOrder S; S.nM = tb[8]; S.nN = FF2 / 256; S.nwg = S.nM * S.nN; S.G = F.G; S.c = bx; S.sB = (size_t)FF2 * D; S.gather = true;
#pragma unroll
        for (int j = 0; j < 9; ++j) S.tb[j] = tb[j];
        moe_fill_idx(F, S, tb, cnt);
        pg8::EpiSwiGLU E{(bf16*)(ws + WS_HM), FF}; pg8::gemm_phase<pg8::EpiSwiGLU, pg8::MoeOrder, true, true, false, true>(ring, g, S, E); } }
    SEAM(15);
    if (IN(16)) { int tb[9], cnt[8]; moe_prefix(F, tb, cnt);
        pg8::Gemm g{(const bf16*)(ws + WS_HM), (const bf16*)(ws + WS_MW2), FF, FF, FF}; pg8::MoeDownOrder S; S.nM = tb[8]; S.G = F.G; S.c = F.vcu; S.nfull = ((8 * tb[8]) / F.G) * F.G; S.kq_elems = FF / 4; S.kq_nt = FF / 4 / 64; S.sB = (size_t)D * FF;
#pragma unroll
        for (int j = 0; j < 9; ++j) S.tb[j] = tb[j];
        pg8::EpiMoeDown E{(bf16*)(ws + WS_XG), (bf16*)(ws + WS_YEP), S.nfull >> 3, (size_t)8 * 256 * D}; pg8::gemm_phase(ring, g, S, E); }
    if constexpr ((DUP_MASK >> 16) & 1u) { if (IN(16)) { int tb[9], cnt[8]; moe_prefix(F, tb, cnt);
        pg8::Gemm g{(const bf16*)(ws + WS_HM), (const bf16*)(ws + WS_MW2), FF, FF, FF}; pg8::MoeDownOrder S; S.nM = tb[8]; S.G = F.G; S.c = F.vcu; S.nfull = ((8 * tb[8]) / F.G) * F.G; S.kq_elems = FF / 4; S.kq_nt = FF / 4 / 64; S.sB = (size_t)D * FF;
#pragma unroll
        for (int j = 0; j < 9; ++j) S.tb[j] = tb[j];
        pg8::EpiMoeDown E{(bf16*)(ws + WS_XG), (bf16*)(ws + WS_YEP), S.nfull >> 3, (size_t)8 * 256 * D}; pg8::gemm_phase(ring, g, S, E); } }
    SEAM(16);
    if (IN(17)) { ln_moe_phase(F, XB0, args.in[10] + D, args.in[11] + D, XB1); }
    if constexpr ((DUP_MASK >> 17) & 1u) { if (IN(17)) { ln_moe_phase(F, XB0, args.in[10] + D, args.in[11] + D, XB1); } }
    SEAM(17);
    if (IN(18)) { pg8::Gemm g{XB1, (const bf16*)(ws + WS_WGATE) + (size_t)D * D, D, D, D}; pg8::StaticOrder S; S.init(MTOK, D, F.G, bx);
        pg8::EpiPle E{XB1, (const bf16*)(ws + WS_PPROJ) + (size_t)MTOK * D, args.in[21] + D, args.out, nullptr, D}; pg8::gemm_phase(ring, g, S, E); }
    if constexpr ((DUP_MASK >> 18) & 1u) { if (IN(18)) { pg8::Gemm g{XB1, (const bf16*)(ws + WS_WGATE) + (size_t)D * D, D, D, D}; pg8::StaticOrder S; S.init(MTOK, D, F.G, bx);
        pg8::EpiPle E{XB1, (const bf16*)(ws + WS_PPROJ) + (size_t)MTOK * D, args.in[21] + D, args.out, nullptr, D}; pg8::gemm_phase(ring, g, S, E); } }
    if (STAMP_SEL != 0 && blockIdx.x == 0 && F.tid == 0 && hi == NPHASE) { const unsigned long long us = ((volatile unsigned long long*)(ws + WS_CTL + 512 * 1024))[STAMP_SEL - 1]; const long long w0 = wall_clock64(); while ((unsigned long long)(wall_clock64() - w0) < us * 100ull) __builtin_amdgcn_s_sleep(32); }
    if (PHT_SEL >= 0 && blockIdx.x == 0 && F.tid == 0 && hi == NPHASE) { if (PHT_SEL == NPHASE - 1) pht1 = wall_clock64(); const long long w0 = wall_clock64(); while (wall_clock64() - w0 < PHT_MULT * (pht1 - pht0)) __builtin_amdgcn_s_sleep(32); }
#undef IN
#undef SEAM
}

extern "C" void kernel_launch(void* const* d_in, const int* in_sizes, int n_in, void* d_out, int out_size, void* d_ws, size_t ws_size, hipStream_t stream) {
    static int grid = 0; static bool one_launch = true;
    if (grid == 0) {
        if (n_in != 22 || out_size != MTOK * D || ws_size < WS_END) { fprintf(stderr, "kernel_launch: unexpected shapes (n_in %d, out %d, ws %zu < %zu)\n", n_in, out_size, ws_size, (size_t)WS_END); grid = -1; return; }
        int dev = 0, cus = 0, per_cu = 0;
        if (hipGetDevice(&dev) != hipSuccess || hipDeviceGetAttribute(&cus, hipDeviceAttributeMultiprocessorCount, dev) != hipSuccess) { grid = -1; return; }
        if (hipFuncSetAttribute((const void*)fwd_kernel, hipFuncAttributeMaxDynamicSharedMemorySize, LDS_BYTES) != hipSuccess) { fprintf(stderr, "kernel_launch: hipFuncSetAttribute failed\n"); grid = -1; return; }
        if (hipOccupancyMaxActiveBlocksPerMultiprocessor(&per_cu, (const void*)fwd_kernel, 512, LDS_BYTES) != hipSuccess || per_cu < 1) { fprintf(stderr, "kernel_launch: occupancy query says %d blocks per CU\n", per_cu); }
        (void)hipGetLastError();
        grid = 256;
        one_launch = (cus >= 256);
    }
    if (grid < 0) return;
    (void)hipMemsetAsync((char*)d_ws + WS_CTL, 0, CTL_ZERO_BYTES, stream);
    Args a{};
    for (int i = 0; i < 22; ++i) a.in[i] = (const float*)d_in[i];
    a.out = (float*)d_out; a.ws = (unsigned char*)d_ws;
    if (MK_PER_PHASE || !one_launch) { for (int p = 0; p < NPHASE; ++p) { a.ph_lo = p; a.ph_hi = p + 1; hipLaunchKernelGGL(fwd_kernel, dim3(grid), dim3(512), LDS_BYTES, stream, a); } }
    else { a.ph_lo = 0; a.ph_hi = NPHASE; hipLaunchKernelGGL(fwd_kernel, dim3(grid), dim3(512), LDS_BYTES, stream, a); }
}
```

```cpp
#include <hip/hip_runtime.h>
#include <cstdio>
#include <cstdint>

#ifndef MK_PER_PHASE
#define MK_PER_PHASE 0
#endif
#ifndef STAMP_SEL
#define STAMP_SEL 0
#endif
#ifndef PHT_SEL
#define PHT_SEL -1
#endif
#define PHT_MULT 4
#ifndef DUP_MASK
#define DUP_MASK 0u
#endif

#define LAS __attribute__((address_space(3)))
#define GAS __attribute__((address_space(1)))
typedef unsigned short bf16;
typedef short bf16x8 __attribute__((ext_vector_type(8)));
typedef short s16x4 __attribute__((ext_vector_type(4)));
typedef float f32x4 __attribute__((ext_vector_type(4)));
typedef float f32x2 __attribute__((ext_vector_type(2)));
typedef unsigned u32x4 __attribute__((ext_vector_type(4)));
typedef unsigned u32x2 __attribute__((ext_vector_type(2)));
typedef GAS unsigned gu32;

constexpr int D = 2048, BATCH = 4, SEQ = 4096, MTOK = BATCH * SEQ;
constexpr int NH = 16, HD = 128, NQKV = 3 * 3 * D;
constexpr int FF = 5632, FF2 = 2 * FF;
constexpr int NE = 8, PLE = 256;
constexpr float LN_EPS = 1e-5f;
constexpr float DN_ALPHA = 1.41421356237309515f;
constexpr int MOE_ROWS = 2 * MTOK + NE * 256;

constexpr size_t MiB = 1u << 20;
constexpr size_t WS_CTL = 0, CTL_ZERO_BYTES = 1 * MiB;
constexpr size_t WS_LIST = 1 * MiB;
constexpr size_t WS_TOK = 2 * MiB;
constexpr size_t WS_LSE = 3 * MiB;
constexpr size_t WS_ROPE = 6 * MiB;
constexpr size_t WS_WGATE = 8 * MiB;
constexpr size_t WS_WPROJ = 24 * MiB;
constexpr size_t WS_WIN = 26 * MiB;
constexpr size_t WS_WCOMB = 34 * MiB;
constexpr size_t WS_WO2 = 42 * MiB;
constexpr size_t WS_WGS = 50 * MiB;
constexpr size_t WS_PB = 52 * MiB;
constexpr size_t WS_PPROJ = 68 * MiB;
constexpr size_t WS_XB0 = 196 * MiB;
constexpr size_t WS_YB = 260 * MiB;
constexpr size_t WS_WQKV = 516 * MiB;
constexpr size_t WS_WO = 588 * MiB;
constexpr size_t WS_W13 = 596 * MiB;
constexpr size_t WS_W2 = 640 * MiB;
constexpr size_t WS_QKV = 662 * MiB;
constexpr size_t WS_OG = 1238 * MiB;
constexpr size_t WS_ATT = 1430 * MiB;
constexpr size_t WS_MW13 = 662 * MiB;
constexpr size_t WS_MW2 = 1014 * MiB;
constexpr size_t WS_H = 1238 * MiB;
constexpr size_t WS_XB1 = 1430 * MiB;
constexpr size_t WS_U = 1190 * MiB;
constexpr size_t WS_MIX = 1254 * MiB;
constexpr size_t WS_HM = 1190 * MiB;
constexpr size_t WS_XG = 516 * MiB;
constexpr size_t WS_YEP = 324 * MiB;
constexpr size_t WS_END = 1564 * MiB;
static_assert(WS_MW2 + (size_t)NE * D * FF * 2 <= WS_U && WS_HM + (size_t)MOE_ROWS * FF * 2 <= WS_END && WS_XG + (size_t)MOE_ROWS * D * 2 <= WS_QKV, "ws map");

constexpr int CW_CNT = 64;
constexpr int CW_BAR = 4096;

constexpr int RING_BYTES = 131072;
constexpr int LDSCTL_OFF = RING_BYTES, MISC_OFF = LDSCTL_OFF + 320;
constexpr int LDS_BYTES = 163840;

#define VM_WAIT() asm volatile("s_waitcnt vmcnt(0)" ::: "memory")
__device__ __forceinline__ unsigned cvt_pk_bf16(float lo, float hi) { unsigned r; asm volatile("v_cvt_pk_bf16_f32 %0, %1, %2" : "=v"(r) : "v"(lo), "v"(hi)); return r; }
__device__ __forceinline__ float bf_lo(unsigned w) { return __uint_as_float(w << 16); }
__device__ __forceinline__ float bf_hi(unsigned w) { return __uint_as_float(w & 0xffff0000u); }
__device__ __forceinline__ float wave_sum(float v) {
#pragma unroll
    for (int o = 1; o < 64; o <<= 1) v += __shfl_xor(v, o);
    return v;
}

namespace pg8 {
#define PG8_LAS __attribute__((address_space(3)))
typedef unsigned short bf16_t;
constexpr int BM = 256, BK = 64, HALF = 128, HTB = HALF * BK * 2, STAGE_BYTES = 8 * HTB, NXCD = 8, WGM = 8;

__host__ __device__ __forceinline__ int lds_byte(int r, int c) { const int st = (r >> 4) * 2 + (c >> 5), rr = r & 15, cc = c & 31, ob = rr * 64 + cc * 2; return st * 1024 + (ob ^ (((ob >> 9) & 1) << 5)); }
__host__ __device__ __forceinline__ void stage_rc(int b, int& R, int& C) { const int st = b / 1024, sb = b % 1024, swz = sb ^ (((sb >> 9) & 1) << 5); R = (st >> 1) * 16 + swz / 64; C = (st & 1) * 32 + (swz % 64) / 2; }
__host__ __device__ __forceinline__ int perm32(int rho) { const int n = rho >> 4, i = rho & 15; return 8 * (i >> 2) + 4 * n + (i & 3); }

struct Unit { int pm, pn, e; };
struct Gemm { const bf16_t* A; const bf16_t* Bt; int K, lda, ldb; };

__device__ __forceinline__ void tile_of(int wgid, int nM, int nN, int& pm, int& pn) {
    const int nwg = nM * nN;
    { const int q = nwg / NXCD, r = nwg % NXCD, xcd = wgid % NXCD, off = wgid / NXCD; wgid = (xcd < r ? xcd * (q + 1) : r * (q + 1) + (xcd - r) * q) + off; }
    const int nig = WGM * nN, gid = wgid / nig, fm = gid * WGM, gsz = (nM - fm) < WGM ? (nM - fm) : WGM;
    pm = fm + ((wgid % nig) % gsz); pn = (wgid % nig) / gsz;
}
struct StaticOrder {
    int nM, nN, nwg, G, c;
    __device__ __forceinline__ void init(int M, int N, int G_, int c_) { nM = M / BM; nN = N / BM; nwg = nM * nN; G = G_; c = c_; }
    __device__ __forceinline__ bool next(int i, Unit& u) const {
        const long L = (long)i * G + c; if (L >= nwg) return false;
        tile_of((int)L, nM, nN, u.pm, u.pn); u.e = 0; return true;
    }
    __device__ __forceinline__ const char* a_ptr(const Gemm& g, const Unit& u) const { return (const char*)g.A + (size_t)u.pm * BM * g.lda * 2; }
    __device__ __forceinline__ const char* b_ptr(const Gemm& g, const Unit& u) const { return (const char*)g.Bt + (size_t)u.pn * BM * g.ldb * 2; }
    __device__ __forceinline__ int unit_nt(const Gemm& g, const Unit&) const { return g.K / BK; }
};
struct BatchOrder {
    int nM, nN, nwg, nb, G, c; size_t sA, sB;
    __device__ __forceinline__ void init(int M, int N, int nb_, size_t sA_, size_t sB_, int G_, int c_) { nM = M / BM; nN = N / BM; nwg = nM * nN; nb = nb_; sA = sA_; sB = sB_; G = G_; c = c_; }
    __device__ __forceinline__ bool next(int i, Unit& u) const {
        const long L = (long)i * G + c; if (L >= (long)nwg * nb) return false;
        u.e = (int)(L / nwg); tile_of((int)(L % nwg), nM, nN, u.pm, u.pn); return true;
    }
    __device__ __forceinline__ const char* a_ptr(const Gemm& g, const Unit& u) const { return (const char*)(g.A + (size_t)u.e * sA) + (size_t)u.pm * BM * g.lda * 2; }
    __device__ __forceinline__ const char* b_ptr(const Gemm& g, const Unit& u) const { return (const char*)(g.Bt + (size_t)u.e * sB) + (size_t)u.pn * BM * g.ldb * 2; }
    __device__ __forceinline__ int unit_nt(const Gemm& g, const Unit&) const { return g.K / BK; }
};
struct MoeOrder {
    int nM, nN, nwg, G, c; size_t sB; int tb[9]; bool gather;
    __device__ __forceinline__ bool next(int i, Unit& u) const {
        const long L = (long)i * G + c; if (L >= nwg) return false;
        tile_of((int)L, nM, nN, u.pm, u.pn);
        int e = 0;
#pragma unroll
        for (int j = 1; j < 8; ++j) e += (u.pm >= tb[j]) ? 1 : 0;
        u.e = e; return true;
    }
    __device__ __forceinline__ const char* a_ptr(const Gemm& g, const Unit& u) const { return (const char*)g.A + (gather ? (size_t)0 : (size_t)u.pm * BM * g.lda * 2); }
    __device__ __forceinline__ const char* b_ptr(const Gemm& g, const Unit& u) const { return (const char*)(g.Bt + (size_t)u.e * sB) + (size_t)u.pn * BM * g.ldb * 2; }
    __device__ __forceinline__ int unit_nt(const Gemm& g, const Unit&) const { return g.K / BK; }
};

struct MoeDownOrder {
    int nM, G, c, nfull, kq_elems, kq_nt; size_t sB; int tb[9];
    __device__ __forceinline__ bool next(int i, Unit& u) const {
        const long L = (long)i * G + c; int kq1 = 0, uu;
        if (L < nfull) uu = (int)L;
        else { const long L2 = L - nfull; if (L2 >= 4l * (8 * nM - nfull)) return false; uu = nfull + (int)(L2 >> 2); kq1 = (int)(L2 & 3) + 1; }
        u.pm = uu >> 3; u.pn = uu & 7;
        int e = 0;
#pragma unroll
        for (int j = 1; j < 8; ++j) e += (u.pm >= tb[j]) ? 1 : 0;
        u.e = e | (kq1 << 8); return true;
    }
    __device__ __forceinline__ const char* a_ptr(const Gemm& g, const Unit& u) const { const int kq1 = u.e >> 8; return (const char*)g.A + ((size_t)u.pm * BM * g.lda + (size_t)(kq1 ? (kq1 - 1) * kq_elems : 0)) * 2; }
    __device__ __forceinline__ const char* b_ptr(const Gemm& g, const Unit& u) const { const int kq1 = u.e >> 8; return (const char*)(g.Bt + (size_t)(u.e & 255) * sB) + ((size_t)u.pn * BM * g.ldb + (size_t)(kq1 ? (kq1 - 1) * kq_elems : 0)) * 2; }
    __device__ __forceinline__ int unit_nt(const Gemm& g, const Unit& u) const { return (u.e >> 8) ? kq_nt : g.K / BK; }
};


struct EpiBf16 {
    static constexpr bool PERM = true;
    bf16_t* O; int ldc; size_t estride; int ecol;
    __device__ __forceinline__ void operator()(const f32x4 (&acc)[2][2][4][2], const Unit& u, int wr, int wc, int fr, int fq) const {
        const int row0 = u.pm * BM + wr * 64 + fr; const int col0 = u.pn * BM + wc * 32 + 8 * fq + u.e * ecol;
        bf16_t* base = O + (size_t)u.e * estride;
#pragma unroll
        for (int ai = 0; ai < 2; ++ai)
#pragma unroll
            for (int m = 0; m < 4; ++m) { bf16_t* rowp = base + (size_t)(row0 + ai * HALF + m * 16) * ldc + col0;
#pragma unroll
                for (int bj = 0; bj < 2; ++bj) { const f32x4 v0 = acc[ai][bj][m][0], v1 = acc[ai][bj][m][1];
                    u32x4 w; w.x = cvt_pk_bf16(v0[0], v0[1]); w.y = cvt_pk_bf16(v0[2], v0[3]); w.z = cvt_pk_bf16(v1[0], v1[1]); w.w = cvt_pk_bf16(v1[2], v1[3]);
                    *(u32x4*)(rowp + bj * HALF) = w; } }
    }
};
struct EpiMoeDown {
    static constexpr bool PERM = true;
    bf16_t* YE; bf16_t* YEP; int pm_split; size_t qstride;
    __device__ __forceinline__ void operator()(const f32x4 (&acc)[2][2][4][2], const Unit& u, int wr, int wc, int fr, int fq) const {
        const int kq1 = u.e >> 8; const int col0 = u.pn * BM + wc * 32 + 8 * fq;
        bf16_t* base = kq1 ? YEP + (size_t)(kq1 - 1) * qstride + (size_t)((u.pm - pm_split) * BM) * D : YE + (size_t)(u.pm * BM) * D;
        const int row0 = wr * 64 + fr;
#pragma unroll
        for (int ai = 0; ai < 2; ++ai)
#pragma unroll
            for (int m = 0; m < 4; ++m) { bf16_t* rowp = base + (size_t)(row0 + ai * HALF + m * 16) * D + col0;
#pragma unroll
                for (int bj = 0; bj < 2; ++bj) { const f32x4 v0 = acc[ai][bj][m][0], v1 = acc[ai][bj][m][1];
                    u32x4 w; w.x = cvt_pk_bf16(v0[0], v0[1]); w.y = cvt_pk_bf16(v0[2], v0[3]); w.z = cvt_pk_bf16(v1[0], v1[1]); w.w = cvt_pk_bf16(v1[2], v1[3]);
                    *(u32x4*)(rowp + bj * HALF) = w; } }
    }
};
struct EpiF32 {
    static constexpr bool PERM = true;
    float* Y; int ldc;
    __device__ __forceinline__ void operator()(const f32x4 (&acc)[2][2][4][2], const Unit& u, int wr, int wc, int fr, int fq) const {
        const int row0 = u.pm * BM + wr * 64 + fr, col0 = u.pn * BM + wc * 32 + 8 * fq;
#pragma unroll
        for (int ai = 0; ai < 2; ++ai)
#pragma unroll
            for (int m = 0; m < 4; ++m) { float* rowp = Y + (size_t)(row0 + ai * HALF + m * 16) * ldc + col0;
#pragma unroll
                for (int bj = 0; bj < 2; ++bj) { *(f32x4*)(rowp + bj * HALF) = acc[ai][bj][m][0]; *(f32x4*)(rowp + bj * HALF + 4) = acc[ai][bj][m][1]; } }
    }
};
struct EpiQKV {
    static constexpr bool PERM = true;
    bf16_t* O; const float* rope;
    __device__ __forceinline__ void operator()(const f32x4 (&acc)[2][2][4][2], const Unit& u, int wr, int wc, int fr, int fq) const {
        const int gt = u.pn >> 3, t = gt % 3, dsh = 2 * (gt / 3), head = 2 * (u.pn & 7) + (wc >> 1), idx0 = 32 * (wc & 1) + 8 * fq;
        const int row0 = u.pm * BM + wr * 64 + fr; bf16_t* hb = O + ((size_t)(gt * 16 + head) * MTOK) * 128 + idx0;
#pragma unroll
        for (int ai = 0; ai < 2; ++ai)
#pragma unroll
            for (int m = 0; m < 4; ++m) { const int row = row0 + ai * HALF + m * 16; const int sq = row & (SEQ - 1);
                bf16_t* rowp = hb + (size_t)((row & ~(SEQ - 1)) + (sq & ((1 << dsh) - 1)) * (SEQ >> dsh) + (sq >> dsh)) * 128;
                f32x4 l0 = acc[ai][0][m][0], l1 = acc[ai][0][m][1], h0 = acc[ai][1][m][0], h1 = acc[ai][1][m][1];
                if (t < 2) { const float* cp = rope + (size_t)(row & (SEQ - 1)) * 64 + idx0; const float* sp = cp + SEQ * 64;
                    const f32x4 c0 = *(const f32x4*)cp, c1 = *(const f32x4*)(cp + 4), s0 = *(const f32x4*)sp, s1 = *(const f32x4*)(sp + 4);
                    const f32x4 a0 = l0 * c0 - h0 * s0, a1 = l1 * c1 - h1 * s1, b0 = h0 * c0 + l0 * s0, b1 = h1 * c1 + l1 * s1;
                    l0 = a0; l1 = a1; h0 = b0; h1 = b1; }
                u32x4 w; w.x = cvt_pk_bf16(l0[0], l0[1]); w.y = cvt_pk_bf16(l0[2], l0[3]); w.z = cvt_pk_bf16(l1[0], l1[1]); w.w = cvt_pk_bf16(l1[2], l1[3]);
                *(u32x4*)rowp = w;
                w.x = cvt_pk_bf16(h0[0], h0[1]); w.y = cvt_pk_bf16(h0[2], h0[3]); w.z = cvt_pk_bf16(h1[0], h1[1]); w.w = cvt_pk_bf16(h1[2], h1[3]);
                *(u32x4*)(rowp + 64) = w; }
    }
};
struct EpiSwiGLU {
    static constexpr bool PERM = true;
    bf16_t* O; int ldc;
    __device__ __forceinline__ void operator()(const f32x4 (&acc)[2][2][4][2], const Unit& u, int wr, int wc, int fr, int fq) const {
        const int row0 = u.pm * BM + wr * 64 + fr; const int col0 = u.pn * HALF + wc * 32 + 8 * fq;
#pragma unroll
        for (int ai = 0; ai < 2; ++ai)
#pragma unroll
            for (int m = 0; m < 4; ++m) { bf16_t* rowp = O + (size_t)(row0 + ai * HALF + m * 16) * ldc + col0;
                float r[8];
#pragma unroll
                for (int n = 0; n < 2; ++n)
#pragma unroll
                    for (int j = 0; j < 4; ++j) { const float a = acc[ai][0][m][n][j], b = acc[ai][1][m][n][j];
                        const float sg = __builtin_amdgcn_rcpf(1.0f + __builtin_amdgcn_exp2f(-1.4426950408889634f * a)); r[n * 4 + j] = a * sg * b; }
                u32x4 w; w.x = cvt_pk_bf16(r[0], r[1]); w.y = cvt_pk_bf16(r[2], r[3]); w.z = cvt_pk_bf16(r[4], r[5]); w.w = cvt_pk_bf16(r[6], r[7]);
                *(u32x4*)rowp = w; }
    }
};
template <bool F32OUT> struct EpiRes {
    static constexpr bool PERM = true;
    const bf16_t* res; void* Y; int ldc; float alpha;
    __device__ __forceinline__ void operator()(const f32x4 (&acc)[2][2][4][2], const Unit& u, int wr, int wc, int fr, int fq) const {
        const int row0 = u.pm * BM + wr * 64 + fr, col0 = u.pn * BM + wc * 32 + 8 * fq;
#pragma unroll
        for (int ai = 0; ai < 2; ++ai)
#pragma unroll
            for (int m = 0; m < 4; ++m) { const size_t off = (size_t)(row0 + ai * HALF + m * 16) * ldc + col0;
#pragma unroll
                for (int bj = 0; bj < 2; ++bj) { const u32x4 rw = *(const u32x4*)(res + off + bj * HALF);
                    f32x4 v0 = acc[ai][bj][m][0], v1 = acc[ai][bj][m][1];
                    v0[0] += alpha * bf_lo(rw.x); v0[1] += alpha * bf_hi(rw.x); v0[2] += alpha * bf_lo(rw.y); v0[3] += alpha * bf_hi(rw.y);
                    v1[0] += alpha * bf_lo(rw.z); v1[1] += alpha * bf_hi(rw.z); v1[2] += alpha * bf_lo(rw.w); v1[3] += alpha * bf_hi(rw.w);
                    if constexpr (F32OUT) { float* yp = (float*)Y + off + bj * HALF; *(f32x4*)yp = v0; *(f32x4*)(yp + 4) = v1; }
                    else { u32x4 w; w.x = cvt_pk_bf16(v0[0], v0[1]); w.y = cvt_pk_bf16(v0[2], v0[3]); w.z = cvt_pk_bf16(v1[0], v1[1]); w.w = cvt_pk_bf16(v1[2], v1[3]); *(u32x4*)((bf16_t*)Y + off + bj * HALF) = w; } }
                if (m == 3) asm volatile("" ::: "memory"); }
    }
};
struct EpiPle {
    static constexpr bool PERM = true;
    const bf16_t* x; const bf16_t* pp; const float* bias; float* outF; bf16_t* outB; int ldc;
    __device__ __forceinline__ void operator()(const f32x4 (&acc)[2][2][4][2], const Unit& u, int wr, int wc, int fr, int fq) const {
        const int row0 = u.pm * BM + wr * 64 + fr, col0 = u.pn * BM + wc * 32 + 8 * fq;
        f32x4 bv[2][2];
#pragma unroll
        for (int bj = 0; bj < 2; ++bj)
#pragma unroll
            for (int n = 0; n < 2; ++n) bv[bj][n] = *(const f32x4*)(bias + col0 + bj * HALF + 4 * n);
#pragma unroll
        for (int ai = 0; ai < 2; ++ai)
#pragma unroll
            for (int m = 0; m < 4; ++m) { const size_t off = (size_t)(row0 + ai * HALF + m * 16) * ldc + col0;
#pragma unroll
                for (int bj = 0; bj < 2; ++bj) { const size_t o2 = off + bj * HALF;
                    const u32x4 xw = *(const u32x4*)(x + o2), pw = *(const u32x4*)(pp + o2);
                    float o[8];
#pragma unroll
                    for (int e = 0; e < 4; ++e) { const int n = e >> 1, j = (e & 1) * 2;
                        const float v0 = acc[ai][bj][m][n][j] + bv[bj][n][j], v1 = acc[ai][bj][m][n][j + 1] + bv[bj][n][j + 1];
                        o[2 * e] = bf_lo(xw[e]) + bf_lo(pw[e]) * __builtin_amdgcn_rcpf(1.0f + __builtin_amdgcn_exp2f(-1.4426950408889634f * v0));
                        o[2 * e + 1] = bf_hi(xw[e]) + bf_hi(pw[e]) * __builtin_amdgcn_rcpf(1.0f + __builtin_amdgcn_exp2f(-1.4426950408889634f * v1)); }
                    if (outF) { float* yp = outF + o2; *(f32x4*)yp = (f32x4){o[0], o[1], o[2], o[3]}; *(f32x4*)(yp + 4) = (f32x4){o[4], o[5], o[6], o[7]}; }
                    else { u32x4 w; w.x = cvt_pk_bf16(o[0], o[1]); w.y = cvt_pk_bf16(o[2], o[3]); w.z = cvt_pk_bf16(o[4], o[5]); w.w = cvt_pk_bf16(o[6], o[7]); *(u32x4*)(outB + o2) = w; } }
                if (m & 1) asm volatile("" ::: "memory"); }
    }
};

constexpr int IDX_LDS_OFF = 131072 + 1024;
template <class Epi, class Sched, bool ALIGN_EPI = true, bool SP2 = true, bool STAMP = false, bool GATHER = false>
__device__ __forceinline__ void gemm_phase(PG8_LAS unsigned char* lds, const Gemm g, const Sched& S, const Epi& E, unsigned long long* stp = nullptr) {
    const int tid = threadIdx.x, wid = __builtin_amdgcn_readfirstlane(tid >> 6), lane = tid & 63, wr = wid >> 2, wc = wid & 3, fr = lane & 15, fq = lane >> 4;
    unsigned voffA[2], voffB[2]; int gR[2], gC[2];
#pragma unroll
    for (int i = 0; i < 2; ++i) { int R, C; stage_rc(tid * 16 + i * 8192, R, C); const int Rb = Epi::PERM ? ((R & ~31) + perm32(R & 31)) : R; gR[i] = R; gC[i] = C;
        voffA[i] = (unsigned)(R * g.lda + C) * 2u; voffB[i] = (unsigned)(Rb * g.ldb + C) * 2u; }
    const size_t kstep = (size_t)(BK * 2);
    const size_t hstepA = (size_t)HALF * g.lda * 2, hstepB = (size_t)HALF * g.ldb * 2;
    const PG8_LAS unsigned short* gidx = (const PG8_LAS unsigned short*)(lds + IDX_LDS_OFF);
    unsigned cvo[2][2], nvo[2][2];
#define PG8_GOFF(dst, ui_) do { _Pragma("unroll") for (int _h = 0; _h < 2; ++_h) _Pragma("unroll") for (int _i = 0; _i < 2; ++_i) \
        dst[_h][_i] = GATHER ? ((unsigned)gidx[(ui_) * 256 + _h * HALF + gR[_i]] * (unsigned)(g.lda * 2) + (unsigned)(gC[_i] * 2)) : (voffA[_i] + (unsigned)(_h * hstepA)); } while (0)
    PG8_GOFF(cvo, 0);
#pragma unroll
    for (int _h = 0; _h < 2; ++_h)
#pragma unroll
        for (int _i = 0; _i < 2; ++_i) nvo[_h][_i] = cvo[_h][_i];
    const unsigned ldsw = (unsigned)wid * 1024u;
    const int aoff = lds_byte(wr * 64 + fr, fq * 8), boff = lds_byte(wc * 32 + fr, fq * 8);
#define PG8_SA(b, h) (((b) * 2 + (h)) * HTB)
#define PG8_SB(b, h) ((4 + (b) * 2 + (h)) * HTB)
#define PG8_STAGE(bufoff, gbase, voff) do { _Pragma("unroll") for (int _i = 0; _i < 2; ++_i) \
        __builtin_amdgcn_global_load_lds((const unsigned*)((const char*)(gbase) + (voff)[_i]), (PG8_LAS unsigned*)(lds + (bufoff) + ldsw + _i * 8192), 16, 0, 0); } while (0)
#define PG8_LDA(dst, b, h) do { _Pragma("unroll") for (int m = 0; m < 4; ++m) _Pragma("unroll") for (int k = 0; k < 2; ++k) dst[m][k] = *(const PG8_LAS bf16x8*)(lds + PG8_SA(b, h) + aoff + m * 2048 + k * 1024); } while (0)
#define PG8_LDB(dst, b, h) do { _Pragma("unroll") for (int n = 0; n < 2; ++n) _Pragma("unroll") for (int k = 0; k < 2; ++k) dst[n][k] = *(const PG8_LAS bf16x8*)(lds + PG8_SB(b, h) + boff + n * 2048 + k * 1024); } while (0)
#define PG8_MMA(ai, bj, At, Bt) do { __builtin_amdgcn_s_setprio(1); _Pragma("unroll") for (int m = 0; m < 4; ++m) _Pragma("unroll") for (int n = 0; n < 2; ++n) _Pragma("unroll") for (int k = 0; k < 2; ++k) \
        acc[ai][bj][m][n] = __builtin_amdgcn_mfma_f32_16x16x32_bf16(Bt[n][k], At[m][k], acc[ai][bj][m][n], 0, 0, 0); __builtin_amdgcn_s_setprio(0); } while (0)
#define PG8_WAIT_V(n) asm volatile("s_waitcnt vmcnt(" #n ")" ::: "memory")
#define PG8_WAIT_L(n) asm volatile("s_waitcnt lgkmcnt(" #n ")" ::: "memory")
#define PG8_BAR __builtin_amdgcn_s_barrier()
#define PG8_SCHED __builtin_amdgcn_sched_barrier(0)
    Unit cur, nxt; int ui = 0;
    if (!S.next(0, cur)) return;
    long long st_c0 = 0, st_w0 = 0, st_k = 0, st_e = 0, st_t = 0; if (STAMP) { st_c0 = clock64(); st_w0 = wall_clock64(); }
    f32x4 acc[2][2][4][2];
#pragma unroll
    for (int a = 0; a < 2; ++a)
#pragma unroll
        for (int b = 0; b < 2; ++b)
#pragma unroll
            for (int m = 0; m < 4; ++m)
#pragma unroll
                for (int n = 0; n < 2; ++n) acc[a][b][m][n] = (f32x4){0.f, 0.f, 0.f, 0.f};
    bf16x8 At[4][2], B0[2][2], B1[2][2];
    const char* cA = S.a_ptr(g, cur); const char* cB = S.b_ptr(g, cur);
    if constexpr (SP2) {
        PG8_STAGE(PG8_SB(0, 0), cB, voffB); PG8_STAGE(PG8_SB(0, 1), cB + hstepB, voffB); PG8_STAGE(PG8_SA(0, 0), cA, cvo[0]); PG8_STAGE(PG8_SA(0, 1), cA, cvo[1]);
        if (wr == 1) PG8_BAR;
        PG8_WAIT_V(2); PG8_BAR;
        PG8_STAGE(PG8_SB(1, 0), cB + kstep, voffB); PG8_STAGE(PG8_SA(1, 0), cA + kstep, cvo[0]); PG8_STAGE(PG8_SB(1, 1), cB + hstepB + kstep, voffB);
        PG8_WAIT_V(6); PG8_BAR;
    } else {
        PG8_STAGE(PG8_SB(0, 0), cB, voffB); PG8_STAGE(PG8_SA(0, 0), cA, cvo[0]); PG8_STAGE(PG8_SB(0, 1), cB + hstepB, voffB); PG8_STAGE(PG8_SA(0, 1), cA, cvo[1]);
        if (wr == 1) PG8_BAR;
        PG8_WAIT_V(4); PG8_BAR;
        PG8_STAGE(PG8_SB(1, 0), cB + kstep, voffB); PG8_STAGE(PG8_SA(1, 0), cA + kstep, cvo[0]); PG8_STAGE(PG8_SB(1, 1), cB + hstepB + kstep, voffB);
        PG8_WAIT_V(6); PG8_BAR;
    }
    for (;;) {
        const bool has_next = S.next(ui + 1, nxt);
        const char* nA = has_next ? S.a_ptr(g, nxt) : cA; const char* nB = has_next ? S.b_ptr(g, nxt) : cB;
        const int nt = S.unit_nt(g, cur);
        if (GATHER && has_next) PG8_GOFF(nvo, ui + 1);
        if (STAMP) st_t = clock64();
        for (int t = 0; t < nt; t += 2) {
            const bool last = (t == nt - 2);
            const char* a1 = cA + (size_t)(t + 1) * kstep;
            const char* a2 = last ? nA : cA + (size_t)(t + 2) * kstep; const char* b2 = last ? nB : cB + (size_t)(t + 2) * kstep;
            const char* a3 = a2 + kstep; const char* b3 = b2 + kstep;
            unsigned xvo[2][2];
#pragma unroll
            for (int _h = 0; _h < 2; ++_h)
#pragma unroll
                for (int _i = 0; _i < 2; ++_i) xvo[_h][_i] = (GATHER && last) ? nvo[_h][_i] : cvo[_h][_i];
            if constexpr (SP2) {
            PG8_LDB(B0, 0, 0); PG8_LDB(B1, 0, 1); PG8_SCHED; PG8_LDA(At, 0, 0); PG8_STAGE(PG8_SA(1, 1), a1, cvo[1]);
            PG8_WAIT_V(8); PG8_WAIT_L(0); PG8_BAR; PG8_MMA(0, 0, At, B0); PG8_MMA(0, 1, At, B1); PG8_BAR; PG8_SCHED;
            PG8_LDA(At, 0, 1); PG8_STAGE(PG8_SB(0, 0), b2, voffB); PG8_STAGE(PG8_SB(0, 1), b2 + hstepB, voffB); PG8_STAGE(PG8_SA(0, 0), a2, xvo[0]);
            PG8_WAIT_V(8); PG8_WAIT_L(0); PG8_BAR; PG8_MMA(1, 0, At, B0); PG8_MMA(1, 1, At, B1); PG8_BAR; PG8_SCHED;
            PG8_LDB(B0, 1, 0); PG8_LDB(B1, 1, 1); PG8_SCHED; PG8_LDA(At, 1, 0); PG8_STAGE(PG8_SA(0, 1), a2, xvo[1]);
            PG8_WAIT_V(8); PG8_WAIT_L(0); PG8_BAR; PG8_MMA(0, 0, At, B0); PG8_MMA(0, 1, At, B1); PG8_BAR; PG8_SCHED;
            PG8_LDA(At, 1, 1); PG8_STAGE(PG8_SB(1, 0), b3, voffB); PG8_STAGE(PG8_SB(1, 1), b3 + hstepB, voffB); PG8_STAGE(PG8_SA(1, 0), a3, xvo[0]);
            PG8_WAIT_V(8); PG8_WAIT_L(0); PG8_BAR; PG8_MMA(1, 0, At, B0); PG8_MMA(1, 1, At, B1); PG8_BAR; PG8_SCHED;
            } else {
            PG8_LDB(B0, 0, 0); PG8_SCHED; PG8_LDA(At, 0, 0); PG8_STAGE(PG8_SA(1, 1), a1, cvo[1]);
            PG8_WAIT_L(8); PG8_BAR; PG8_WAIT_L(0); PG8_MMA(0, 0, At, B0); PG8_BAR; PG8_SCHED;
            PG8_LDB(B1, 0, 1); PG8_STAGE(PG8_SB(0, 0), b2, voffB);
            PG8_BAR; PG8_WAIT_L(0); PG8_MMA(0, 1, At, B1); PG8_BAR;
            PG8_LDA(At, 0, 1); PG8_STAGE(PG8_SA(0, 0), a2, xvo[0]);
            PG8_BAR; PG8_WAIT_L(0); PG8_MMA(1, 0, At, B0); PG8_BAR; PG8_SCHED;
            PG8_STAGE(PG8_SB(0, 1), b2 + hstepB, voffB);
            PG8_WAIT_V(6); PG8_BAR; PG8_MMA(1, 1, At, B1); PG8_BAR;
            PG8_LDB(B0, 1, 0); PG8_SCHED; PG8_LDA(At, 1, 0); PG8_STAGE(PG8_SA(0, 1), a2, xvo[1]);
            PG8_WAIT_L(8); PG8_BAR; PG8_WAIT_L(0); PG8_MMA(0, 0, At, B0); PG8_BAR; PG8_SCHED;
            PG8_LDB(B1, 1, 1); PG8_STAGE(PG8_SB(1, 0), b3, voffB);
            PG8_BAR; PG8_WAIT_L(0); PG8_MMA(0, 1, At, B1); PG8_BAR;
            PG8_LDA(At, 1, 1); PG8_STAGE(PG8_SA(1, 0), a3, xvo[0]);
            PG8_BAR; PG8_WAIT_L(0); PG8_MMA(1, 0, At, B0); PG8_BAR; PG8_SCHED;
            PG8_STAGE(PG8_SB(1, 1), b3 + hstepB, voffB);
            PG8_WAIT_V(6); PG8_BAR; PG8_MMA(1, 1, At, B1); PG8_BAR;
            }
        }
        if (STAMP) { const long long c = clock64(); st_k += c - st_t; st_t = c; }
        if constexpr (ALIGN_EPI) { if (wr == 0) PG8_BAR; }
        E(acc, cur, wr, wc, fr, fq);
        if (STAMP) { const long long c = clock64(); st_e += c - st_t; }
        if (!has_next) break;
#pragma unroll
        for (int a = 0; a < 2; ++a)
#pragma unroll
            for (int b = 0; b < 2; ++b)
#pragma unroll
                for (int m = 0; m < 4; ++m)
#pragma unroll
                    for (int n = 0; n < 2; ++n) acc[a][b][m][n] = (f32x4){0.f, 0.f, 0.f, 0.f};
        cur = nxt; cA = nA; cB = nB; ++ui;
        if (GATHER) {
#pragma unroll
            for (int _h = 0; _h < 2; ++_h)
#pragma unroll
                for (int _i = 0; _i < 2; ++_i) cvo[_h][_i] = nvo[_h][_i]; }
        if constexpr (ALIGN_EPI) { if (wr == 1) PG8_BAR; }
    }
    PG8_WAIT_V(0);
    if constexpr (!ALIGN_EPI) { if (wr == 0) PG8_BAR; }
    PG8_BAR;
    if (STAMP) { if (blockIdx.x == 0 && tid == 0) { const long long c1 = clock64(), w1 = wall_clock64(); stp[0] = (unsigned long long)((c1 - st_c0) * 100 / (w1 - st_w0)); stp[1] = (unsigned long long)(st_k / ((ui + 1) * (g.K / BK))); stp[2] = (unsigned long long)(st_e / (10 * (ui + 1))); } }
#undef PG8_GOFF
#undef PG8_SA
#undef PG8_SB
#undef PG8_STAGE
#undef PG8_LDA
#undef PG8_LDB
#undef PG8_MMA
#undef PG8_WAIT_V
#undef PG8_WAIT_L
#undef PG8_BAR
#undef PG8_SCHED
}
}

#define XB_TMO      128
#define XB_XCNT(j)  (256  + 64 * (j))
#define XB_XSUB(j)  (1280 + 64 * (j))
#define XB_XGEN(j)  (2304 + 64 * (j))
#define XB_TOP      3328
#define XB_TOPGEN   3392
#define XCD_BAR_WORDS 3456
#define XB_SPIN_CAP (1u << 18)

__device__ __forceinline__ unsigned xb_ld(unsigned* p)              { return __hip_atomic_load(p, __ATOMIC_RELAXED, __HIP_MEMORY_SCOPE_AGENT); }
__device__ __forceinline__ unsigned xb_add(unsigned* p, unsigned v) { return __hip_atomic_fetch_add(p, v, __ATOMIC_RELAXED, __HIP_MEMORY_SCOPE_AGENT); }
__device__ __forceinline__ unsigned xb_xcc_id() { return (unsigned)__builtin_amdgcn_s_getreg((3 << 11) | 20) & 0xFu; }
#define XB_SPIN(cond, bar) do { unsigned _sp = 0; while (cond) { __builtin_amdgcn_s_sleep(1); \
    if ((++_sp & 255u) == 0u) { if (xb_ld(&(bar)[XB_TMO])) break; if (_sp > XB_SPIN_CAP) { atomicAdd(&(bar)[XB_TMO], 1u); break; } } } } while (0)

struct XcdBarrier { unsigned* bar; unsigned x; volatile LAS unsigned* st; };

__device__ __forceinline__ XcdBarrier xcd_barrier_post(unsigned* bar, volatile LAS unsigned* st) {
    XcdBarrier b; b.bar = bar; b.x = xb_xcc_id(); b.st = st;
    if (threadIdx.x == 0) (void)xb_add(&bar[XB_XCNT(b.x)], 1u);
    return b;
}
__device__ __forceinline__ void xcd_barrier_complete(unsigned* bar, unsigned x, unsigned& nloc, unsigned& nx) {
    const unsigned G = gridDim.x * gridDim.y * gridDim.z;
    unsigned sum, cnt, mine, sp = 0u;
    for (;;) {
        sum = 0u; cnt = 0u; mine = 0u;
#pragma unroll
        for (unsigned j = 0; j < 16; ++j) { const unsigned c = xb_ld(&bar[XB_XCNT(j)]); sum += c; cnt += (c > 0u) ? 1u : 0u; mine = (j == x) ? c : mine; }
        if (sum == G) break;
        __builtin_amdgcn_s_sleep(1);
        if ((++sp & 255u) == 0u) { if (xb_ld(&bar[XB_TMO])) break; if (sp > XB_SPIN_CAP) { atomicAdd(&bar[XB_TMO], 1u); break; } }
    }
    nloc = mine > 0u ? mine : 1u; nx = cnt > 0u ? cnt : 1u;
}
__device__ __forceinline__ void xcd_barrier(const XcdBarrier& b) {
    asm volatile("s_waitcnt vmcnt(0)" ::: "memory");
    __syncthreads();
    if (threadIdx.x == 0) {
        unsigned* bar = b.bar;
        __builtin_amdgcn_s_waitcnt(0);
        unsigned nloc = b.st[0], nx = b.st[1];
        if (nloc == 0u) { xcd_barrier_complete(bar, b.x, nloc, nx); b.st[0] = nloc; b.st[1] = nx; }
        const unsigned old = xb_add(&bar[XB_XSUB(b.x)], 1u);
        const unsigned gen = old / nloc;
        if (old + 1u == (gen + 1u) * nloc) {
            __builtin_amdgcn_fence(__ATOMIC_RELEASE, "agent");
            asm volatile("s_waitcnt vmcnt(0)" ::: "memory");
            const unsigned og = xb_add(&bar[XB_TOP], 1u);
            const unsigned tg = og / nx;
            if (og + 1u == (tg + 1u) * nx) xb_add(&bar[XB_TOPGEN], 1u);
            else XB_SPIN(xb_ld(&bar[XB_TOPGEN]) == tg, bar);
            __builtin_amdgcn_fence(__ATOMIC_ACQUIRE, "agent");
            xb_add(&bar[XB_XGEN(b.x)], 1u);
            asm volatile("s_waitcnt vmcnt(0)" ::: "memory");
        } else {
            XB_SPIN(xb_ld(&bar[XB_XGEN(b.x)]) == gen, bar);
            __builtin_amdgcn_fence(__ATOMIC_ACQUIRE, "agent");
            asm volatile("s_waitcnt vmcnt(0)" ::: "memory");
        }
    }
    __syncthreads();
}

struct Frame {
    LAS unsigned char* lds;
    int tid, lane, wave, vcu, G;
    unsigned char* ws;
};
struct Args { const float* in[22]; float* out; unsigned char* ws; int ph_lo, ph_hi; };

__device__ __forceinline__ void cvt_tile(const float* W, size_t ldw, int k0, int n0, bf16* WT, size_t ldt, int dst_row0, int lane) {
    const int kb = lane >> 3, nb = lane & 7;
    const float* src = W + (size_t)(k0 + 8 * kb) * ldw + n0 + 4 * nb;
    f32x4 v[8];
#pragma unroll
    for (int j = 0; j < 8; ++j) v[j] = *(const f32x4*)(src + (size_t)j * ldw);
#pragma unroll
    for (int jn = 0; jn < 4; ++jn) { u32x4 o; o.x = cvt_pk_bf16(v[0][jn], v[1][jn]); o.y = cvt_pk_bf16(v[2][jn], v[3][jn]); o.z = cvt_pk_bf16(v[4][jn], v[5][jn]); o.w = cvt_pk_bf16(v[6][jn], v[7][jn]);
        *(u32x4*)(WT + (size_t)(dst_row0 + 4 * nb + jn) * ldt + k0 + 8 * kb) = o; }
}
struct MapId { __device__ __forceinline__ int operator()(int n) const { return n; } };
struct MapQKV { __device__ __forceinline__ int operator()(int n) const { const int gt = n >> 11, head = (n >> 7) & 15, d = n & 127; return (gt * 8 + (head >> 1)) * 256 + 128 * (d >> 6) + 64 * (head & 1) + (d & 63); } };
struct MapGU { int which; __device__ __forceinline__ int operator()(int n) const { return 256 * (n >> 7) + 128 * which + (n & 127); } };
template <class Map> __device__ __forceinline__ void cvt_matrix(const float* W, int K, int N, bf16* WT, size_t ldt, Map map, int& it0, int gw, int NGW, int lane) {
    const int nblk = N / 32, items = (K / 64) * nblk;
    int it = gw - it0; if (it < 0) it += ((-it + NGW - 1) / NGW) * NGW;
    for (; it < items; it += 2 * NGW) { const int it2 = it + NGW; const bool two = it2 < items;
        const int kb = it / nblk, nb = it - kb * nblk, kb2 = two ? it2 / nblk : kb, nb2 = two ? it2 - kb2 * nblk : nb;
        const int q8 = lane >> 3, n8 = lane & 7;
        const float* sa = W + (size_t)(64 * kb + 8 * q8) * N + 32 * nb + 4 * n8; const float* sb = W + (size_t)(64 * kb2 + 8 * q8) * N + 32 * nb2 + 4 * n8;
        f32x4 va[8], vb[8];
#pragma unroll
        for (int j = 0; j < 8; ++j) va[j] = *(const f32x4*)(sa + (size_t)j * N);
#pragma unroll
        for (int j = 0; j < 8; ++j) vb[j] = *(const f32x4*)(sb + (size_t)j * N);
        const int da = map(32 * nb), db = map(32 * nb2);
#pragma unroll
        for (int jn = 0; jn < 4; ++jn) { u32x4 o; o.x = cvt_pk_bf16(va[0][jn], va[1][jn]); o.y = cvt_pk_bf16(va[2][jn], va[3][jn]); o.z = cvt_pk_bf16(va[4][jn], va[5][jn]); o.w = cvt_pk_bf16(va[6][jn], va[7][jn]);
            *(u32x4*)(WT + (size_t)(da + 4 * n8 + jn) * ldt + 64 * kb + 8 * q8) = o; }
        if (two) {
#pragma unroll
            for (int jn = 0; jn < 4; ++jn) { u32x4 o; o.x = cvt_pk_bf16(vb[0][jn], vb[1][jn]); o.y = cvt_pk_bf16(vb[2][jn], vb[3][jn]); o.z = cvt_pk_bf16(vb[4][jn], vb[5][jn]); o.w = cvt_pk_bf16(vb[6][jn], vb[7][jn]);
                *(u32x4*)(WT + (size_t)(db + 4 * n8 + jn) * ldt + 64 * kb2 + 8 * q8) = o; } }
    }
    it0 = (it0 + items) % NGW;
}
__device__ __forceinline__ void cvt_flat(const float* s, bf16* d, size_t n, int gw, int NGW, int lane) {
    for (size_t i = ((size_t)gw * 64 + lane) * 8; i < n; i += (size_t)NGW * 64 * 8) { const f32x4 a = *(const f32x4*)(s + i), b = *(const f32x4*)(s + i + 4);
        u32x4 o; o.x = cvt_pk_bf16(a[0], a[1]); o.y = cvt_pk_bf16(a[2], a[3]); o.z = cvt_pk_bf16(b[0], b[1]); o.w = cvt_pk_bf16(b[2], b[3]); *(u32x4*)(d + i) = o; }
}

__device__ __forceinline__ void p0_prologue(Frame& F, const Args& a) {
    const int gw = F.vcu * 8 + F.wave, NGW = F.G * 8, lane = F.lane; unsigned char* ws = F.ws; int it0 = 0;
    cvt_matrix(a.in[2], D, NQKV, (bf16*)(ws + WS_WQKV), D, MapQKV{}, it0, gw, NGW, lane);
    cvt_matrix(a.in[3], D, D, (bf16*)(ws + WS_WO), D, MapId{}, it0, gw, NGW, lane);
    cvt_matrix(a.in[12], D, FF, (bf16*)(ws + WS_W13), D, MapGU{0}, it0, gw, NGW, lane);
    cvt_matrix(a.in[13], D, FF, (bf16*)(ws + WS_W13), D, MapGU{1}, it0, gw, NGW, lane);
    cvt_matrix(a.in[14], FF, D, (bf16*)(ws + WS_W2), FF, MapId{}, it0, gw, NGW, lane);
    cvt_matrix(a.in[20], D, D, (bf16*)(ws + WS_WGATE), D, MapId{}, it0, gw, NGW, lane);
    cvt_matrix(a.in[20] + (size_t)D * D, D, D, (bf16*)(ws + WS_WGATE) + (size_t)D * D, D, MapId{}, it0, gw, NGW, lane);
    cvt_matrix(a.in[19], PLE, D, (bf16*)(ws + WS_WPROJ), PLE, MapId{}, it0, gw, NGW, lane);
    cvt_matrix(a.in[19] + (size_t)PLE * D, PLE, D, (bf16*)(ws + WS_WPROJ) + (size_t)D * PLE, PLE, MapId{}, it0, gw, NGW, lane);
    cvt_matrix(a.in[4], D, D, (bf16*)(ws + WS_WIN), D, MapId{}, it0, gw, NGW, lane);
    cvt_matrix(a.in[7], D, D, (bf16*)(ws + WS_WO2), D, MapId{}, it0, gw, NGW, lane);
    { const float* wg = a.in[5]; const float* sc = a.in[6]; bf16* o = (bf16*)(ws + WS_WGS);
      for (size_t i = ((size_t)gw * 64 + lane) * 8; i < (size_t)4 * 512 * 512; i += (size_t)NGW * 64 * 8) { const int g = (int)(i >> 18), d = (int)(i & 511);
          const f32x4 x0 = *(const f32x4*)(wg + i), x1 = *(const f32x4*)(wg + i + 4), s0 = *(const f32x4*)(sc + g * 512 + d), s1 = *(const f32x4*)(sc + g * 512 + d + 4);
          const f32x4 y0 = x0 * s0, y1 = x1 * s1; u32x4 w; w.x = cvt_pk_bf16(y0[0], y0[1]); w.y = cvt_pk_bf16(y0[2], y0[3]); w.z = cvt_pk_bf16(y1[0], y1[1]); w.w = cvt_pk_bf16(y1[2], y1[3]); *(u32x4*)(o + i) = w; } }
    cvt_flat(a.in[0], (bf16*)(ws + WS_XB0), (size_t)MTOK * D, gw, NGW, lane);
    cvt_flat(a.in[1], (bf16*)(ws + WS_PB), (size_t)2 * MTOK * PLE, gw, NGW, lane);
    { float* ct = (float*)(ws + WS_ROPE); float* st = ct + SEQ * 64;
      for (int i = gw * 64 + lane; i < SEQ * 64; i += NGW * 64) { const int pos = i >> 6, j = i & 63;
          const double inv = exp2(-(double)j * (13.287712379549449 / 64.0));
          const double ang = (double)pos * inv; ct[i] = (float)cos(ang); st[i] = (float)sin(ang); } }
}

__device__ __forceinline__ void attn_load_block(const bf16* hp, int blk, LAS unsigned char* slot, bool isV, int w, int lane) {
#pragma unroll
    for (int i = 0; i < 4; ++i) {
        const int idx = i * 8 + w, row = idx * 4 + (lane >> 4), cs = lane & 15;
        const int c = cs ^ (isV ? (((row & 3) << 2) | ((row >> 2) & 3)) : (row & 7));
        const bf16* rp = hp + (size_t)(128 * blk + row) * 128 + c * 8;
        __builtin_amdgcn_global_load_lds((const unsigned*)rp, (LAS unsigned*)(slot + idx * 1024), 16, 0, 0);
    }
}
__device__ __forceinline__ void attn_phase(Frame& F) {
    const bf16* QKV = (const bf16*)(F.ws + WS_QKV); bf16* OG = (bf16*)(F.ws + WS_OG); float* LSE = (float*)(F.ws + WS_LSE);
    LAS unsigned char* Kl = F.lds; LAS unsigned char* Vl = F.lds + 98304;
    volatile LAS unsigned* MISCw = (volatile LAS unsigned*)(F.lds + MISC_OFF);
    const unsigned keep0 = MISCw[8], keep1 = MISCw[9];
    const int w = F.wave, lane = F.lane, q16 = lane & 15, g4 = lane >> 4, sw = ((g4 & 1) << 1) | (g4 >> 1);
    const int pi16 = (q16 & 3) | ((q16 & 4) << 1) | ((q16 & 8) >> 1);
    const int qq = q16 >> 2, pp = q16 & 3;
    bf16x8 bqn[4];
#pragma unroll
    for (int ks = 0; ks < 4; ++ks) bqn[ks] = (bf16x8){0, 0, 0, 0, 0, 0, 0, 0};
    __syncthreads();
    for (int i = F.tid; i < LDS_BYTES / 16; i += 512) *(LAS u32x4*)(F.lds + i * 16) = (u32x4){0u, 0u, 0u, 0u};
    for (int p = F.vcu; p < 768; p += F.G) {
        const int b = 3 - p / 192, pr = p % 192, g = pr >> 6, h = (pr & 63) >> 2, qs = pr & 3;
        const int dsh = 2 * g, dil = 1 << dsh, nb = 32 >> dsh;
        const bf16* planeQ = QKV + ((size_t)((g * 3 + 0) * 16 + h) * MTOK) * 128; const bf16* planeK = planeQ + (size_t)16 * MTOK * 128; const bf16* planeV = planeK + (size_t)16 * MTOK * 128;
        for (int u = 0; u < 8; ++u) {
            int r, n;
            if (g == 0) { r = 0; n = qs * 8 + u; } else if (g == 1) { r = qs; n = u; } else { r = qs * 4 + (u >> 1); n = u & 1; }
            const bool first = (u == 0) || (n == 0), cont = (u < 7) && (n + 1 < nb);
            const size_t tok0 = (size_t)b * SEQ + r; const size_t crow = (size_t)b * SEQ + (size_t)r * (SEQ >> dsh);
            const bf16* hQ = planeQ + crow * 128; const bf16* hK = planeK + crow * 128; const bf16* hV = planeV + crow * 128;
            const int par = n & 1, k3 = n % 3, kp3 = (n + 2) % 3, kn3 = (n + 1) % 3;
            const size_t qtok = tok0 + (size_t)(128 * n + 16 * w + q16) * dil;
            bf16x8 bq[4];
            if (first) {
                __syncthreads();
                attn_load_block(hK, n, Kl + k3 * 32768, false, w, lane);
                attn_load_block(hV, n, Vl + par * 32768, true, w, lane);
                if (n > 0) { attn_load_block(hK, n - 1, Kl + kp3 * 32768, false, w, lane);
                             attn_load_block(hV, n - 1, Vl + (par ^ 1) * 32768, true, w, lane); }
#pragma unroll
                for (int ks = 0; ks < 4; ++ks) bq[ks] = *(const bf16x8*)(hQ + (size_t)(128 * n + 16 * w + q16) * 128 + 32 * ks + 8 * g4);
            } else {
#pragma unroll
                for (int ks = 0; ks < 4; ++ks) bq[ks] = bqn[ks];
            }
            if (first) asm volatile("s_waitcnt vmcnt(0)" ::: "memory"); else asm volatile("s_waitcnt vmcnt(4)" ::: "memory");
            __syncthreads();
            if (!first) attn_load_block(hV, n, Vl + par * 32768, true, w, lane);
            if (cont) attn_load_block(hK, n + 1, Kl + kn3 * 32768, false, w, lane);
            f32x4 s[9];
            {
                bf16x8 ka[2][4];
#define ATT_LDK(buf, ti_) do { const int _kt = w + (ti_); const int _row = ((_kt >> 3) ? k3 : kp3) * 128 + (_kt & 7) * 16 + pi16; \
                    _Pragma("unroll") for (int _ks = 0; _ks < 4; ++_ks) ka[buf][_ks] = *(const LAS bf16x8*)(Kl + _row * 256 + (((4 * _ks + g4) ^ (_row & 7)) << 4)); } while (0)
                ATT_LDK(0, 0);
#pragma unroll
                for (int ti = 0; ti < 9; ++ti) {
                    if (ti < 8) ATT_LDK((ti + 1) & 1, ti + 1);
                    __builtin_amdgcn_sched_barrier(0);
                    f32x4 acc = (f32x4){0.f, 0.f, 0.f, 0.f};
#pragma unroll
                    for (int ks = 0; ks < 4; ++ks) acc = __builtin_amdgcn_mfma_f32_16x16x32_bf16(ka[ti & 1][ks], bq[ks], acc, 0, 0, 0);
                    s[ti] = acc;
                }
#undef ATT_LDK
            }
            const float C2 = 0.08838834764831845f * 1.4426950408889634f; const float NEG = -__builtin_inff();
            float mx = NEG;
#pragma unroll
            for (int ti = 0; ti < 9; ++ti) {
                const bool tile_ok = (n > 0 || w + ti >= 8);
#pragma unroll
                for (int i = 0; i < 4; ++i) { const int kk = 4 * sw + i; bool ok = tile_ok;
                    if (ti == 0) ok = ok && (kk >= q16);
                    if (ti == 8) ok = ok && (kk <= q16);
                    const float v = ok ? s[ti][i] * C2 : NEG; s[ti][i] = v; mx = fmaxf(mx, v); }
            }
            mx = fmaxf(mx, __shfl_xor(mx, 16)); mx = fmaxf(mx, __shfl_xor(mx, 32));
            float l = 0.f;
#pragma unroll
            for (int ti = 0; ti < 9; ++ti)
#pragma unroll
                for (int i = 0; i < 4; ++i) { const float pv = __builtin_amdgcn_exp2f(s[ti][i] - mx); s[ti][i] = pv; l += pv; }
            l += __shfl_xor(l, 16); l += __shfl_xor(l, 32);
            bf16x8 pf[5];
#pragma unroll
            for (int uu = 0; uu < 5; ++uu) { u32x4 wv; wv.x = cvt_pk_bf16(s[2 * uu][0], s[2 * uu][1]); wv.y = cvt_pk_bf16(s[2 * uu][2], s[2 * uu][3]);
                if (uu < 4) { wv.z = cvt_pk_bf16(s[2 * uu + 1][0], s[2 * uu + 1][1]); wv.w = cvt_pk_bf16(s[2 * uu + 1][2], s[2 * uu + 1][3]); } else { wv.z = 0u; wv.w = 0u; }
                pf[uu] = __builtin_bit_cast(bf16x8, wv); }
            if (cont) asm volatile("s_waitcnt vmcnt(4)" ::: "memory"); else asm volatile("s_waitcnt vmcnt(0)" ::: "memory");
            __syncthreads();
            if (cont) {
#pragma unroll
                for (int ks = 0; ks < 4; ++ks) bqn[ks] = *(const bf16x8*)(hQ + (size_t)(128 * (n + 1) + 16 * w + q16) * 128 + 32 * ks + 8 * g4);
            }
            const float rl = 1.0f / l;
            const size_t orow = (size_t)g * MTOK * D + qtok * D + h * 128;
            {
                s16x4 va[2][9];
#define ATT_TRV(r_, ch_) __builtin_bit_cast(s16x4, __builtin_amdgcn_ds_read_tr16_b64_v4i16((LAS s16x4*)(Vl + 256 * (r_) + 16 * ((ch_) ^ ((((r_) & 3) << 2) | (((r_) >> 2) & 3))) + 8 * (pp & 1))))
#define ATT_LDV(buf, dt_) do { const int _ch = 2 * (dt_) + (pp >> 1); \
                    _Pragma("unroll") for (int _u = 0; _u < 5; ++_u) { const int _kt0 = w + 2 * _u; const int _r0 = (par ^ 1 ^ (_kt0 >> 3)) * 128 + (_kt0 & 7) * 16 + 4 * sw + qq; va[buf][_u] = ATT_TRV(_r0, _ch); \
                        if (_u < 4) { const int _kt1 = _kt0 + 1; const int _r1 = (par ^ 1 ^ (_kt1 >> 3)) * 128 + (_kt1 & 7) * 16 + 4 * sw + qq; va[buf][5 + _u] = ATT_TRV(_r1, _ch); } } } while (0)
                ATT_LDV(0, 0);
#pragma unroll
                for (int dt = 0; dt < 8; ++dt) {
                    if (dt < 7) ATT_LDV((dt + 1) & 1, dt + 1);
                    __builtin_amdgcn_sched_barrier(0);
                    f32x4 o = (f32x4){0.f, 0.f, 0.f, 0.f};
#pragma unroll
                    for (int uu = 0; uu < 5; ++uu) { const s16x4 lo = va[dt & 1][uu]; const s16x4 hi = (uu < 4) ? va[dt & 1][5 + uu] : (s16x4){0, 0, 0, 0};
                        bf16x8 av; av[0] = lo[0]; av[1] = lo[1]; av[2] = lo[2]; av[3] = lo[3]; av[4] = hi[0]; av[5] = hi[1]; av[6] = hi[2]; av[7] = hi[3];
                        o = __builtin_amdgcn_mfma_f32_16x16x32_bf16(av, pf[uu], o, 0, 0, 0); }
                    o = o * rl;
                    u32x2 wv; wv.x = cvt_pk_bf16(o[0], o[1]); wv.y = cvt_pk_bf16(o[2], o[3]);
                    *(u32x2*)(OG + orow + 16 * dt + 4 * g4) = wv;
                }
#undef ATT_LDV
#undef ATT_TRV
            }
            if (g4 == 0) LSE[((size_t)g * MTOK + qtok) * NH + h] = mx * 0.6931471805599453f + __logf(l);
        }
    }
    __syncthreads();
    if (F.tid == 0) { MISCw[8] = keep0; MISCw[9] = keep1; }
    __syncthreads();
}

__device__ __forceinline__ void combine_phase(Frame& F) {
    const bf16* OG = (const bf16*)(F.ws + WS_OG); const float* LSE = (const float*)(F.ws + WS_LSE); bf16* ATT = (bf16*)(F.ws + WS_ATT);
    const int gw = F.vcu * 8 + F.wave, NGW = F.G * 8, lane = F.lane;
    for (int m = gw; m < MTOK; m += NGW) {
#pragma unroll
        for (int j = 0; j < 4; ++j) { const int c = lane + 64 * j, h = c >> 4;
            const float l0 = LSE[(size_t)m * NH + h], l1 = LSE[((size_t)MTOK + m) * NH + h], l2 = LSE[((size_t)2 * MTOK + m) * NH + h];
            const float mx = fmaxf(l0, fmaxf(l1, l2)); float w0 = __expf(l0 - mx), w1 = __expf(l1 - mx), w2 = __expf(l2 - mx); const float rs = 1.0f / (w0 + w1 + w2); w0 *= rs; w1 *= rs; w2 *= rs;
            const u32x4 a = *(const u32x4*)(OG + (size_t)m * D + c * 8), b = *(const u32x4*)(OG + ((size_t)MTOK + m) * D + c * 8), d = *(const u32x4*)(OG + ((size_t)2 * MTOK + m) * D + c * 8);
            u32x4 o;
#pragma unroll
            for (int e = 0; e < 4; ++e) { const float lo = w0 * bf_lo(a[e]) + w1 * bf_lo(b[e]) + w2 * bf_lo(d[e]), hi = w0 * bf_hi(a[e]) + w1 * bf_hi(b[e]) + w2 * bf_hi(d[e]); o[e] = cvt_pk_bf16(lo, hi); }
            *(u32x4*)(ATT + (size_t)m * D + c * 8) = o; }
    }
}
__device__ __forceinline__ void moe_convert_phase(Frame& F, const Args& a) {
    const int gw = F.vcu * 8 + F.wave, NGW = F.G * 8, lane = F.lane; int it0 = 0;
    bf16* W13 = (bf16*)(F.ws + WS_MW13); bf16* W2 = (bf16*)(F.ws + WS_MW2);
    for (int e = 0; e < NE; ++e) {
        cvt_matrix(a.in[16] + (size_t)e * D * FF, D, FF, W13 + (size_t)e * FF2 * D, D, MapGU{0}, it0, gw, NGW, lane);
        cvt_matrix(a.in[17] + (size_t)e * D * FF, D, FF, W13 + (size_t)e * FF2 * D, D, MapGU{1}, it0, gw, NGW, lane);
        cvt_matrix(a.in[18] + (size_t)e * FF * D, FF, D, W2 + (size_t)e * D * FF, FF, MapId{}, it0, gw, NGW, lane);
    }
}

__device__ __forceinline__ void ln_core(f32x4 (&v)[8], const f32x4 (&gg)[8], const f32x4 (&bb)[8]) {
    float s = 0.f;
#pragma unroll
    for (int j = 0; j < 8; ++j) s += (v[j][0] + v[j][1]) + (v[j][2] + v[j][3]);
    const float mean = wave_sum(s) * (1.f / D); float s2 = 0.f;
#pragma unroll
    for (int j = 0; j < 8; ++j) { v[j] = v[j] - mean; s2 += (v[j][0] * v[j][0] + v[j][1] * v[j][1]) + (v[j][2] * v[j][2] + v[j][3] * v[j][3]); }
    const float rstd = 1.0f / sqrtf(wave_sum(s2) * (1.f / D) + LN_EPS);
#pragma unroll
    for (int j = 0; j < 8; ++j) v[j] = v[j] * rstd * gg[j] + bb[j];
}
__device__ __forceinline__ void ln_store(const f32x4 (&v)[8], bf16* xb, int lane) {
#pragma unroll
    for (int j = 0; j < 8; ++j) { u32x2 w; w.x = cvt_pk_bf16(v[j][0], v[j][1]); w.y = cvt_pk_bf16(v[j][2], v[j][3]); *(u32x2*)(xb + 4 * lane + 256 * j) = w; }
}
__device__ __forceinline__ void ln_load_gb8(const float* gam, const float* bet, f32x4 (&gg)[8], f32x4 (&bb)[8], int lane) {
#pragma unroll
    for (int j = 0; j < 4; ++j) { const int c = (lane + 64 * j) * 8; gg[2 * j] = *(const f32x4*)(gam + c); gg[2 * j + 1] = *(const f32x4*)(gam + c + 4); bb[2 * j] = *(const f32x4*)(bet + c); bb[2 * j + 1] = *(const f32x4*)(bet + c + 4); }
}
__device__ __forceinline__ void ln_store8(const f32x4 (&v)[8], bf16* xb, int lane) {
#pragma unroll
    for (int j = 0; j < 4; ++j) { u32x4 w; w.x = cvt_pk_bf16(v[2 * j][0], v[2 * j][1]); w.y = cvt_pk_bf16(v[2 * j][2], v[2 * j][3]); w.z = cvt_pk_bf16(v[2 * j + 1][0], v[2 * j + 1][1]); w.w = cvt_pk_bf16(v[2 * j + 1][2], v[2 * j + 1][3]);
        *(u32x4*)(xb + (lane + 64 * j) * 8) = w; }
}
__device__ __forceinline__ void ln_unpack8(const u32x4 (&w)[4], f32x4 (&v)[8]) {
#pragma unroll
    for (int j = 0; j < 4; ++j) { v[2 * j] = (f32x4){bf_lo(w[j].x), bf_hi(w[j].x), bf_lo(w[j].y), bf_hi(w[j].y)}; v[2 * j + 1] = (f32x4){bf_lo(w[j].z), bf_hi(w[j].z), bf_lo(w[j].w), bf_hi(w[j].w)}; }
}
__device__ __forceinline__ void ln_phase(Frame& F, const bf16* YB, const bf16* RES, const float* gam, const float* bet, bf16* XB) {
    const int gw = F.vcu * 8 + F.wave, NGW = F.G * 8, lane = F.lane;
    f32x4 gg[8], bb[8]; ln_load_gb8(gam, bet, gg, bb, lane);
    for (int m = gw; m < MTOK; m += 2 * NGW) {
        const int m2 = m + NGW; const bool has2 = m2 < MTOK; const int mb = has2 ? m2 : m;
        u32x4 wa[4], wb[4], ra[4], rb[4];
#pragma unroll
        for (int j = 0; j < 4; ++j) { wa[j] = *(const u32x4*)(YB + (size_t)m * D + (lane + 64 * j) * 8); ra[j] = *(const u32x4*)(RES + (size_t)m * D + (lane + 64 * j) * 8); }
#pragma unroll
        for (int j = 0; j < 4; ++j) { wb[j] = *(const u32x4*)(YB + (size_t)mb * D + (lane + 64 * j) * 8); rb[j] = *(const u32x4*)(RES + (size_t)mb * D + (lane + 64 * j) * 8); }
        f32x4 v[8], r[8];
        ln_unpack8(wa, v); ln_unpack8(ra, r);
#pragma unroll
        for (int j = 0; j < 8; ++j) v[j] = r[j] * DN_ALPHA + v[j];
        ln_core(v, gg, bb); ln_store8(v, XB + (size_t)m * D, lane);
        if (has2) { ln_unpack8(wb, v); ln_unpack8(rb, r);
#pragma unroll
            for (int j = 0; j < 8; ++j) v[j] = r[j] * DN_ALPHA + v[j];
            ln_core(v, gg, bb); ln_store8(v, XB + (size_t)m2 * D, lane); }
    }
}
template <int J> __device__ __forceinline__ void pool_chunk8(const bf16* U, bf16* MIX, int m0, int t0, int lane) {
    constexpr int W = 2 << J, NR = W + 7;
    const int c = lane + 64 * J;
    u32x4 x[NR];
#pragma unroll
    for (int i = 0; i < NR; ++i) { const int dt = i - (W - 1); x[i] = *(const u32x4*)(U + (size_t)(m0 + ((t0 + dt >= 0) ? dt : 0)) * D + c * 8); }
    float sum[8];
#pragma unroll
    for (int e = 0; e < 8; ++e) sum[e] = 0.f;
#pragma unroll
    for (int i = 0; i < W - 1; ++i) { const float k = (t0 + i - (W - 1) >= 0) ? 1.f : 0.f;
#pragma unroll
        for (int e = 0; e < 4; ++e) { sum[2 * e] += k * bf_lo(x[i][e]); sum[2 * e + 1] += k * bf_hi(x[i][e]); } }
#pragma unroll
    for (int rr = 0; rr < 8; ++rr) {
        const int t = t0 + rr; const u32x4 cur = x[W - 1 + rr];
#pragma unroll
        for (int e = 0; e < 4; ++e) { sum[2 * e] += bf_lo(cur[e]); sum[2 * e + 1] += bf_hi(cur[e]); }
        const int cnt = (t + 1 < W) ? t + 1 : W; const float rc = 1.0f / (float)cnt; u32x4 o;
#pragma unroll
        for (int e = 0; e < 4; ++e) o[e] = cvt_pk_bf16(sum[2 * e] * rc - bf_lo(cur[e]), sum[2 * e + 1] * rc - bf_hi(cur[e]));
        *(u32x4*)(MIX + (size_t)(m0 + rr) * D + c * 8) = o;
        const float k = (t - (W - 1) >= 0) ? 1.f : 0.f;
#pragma unroll
        for (int e = 0; e < 4; ++e) { sum[2 * e] -= k * bf_lo(x[rr][e]); sum[2 * e + 1] -= k * bf_hi(x[rr][e]); }
    }
}
__device__ __forceinline__ void pool_phase(Frame& F) {
    const bf16* U = (const bf16*)(F.ws + WS_U); bf16* MIX = (bf16*)(F.ws + WS_MIX);
    const int gw = F.vcu * 8 + F.wave, NGW = F.G * 8, lane = F.lane;
    for (int m0 = gw * 8; m0 < MTOK; m0 += NGW * 8) { const int t0 = m0 & (SEQ - 1);
        pool_chunk8<0>(U, MIX, m0, t0, lane); pool_chunk8<1>(U, MIX, m0, t0, lane); pool_chunk8<2>(U, MIX, m0, t0, lane); pool_chunk8<3>(U, MIX, m0, t0, lane); }
}
__device__ __forceinline__ void ln_router_phase(Frame& F, const float* Y, const bf16* RES, const float* gam, const float* bet, const float* wrt, bf16* XB) {
    const int gw = F.vcu * 8 + F.wave, NGW = F.G * 8, lane = F.lane, tid = F.tid;
    LAS float* WR = (LAS float*)F.lds;
    LAS int* cntl = (LAS int*)(F.lds + 65536);
    LAS int* info = (LAS int*)(F.lds + 65536 + 64);
    int* LIST = (int*)(F.ws + WS_LIST); int* TOK = (int*)(F.ws + WS_TOK); unsigned* gcnt = (unsigned*)(F.ws + WS_CTL) + CW_CNT;
    __syncthreads();
    for (int i = tid; i < D * NE; i += 512) { const int c = i >> 3, e = i & 7; WR[e * D + c] = wrt[i]; }
    if (tid < 16) cntl[tid] = 0;
    __syncthreads();
    f32x4 gg[8], bb[8];
#pragma unroll
    for (int j = 0; j < 8; ++j) { gg[j] = *(const f32x4*)(gam + 4 * lane + 256 * j); bb[j] = *(const f32x4*)(bet + 4 * lane + 256 * j); }
    int k = 0;
    f32x4 vn[8]; u32x2 rn[8];
#pragma unroll
    for (int j = 0; j < 8; ++j) { vn[j] = *(const f32x4*)(Y + (size_t)(gw < MTOK ? gw : 0) * D + 4 * lane + 256 * j); rn[j] = *(const u32x2*)(RES + (size_t)(gw < MTOK ? gw : 0) * D + 4 * lane + 256 * j); }
    for (int m = gw; m < MTOK; m += NGW, ++k) {
        f32x4 v[8];
#pragma unroll
        for (int j = 0; j < 8; ++j) { v[j][0] = DN_ALPHA * bf_lo(rn[j].x) + vn[j][0]; v[j][1] = DN_ALPHA * bf_hi(rn[j].x) + vn[j][1]; v[j][2] = DN_ALPHA * bf_lo(rn[j].y) + vn[j][2]; v[j][3] = DN_ALPHA * bf_hi(rn[j].y) + vn[j][3]; }
        { const int mn = (m + NGW < MTOK) ? m + NGW : m;
#pragma unroll
          for (int j = 0; j < 8; ++j) { vn[j] = *(const f32x4*)(Y + (size_t)mn * D + 4 * lane + 256 * j); rn[j] = *(const u32x2*)(RES + (size_t)mn * D + 4 * lane + 256 * j); } }
        ln_core(v, gg, bb); ln_store(v, XB + (size_t)m * D, lane);
        float lg[8];
#pragma unroll
        for (int e = 0; e < 8; ++e) { float s = 0.f;
#pragma unroll
            for (int j = 0; j < 8; ++j) { const f32x4 wv = *(const LAS f32x4*)(WR + e * D + 4 * lane + 256 * j); s += (v[j][0] * wv[0] + v[j][1] * wv[1]) + (v[j][2] * wv[2] + v[j][3] * wv[3]); }
            lg[e] = wave_sum(s); }
        int e1 = 0; float v1 = lg[0];
#pragma unroll
        for (int e = 1; e < 8; ++e) if (lg[e] > v1) { v1 = lg[e]; e1 = e; }
        int e2 = -1; float v2 = -__builtin_inff();
#pragma unroll
        for (int e = 0; e < 8; ++e) if (e != e1 && lg[e] > v2) { v2 = lg[e]; e2 = e; }
        if (lane == 0 && k < 8) { const float ex = __expf(v2 - v1), g1 = 1.0f / (1.0f + ex), g2 = ex * g1;
            const int ls1 = atomicAdd((int*)&cntl[e1], 1), ls2 = atomicAdd((int*)&cntl[e2], 1);
            LAS int* q = info + (F.wave * 8 + k) * 8; q[0] = m; q[1] = e1; q[2] = e2; q[3] = ls1; q[4] = ls2; q[5] = __float_as_int(g1); q[6] = __float_as_int(g2); }
    }
    const int nrows = k < 8 ? k : 8;
    if (lane == 0) info[512 + F.wave] = nrows;
    __syncthreads();
    if (tid < 8) cntl[8 + tid] = (int)__hip_atomic_fetch_add(gcnt + 64 * tid, (unsigned)cntl[tid], __ATOMIC_RELAXED, __HIP_MEMORY_SCOPE_AGENT);
    __syncthreads();
    if (tid < 64) { const int wv = tid >> 3, kk = tid & 7;
        if (kk < info[512 + wv]) { const LAS int* q = info + tid * 8; const int m = q[0], e1 = q[1], e2 = q[2], s1 = cntl[8 + e1] + q[3], s2 = cntl[8 + e2] + q[4];
            LIST[e1 * MTOK + s1] = m; LIST[e2 * MTOK + s2] = m;
            int* t = TOK + (size_t)m * 8; t[0] = e1; t[1] = s1; t[2] = q[5]; t[3] = e2; t[4] = s2; t[5] = q[6]; } }
    __syncthreads();
}
__device__ __forceinline__ void moe_prefix(Frame& F, int (&tb)[9], int (&cnt)[8]) {
    const unsigned* gcnt = (const unsigned*)(F.ws + WS_CTL) + CW_CNT; tb[0] = 0;
#pragma unroll
    for (int e = 0; e < 8; ++e) { cnt[e] = (int)__builtin_amdgcn_readfirstlane(gcnt[64 * e]); tb[e + 1] = tb[e] + ((cnt[e] + 255) >> 8); }
}
__device__ __forceinline__ void moe_fill_idx(Frame& F, const pg8::MoeOrder& S, const int (&tb)[9], const int (&cnt)[8]) {
    LAS unsigned short* idx = (LAS unsigned short*)(F.lds + pg8::IDX_LDS_OFF); const int* LIST = (const int*)(F.ws + WS_LIST);
    const int row = F.tid & 255, sub = F.tid >> 8;
    for (int ui = 0; ui < 30; ui += 2) {
        pg8::Unit u0; if (!S.next(ui, u0)) break;
        pg8::Unit u; const int uu = ui + sub;
        if (S.next(uu, u)) { int base = 0, ce = 0;
#pragma unroll
            for (int j = 0; j < 8; ++j) if (j == u.e) { base = tb[j]; ce = cnt[j]; }
            const int sidx = (u.pm - base) * 256 + row; const int tok = LIST[u.e * MTOK + (sidx < ce ? sidx : 0)];
            idx[uu * 256 + row] = (unsigned short)tok; }
    }
    __syncthreads();
}
__device__ __forceinline__ int gather_src(const int (&tb)[9], const int (&cnt)[8], const int* LIST, int rr) {
    const int tile = rr >> 8; int e = 0;
#pragma unroll
    for (int j = 1; j < 8; ++j) e += (tile >= tb[j]) ? 1 : 0;
    int base = 0, ce = 0;
#pragma unroll
    for (int j = 0; j < 8; ++j) if (j == e) { base = tb[j] * 256; ce = cnt[j]; }
    const int sidx = rr - base; return (sidx < ce) ? LIST[e * MTOK + sidx] : -1;
}
__device__ __forceinline__ void gather_phase(Frame& F) {
    const int gw = F.vcu * 8 + F.wave, NGW = F.G * 8, lane = F.lane;
    int tb[9], cnt[8]; moe_prefix(F, tb, cnt);
    const int* LIST = (const int*)(F.ws + WS_LIST); const bf16* XB = (const bf16*)(F.ws + WS_XB0); bf16* XG = (bf16*)(F.ws + WS_XG);
    const int rows = tb[8] * 256;
    for (int rr = gw; rr < rows; rr += 4 * NGW) {
        int tk[4];
#pragma unroll
        for (int k = 0; k < 4; ++k) { const int r = rr + k * NGW; tk[k] = (r < rows) ? gather_src(tb, cnt, LIST, r) : -2; }
        u32x4 v[4][4];
#pragma unroll
        for (int k = 0; k < 4; ++k)
#pragma unroll
            for (int j = 0; j < 4; ++j) v[k][j] = (tk[k] >= 0) ? *(const u32x4*)(XB + (size_t)tk[k] * D + (lane + 64 * j) * 8) : (u32x4){0u, 0u, 0u, 0u};
#pragma unroll
        for (int k = 0; k < 4; ++k) if (tk[k] != -2) {
#pragma unroll
            for (int j = 0; j < 4; ++j) *(u32x4*)(XG + (size_t)(rr + k * NGW) * D + (lane + 64 * j) * 8) = v[k][j]; }
    }
}
struct MoeRow { int r1, r2; float g1, g2; };
__device__ __forceinline__ MoeRow moe_row_info(const int* TOK, const int (&tb)[9], int m) {
    const int* t = TOK + (size_t)m * 8; const int e1 = t[0], s1 = t[1], e2 = t[3], s2 = t[4]; MoeRow r; r.g1 = __int_as_float(t[2]); r.g2 = __int_as_float(t[5]);
    int b1 = 0, b2 = 0;
#pragma unroll
    for (int j = 0; j < 8; ++j) { if (j == e1) b1 = tb[j] * 256; if (j == e2) b2 = tb[j] * 256; }
    r.r1 = b1 + s1; r.r2 = b2 + s2; return r;
}
__device__ __forceinline__ void ln_moe_phase(Frame& F, const bf16* X4, const float* gam, const float* bet, bf16* XB) {
    const int gw = F.vcu * 8 + F.wave, NGW = F.G * 8, lane = F.lane;
    int tb[9], cnt[8]; moe_prefix(F, tb, cnt);
    const int* TOK = (const int*)(F.ws + WS_TOK); const bf16* YE = (const bf16*)(F.ws + WS_XG); const bf16* YEP = (const bf16*)(F.ws + WS_YEP); constexpr size_t QSTR = (size_t)8 * 256 * D;
    const int split0 = (((8 * tb[8]) / F.G) * F.G >> 3) * 256;
    f32x4 gg[8], bb[8]; ln_load_gb8(gam, bet, gg, bb, lane);
    for (int m0 = gw; m0 < MTOK; m0 += 2 * NGW) {
        const bool has2 = (m0 + NGW) < MTOK; const int mm[2] = {m0, has2 ? m0 + NGW : m0};
        MoeRow ri[2]; ri[0] = moe_row_info(TOK, tb, mm[0]); ri[1] = moe_row_info(TOK, tb, mm[1]);
        u32x4 xw[2][4], aw[2][4], bw[2][4]; const bf16* y1[2]; const bf16* y2[2]; bool p1[2], p2[2];
#pragma unroll
        for (int q = 0; q < 2; ++q) { p1[q] = ri[q].r1 >= split0; p2[q] = ri[q].r2 >= split0;
            y1[q] = p1[q] ? YEP + (size_t)(ri[q].r1 - split0) * D : YE + (size_t)ri[q].r1 * D; y2[q] = p2[q] ? YEP + (size_t)(ri[q].r2 - split0) * D : YE + (size_t)ri[q].r2 * D;
#pragma unroll
            for (int j = 0; j < 4; ++j) { const int c = (lane + 64 * j) * 8; xw[q][j] = *(const u32x4*)(X4 + (size_t)mm[q] * D + c); aw[q][j] = *(const u32x4*)(y1[q] + c); bw[q][j] = *(const u32x4*)(y2[q] + c); } }
#pragma unroll
        for (int q = 0; q < 2; ++q) { if (q == 1 && !has2) break;
            const float g1 = ri[q].g1, g2 = ri[q].g2; f32x4 v[8];
#pragma unroll
            for (int j = 0; j < 4; ++j) { const int c = (lane + 64 * j) * 8; const u32x4 x = xw[q][j], a = aw[q][j], b = bw[q][j];
                float fa[8], fb[8];
#pragma unroll
                for (int e = 0; e < 4; ++e) { fa[2 * e] = bf_lo(a[e]); fa[2 * e + 1] = bf_hi(a[e]); fb[2 * e] = bf_lo(b[e]); fb[2 * e + 1] = bf_hi(b[e]); }
                if (p1[q]) {
#pragma unroll
                    for (int kq = 1; kq < 4; ++kq) { const u32x4 t4 = *(const u32x4*)(y1[q] + (size_t)kq * QSTR + c);
#pragma unroll
                        for (int e = 0; e < 4; ++e) { fa[2 * e] += bf_lo(t4[e]); fa[2 * e + 1] += bf_hi(t4[e]); } } }
                if (p2[q]) {
#pragma unroll
                    for (int kq = 1; kq < 4; ++kq) { const u32x4 t4 = *(const u32x4*)(y2[q] + (size_t)kq * QSTR + c);
#pragma unroll
                        for (int e = 0; e < 4; ++e) { fb[2 * e] += bf_lo(t4[e]); fb[2 * e + 1] += bf_hi(t4[e]); } } }
#pragma unroll
                for (int e = 0; e < 4; ++e) { const float lo = DN_ALPHA * bf_lo(x[e]) + g1 * fa[2 * e] + g2 * fb[2 * e], hi = DN_ALPHA * bf_hi(x[e]) + g1 * fa[2 * e + 1] + g2 * fb[2 * e + 1];
                    v[2 * j + (e >> 1)][(e & 1) * 2] = lo; v[2 * j + (e >> 1)][(e & 1) * 2 + 1] = hi; } }
            ln_core(v, gg, bb); ln_store8(v, XB + (size_t)mm[q] * D, lane);
        }
    }
}

constexpr int NPHASE = 19;
__global__ void __launch_bounds__(512, 2) fwd_kernel(Args args) {
    extern __shared__ __attribute__((aligned(16))) unsigned char lds[];
    Frame F; F.lds = (LAS unsigned char*)lds; F.tid = threadIdx.x; F.lane = F.tid & 63; F.wave = __builtin_amdgcn_readfirstlane(F.tid >> 6);
    F.G = gridDim.x; { const int bx = blockIdx.x; F.vcu = (F.G % 8 == 0) ? (bx % 8) * (F.G / 8) + bx / 8 : bx; }
    F.ws = args.ws; unsigned char* ws = args.ws;
    volatile LAS unsigned* MISC = (volatile LAS unsigned*)(F.lds + MISC_OFF);
    for (int u = F.tid; u < (LDS_BYTES - LDSCTL_OFF) / 4; u += 512) ((LAS unsigned*)(F.lds + LDSCTL_OFF))[u] = 0u;
    __syncthreads();
    XcdBarrier bar; bar.bar = (unsigned*)(ws + WS_CTL) + CW_BAR; bar.x = 0; bar.st = nullptr;
    if (args.ph_hi - args.ph_lo > 1) bar = xcd_barrier_post((unsigned*)(ws + WS_CTL) + CW_BAR, MISC + 8);
    const int lo = args.ph_lo, hi = args.ph_hi;
#define IN(k) (lo <= (k) && (k) < hi)
    long long pht0 = 0, pht1 = 0; if (PHT_SEL == 0) pht0 = wall_clock64();
#define SEAM(k) do { if (IN(k) && IN((k) + 1)) xcd_barrier(bar); if (PHT_SEL == (k) + 1) pht0 = wall_clock64(); if (PHT_SEL == (k)) pht1 = wall_clock64(); } while (0)
    LAS unsigned char* ring = F.lds;
    const int bx = (int)blockIdx.x;
    bf16* XB0 = (bf16*)(ws + WS_XB0); bf16* XB1 = (bf16*)(ws + WS_XB1); bf16* YB = (bf16*)(ws + WS_YB); float* Y = args.out;

    if (IN(0)) { p0_prologue(F, args); }
    if constexpr ((DUP_MASK >> 0) & 1u) { if (IN(0)) { p0_prologue(F, args); } }
    SEAM(0);
    if (IN(1)) {
        { pg8::Gemm g{XB0, (const bf16*)(ws + WS_WQKV), D, D, D}; pg8::StaticOrder S; S.init(MTOK, NQKV, F.G, bx);
          pg8::EpiQKV E{(bf16*)(ws + WS_QKV), (const float*)(ws + WS_ROPE)}; pg8::gemm_phase(ring, g, S, E); }
        { pg8::Gemm g{(const bf16*)(ws + WS_PB), (const bf16*)(ws + WS_WPROJ), PLE, PLE, PLE}; pg8::BatchOrder S; S.init(MTOK, D, 2, (size_t)MTOK * PLE, (size_t)D * PLE, F.G, bx);
          pg8::EpiBf16 E{(bf16*)(ws + WS_PPROJ), D, (size_t)MTOK * D, 0}; pg8::gemm_phase(ring, g, S, E); }
        {
          pg8::Gemm g{(const bf16*)(ws + WS_WO2), (const bf16*)(ws + WS_WGS), 512, D, 512}; pg8::BatchOrder S; S.init(D, 512, 4, (size_t)512, (size_t)512 * 512, F.G, bx);
          pg8::EpiBf16 E{(bf16*)(ws + WS_WCOMB), D, (size_t)0, 512}; pg8::gemm_phase(ring, g, S, E); }
    }
    if constexpr ((DUP_MASK >> 1) & 1u) { if (IN(1)) {
        { pg8::Gemm g{XB0, (const bf16*)(ws + WS_WQKV), D, D, D}; pg8::StaticOrder S; S.init(MTOK, NQKV, F.G, bx);
          pg8::EpiQKV E{(bf16*)(ws + WS_QKV), (const float*)(ws + WS_ROPE)}; pg8::gemm_phase(ring, g, S, E); }
        { pg8::Gemm g{(const bf16*)(ws + WS_PB), (const bf16*)(ws + WS_WPROJ), PLE, PLE, PLE}; pg8::BatchOrder S; S.init(MTOK, D, 2, (size_t)MTOK * PLE, (size_t)D * PLE, F.G, bx);
          pg8::EpiBf16 E{(bf16*)(ws + WS_PPROJ), D, (size_t)MTOK * D, 0}; pg8::gemm_phase(ring, g, S, E); }
        {
          pg8::Gemm g{(const bf16*)(ws + WS_WO2), (const bf16*)(ws + WS_WGS), 512, D, 512}; pg8::BatchOrder S; S.init(D, 512, 4, (size_t)512, (size_t)512 * 512, F.G, bx);
          pg8::EpiBf16 E{(bf16*)(ws + WS_WCOMB), D, (size_t)0, 512}; pg8::gemm_phase(ring, g, S, E); }
    } }
    SEAM(1);
    if (IN(2)) { attn_phase(F); }
    if constexpr ((DUP_MASK >> 2) & 1u) { if (IN(2)) { attn_phase(F); } }
    SEAM(2);
    if (IN(3)) { combine_phase(F); moe_convert_phase(F, args); }
    if constexpr ((DUP_MASK >> 3) & 1u) { if (IN(3)) { combine_phase(F); moe_convert_phase(F, args); } }
    SEAM(3);
    if (IN(4)) { pg8::Gemm g{(const bf16*)(ws + WS_ATT), (const bf16*)(ws + WS_WO), D, D, D}; pg8::StaticOrder S; S.init(MTOK, D, F.G, bx);
        pg8::EpiBf16 E{YB, D, (size_t)0, 0}; pg8::gemm_phase(ring, g, S, E); }
    if constexpr ((DUP_MASK >> 4) & 1u) { if (IN(4)) { pg8::Gemm g{(const bf16*)(ws + WS_ATT), (const bf16*)(ws + WS_WO), D, D, D}; pg8::StaticOrder S; S.init(MTOK, D, F.G, bx);
        pg8::EpiBf16 E{YB, D, (size_t)0, 0}; pg8::gemm_phase(ring, g, S, E); } }
    SEAM(4);
    if (IN(5)) { ln_phase(F, YB, XB0, args.in[8], args.in[9], XB0); }
    if constexpr ((DUP_MASK >> 5) & 1u) { if (IN(5)) { ln_phase(F, YB, XB0, args.in[8], args.in[9], XB0); } }
    SEAM(5);
    if (IN(6)) { pg8::Gemm g{XB0, (const bf16*)(ws + WS_W13), D, D, D}; pg8::StaticOrder S; S.init(MTOK, FF2, F.G, bx);
        pg8::EpiSwiGLU E{(bf16*)(ws + WS_H), FF}; pg8::gemm_phase<pg8::EpiSwiGLU, pg8::StaticOrder, true, true, (STAMP_SEL != 0)>(ring, g, S, E, (unsigned long long*)(ws + WS_CTL + 512 * 1024)); }
    if constexpr ((DUP_MASK >> 6) & 1u) { if (IN(6)) { pg8::Gemm g{XB0, (const bf16*)(ws + WS_W13), D, D, D}; pg8::StaticOrder S; S.init(MTOK, FF2, F.G, bx);
        pg8::EpiSwiGLU E{(bf16*)(ws + WS_H), FF}; pg8::gemm_phase(ring, g, S, E); } }
    SEAM(6);
    if (IN(7)) { pg8::Gemm g{(const bf16*)(ws + WS_H), (const bf16*)(ws + WS_W2), FF, FF, FF}; pg8::StaticOrder S; S.init(MTOK, D, F.G, bx);
        pg8::EpiBf16 E{YB, D, (size_t)0, 0}; pg8::gemm_phase(ring, g, S, E); }
    if constexpr ((DUP_MASK >> 7) & 1u) { if (IN(7)) { pg8::Gemm g{(const bf16*)(ws + WS_H), (const bf16*)(ws + WS_W2), FF, FF, FF}; pg8::StaticOrder S; S.init(MTOK, D, F.G, bx);
        pg8::EpiBf16 E{YB, D, (size_t)0, 0}; pg8::gemm_phase(ring, g, S, E); } }
    SEAM(7);
    if (IN(8)) { ln_phase(F, YB, XB0, args.in[10], args.in[11], XB0); }
    if constexpr ((DUP_MASK >> 8) & 1u) { if (IN(8)) { ln_phase(F, YB, XB0, args.in[10], args.in[11], XB0); } }
    SEAM(8);
    if (IN(9)) { pg8::Gemm g{XB0, (const bf16*)(ws + WS_WGATE), D, D, D}; pg8::StaticOrder S; S.init(MTOK, D, F.G, bx);
        pg8::EpiPle E{XB0, (const bf16*)(ws + WS_PPROJ), args.in[21], nullptr, XB1, D}; pg8::gemm_phase(ring, g, S, E); }
    if constexpr ((DUP_MASK >> 9) & 1u) { if (IN(9)) { pg8::Gemm g{XB0, (const bf16*)(ws + WS_WGATE), D, D, D}; pg8::StaticOrder S; S.init(MTOK, D, F.G, bx);
        pg8::EpiPle E{XB0, (const bf16*)(ws + WS_PPROJ), args.in[21], nullptr, XB1, D}; pg8::gemm_phase(ring, g, S, E); } }
    SEAM(9);
    if (IN(10)) { pg8::Gemm g{XB1, (const bf16*)(ws + WS_WIN), D, D, D}; pg8::StaticOrder S; S.init(MTOK, D, F.G, bx);
        pg8::EpiBf16 E{(bf16*)(ws + WS_U), D, (size_t)0, 0}; pg8::gemm_phase(ring, g, S, E); }
    if constexpr ((DUP_MASK >> 10) & 1u) { if (IN(10)) { pg8::Gemm g{XB1, (const bf16*)(ws + WS_WIN), D, D, D}; pg8::StaticOrder S; S.init(MTOK, D, F.G, bx);
        pg8::EpiBf16 E{(bf16*)(ws + WS_U), D, (size_t)0, 0}; pg8::gemm_phase(ring, g, S, E); } }
    SEAM(10);
    if (IN(11)) { pool_phase(F); }
    if constexpr ((DUP_MASK >> 11) & 1u) { if (IN(11)) { pool_phase(F); } }
    SEAM(11);
    if (IN(12)) { pg8::Gemm g{(const bf16*)(ws + WS_MIX), (const bf16*)(ws + WS_WCOMB), D, D, D}; pg8::StaticOrder S; S.init(MTOK, D, F.G, bx);
        pg8::EpiF32 E{Y, D}; pg8::gemm_phase(ring, g, S, E); }
    if constexpr ((DUP_MASK >> 12) & 1u) { if (IN(12)) { pg8::Gemm g{(const bf16*)(ws + WS_MIX), (const bf16*)(ws + WS_WCOMB), D, D, D}; pg8::StaticOrder S; S.init(MTOK, D, F.G, bx);
        pg8::EpiF32 E{Y, D}; pg8::gemm_phase(ring, g, S, E); } }
    SEAM(12);
    if (IN(13)) { ln_router_phase(F, Y, XB1, args.in[8] + D, args.in[9] + D, args.in[15], XB0); }
    if constexpr ((DUP_MASK >> 13) & 1u) { if (IN(13)) { ln_router_phase(F, Y, XB1, args.in[8] + D, args.in[9] + D, args.in[15], XB0); } }
    SEAM(13);
    if (PHT_SEL == 15) pht0 = wall_clock64();
    if (IN(15)) { int tb[9], cnt[8]; moe_prefix(F, tb, cnt);
        pg8::Gemm g{XB0, (const bf16*)(ws + WS_MW13), D, D, D}; pg8::MoeOrder S; S.nM = tb[8]; S.nN = FF2 / 256; S.nwg = S.nM * S.nN; S.G = F.G; S.c = bx; S.sB = (size_t)FF2 * D; S.gather = true;
#pragma unroll
        for (int j = 0; j < 9; ++j) S.tb[j] = tb[j];
        moe_fill_idx(F, S, tb, cnt);
        pg8::EpiSwiGLU E{(bf16*)(ws + WS_HM), FF}; pg8::gemm_phase<pg8::EpiSwiGLU, pg8::MoeOrder, true, true, false, true>(ring, g, S, E); }
    if constexpr ((DUP_MASK >> 15) & 1u) { if (IN(15)) { int tb[9], cnt[8]; moe_prefix(F, tb, cnt);
        pg8::Gemm g{XB0, (const bf16*)(ws + WS_MW13), D, D, D}; pg8::MoeOrder S; S.nM = tb[8]; S.nN = FF2 / 256; S.nwg = S.nM * S.nN; S.G = F.G; S.c = bx; S.sB = (size_t)FF2 * D; S.gather = true;
#pragma unroll
        for (int j = 0; j < 9; ++j) S.tb[j] = tb[j];
        moe_fill_idx(F, S, tb, cnt);
        pg8::EpiSwiGLU E{(bf16*)(ws + WS_HM), FF}; pg8::gemm_phase<pg8::EpiSwiGLU, pg8::MoeOrder, true, true, false, true>(ring, g, S, E); } }
    SEAM(15);
    if (IN(16)) { int tb[9], cnt[8]; moe_prefix(F, tb, cnt);
        pg8::Gemm g{(const bf16*)(ws + WS_HM), (const bf16*)(ws + WS_MW2), FF, FF, FF}; pg8::MoeDownOrder S; S.nM = tb[8]; S.G = F.G; S.c = F.vcu; S.nfull = ((8 * tb[8]) / F.G) * F.G; S.kq_elems = FF / 4; S.kq_nt = FF / 4 / 64; S.sB = (size_t)D * FF;
#pragma unroll
        for (int j = 0; j < 9; ++j) S.tb[j] = tb[j];
        pg8::EpiMoeDown E{(bf16*)(ws + WS_XG), (bf16*)(ws + WS_YEP), S.nfull >> 3, (size_t)8 * 256 * D}; pg8::gemm_phase(ring, g, S, E); }
    if constexpr ((DUP_MASK >> 16) & 1u) { if (IN(16)) { int tb[9], cnt[8]; moe_prefix(F, tb, cnt);
        pg8::Gemm g{(const bf16*)(ws + WS_HM), (const bf16*)(ws + WS_MW2), FF, FF, FF}; pg8::MoeDownOrder S; S.nM = tb[8]; S.G = F.G; S.c = F.vcu; S.nfull = ((8 * tb[8]) / F.G) * F.G; S.kq_elems = FF / 4; S.kq_nt = FF / 4 / 64; S.sB = (size_t)D * FF;
#pragma unroll
        for (int j = 0; j < 9; ++j) S.tb[j] = tb[j];
        pg8::EpiMoeDown E{(bf16*)(ws + WS_XG), (bf16*)(ws + WS_YEP), S.nfull >> 3, (size_t)8 * 256 * D}; pg8::gemm_phase(ring, g, S, E); } }
    SEAM(16);
    if (IN(17)) { ln_moe_phase(F, XB0, args.in[10] + D, args.in[11] + D, XB1); }
    if constexpr ((DUP_MASK >> 17) & 1u) { if (IN(17)) { ln_moe_phase(F, XB0, args.in[10] + D, args.in[11] + D, XB1); } }
    SEAM(17);
    if (IN(18)) { pg8::Gemm g{XB1, (const bf16*)(ws + WS_WGATE) + (size_t)D * D, D, D, D}; pg8::StaticOrder S; S.init(MTOK, D, F.G, bx);
        pg8::EpiPle E{XB1, (const bf16*)(ws + WS_PPROJ) + (size_t)MTOK * D, args.in[21] + D, args.out, nullptr, D}; pg8::gemm_phase(ring, g, S, E); }
    if constexpr ((DUP_MASK >> 18) & 1u) { if (IN(18)) { pg8::Gemm g{XB1, (const bf16*)(ws + WS_WGATE) + (size_t)D * D, D, D, D}; pg8::StaticOrder S; S.init(MTOK, D, F.G, bx);
        pg8::EpiPle E{XB1, (const bf16*)(ws + WS_PPROJ) + (size_t)MTOK * D, args.in[21] + D, args.out, nullptr, D}; pg8::gemm_phase(ring, g, S, E); } }
    if (STAMP_SEL != 0 && blockIdx.x == 0 && F.tid == 0 && hi == NPHASE) { const unsigned long long us = ((volatile unsigned long long*)(ws + WS_CTL + 512 * 1024))[STAMP_SEL - 1]; const long long w0 = wall_clock64(); while ((unsigned long long)(wall_clock64() - w0) < us * 100ull) __builtin_amdgcn_s_sleep(32); }
    if (PHT_SEL >= 0 && blockIdx.x == 0 && F.tid == 0 && hi == NPHASE) { if (PHT_SEL == NPHASE - 1) pht1 = wall_clock64(); const long long w0 = wall_clock64(); while (wall_clock64() - w0 < PHT_MULT * (pht1 - pht0)) __builtin_amdgcn_s_sleep(32); }
#undef IN
#undef SEAM
}

extern "C" void kernel_launch(void* const* d_in, const int* in_sizes, int n_in, void* d_out, int out_size, void* d_ws, size_t ws_size, hipStream_t stream) {
    static int grid = 0; static bool one_launch = true;
    if (grid == 0) {
        if (n_in != 22 || out_size != MTOK * D || ws_size < WS_END) { fprintf(stderr, "kernel_launch: unexpected shapes (n_in %d, out %d, ws %zu < %zu)\n", n_in, out_size, ws_size, (size_t)WS_END); grid = -1; return; }
        int dev = 0, cus = 0, per_cu = 0;
        if (hipGetDevice(&dev) != hipSuccess || hipDeviceGetAttribute(&cus, hipDeviceAttributeMultiprocessorCount, dev) != hipSuccess) { grid = -1; return; }
        if (hipFuncSetAttribute((const void*)fwd_kernel, hipFuncAttributeMaxDynamicSharedMemorySize, LDS_BYTES) != hipSuccess) { fprintf(stderr, "kernel_launch: hipFuncSetAttribute failed\n"); grid = -1; return; }
        if (hipOccupancyMaxActiveBlocksPerMultiprocessor(&per_cu, (const void*)fwd_kernel, 512, LDS_BYTES) != hipSuccess || per_cu < 1) { fprintf(stderr, "kernel_launch: occupancy query says %d blocks per CU\n", per_cu); }
        (void)hipGetLastError();
        grid = 256;
        one_launch = (cus >= 256);
    }
    if (grid < 0) return;
    (void)hipMemsetAsync((char*)d_ws + WS_CTL, 0, CTL_ZERO_BYTES, stream);
    Args a{};
    for (int i = 0; i < 22; ++i) a.in[i] = (const float*)d_in[i];
    a.out = (float*)d_out; a.ws = (unsigned char*)d_ws;
    if (MK_PER_PHASE || !one_launch) { for (int p = 0; p < NPHASE; ++p) { a.ph_lo = p; a.ph_hi = p + 1; hipLaunchKernelGGL(fwd_kernel, dim3(grid), dim3(512), LDS_BYTES, stream, a); } }
    else { a.ph_lo = 0; a.ph_hi = NPHASE; hipLaunchKernelGGL(fwd_kernel, dim3(grid), dim3(512), LDS_BYTES, stream, a); }
}
```

```cpp
#include <hip/hip_runtime.h>
#include <cstdio>
#include <cstdint>

#ifndef MK_PER_PHASE
#define MK_PER_PHASE 0
#endif
#ifndef STAMP_SEL
#define STAMP_SEL 0
#endif
#ifndef PHT_SEL
#define PHT_SEL -1
#endif
#define PHT_MULT 4
#ifndef SPREAD_SEL
#define SPREAD_SEL 0
#endif
#ifndef SPREAD_XCD
#define SPREAD_XCD 0
#endif
#ifndef DUP_MASK
#define DUP_MASK 0u
#endif

#define LAS __attribute__((address_space(3)))
#define GAS __attribute__((address_space(1)))
typedef unsigned short bf16;
typedef short bf16x8 __attribute__((ext_vector_type(8)));
typedef short s16x4 __attribute__((ext_vector_type(4)));
typedef float f32x4 __attribute__((ext_vector_type(4)));
typedef float f32x2 __attribute__((ext_vector_type(2)));
typedef unsigned u32x4 __attribute__((ext_vector_type(4)));
typedef unsigned u32x2 __attribute__((ext_vector_type(2)));
typedef GAS unsigned gu32;

constexpr int D = 2048, BATCH = 4, SEQ = 4096, MTOK = BATCH * SEQ;
constexpr int NH = 16, HD = 128, NQKV = 3 * 3 * D;
constexpr int FF = 5632, FF2 = 2 * FF;
constexpr int NE = 8, PLE = 256;
constexpr float LN_EPS = 1e-5f;
constexpr float DN_ALPHA = 1.41421356237309515f;
constexpr int MOE_ROWS = 2 * MTOK + NE * 256;

constexpr size_t MiB = 1u << 20;
constexpr size_t WS_CTL = 0, CTL_ZERO_BYTES = 1 * MiB;
constexpr size_t WS_LIST = 1 * MiB;
constexpr size_t WS_TOK = 2 * MiB;
constexpr size_t WS_LSE = 3 * MiB;
constexpr size_t WS_ROPE = 6 * MiB;
constexpr size_t WS_WGATE = 8 * MiB;
constexpr size_t WS_WPROJ = 24 * MiB;
constexpr size_t WS_WIN = 26 * MiB;
constexpr size_t WS_WCOMB = 34 * MiB;
constexpr size_t WS_WO2 = 42 * MiB;
constexpr size_t WS_WGS = 50 * MiB;
constexpr size_t WS_PB = 52 * MiB;
constexpr size_t WS_PPROJ = 68 * MiB;
constexpr size_t WS_XB0 = 196 * MiB;
constexpr size_t WS_YB = 260 * MiB;
constexpr size_t WS_WQKV = 516 * MiB;
constexpr size_t WS_WO = 588 * MiB;
constexpr size_t WS_W13 = 596 * MiB;
constexpr size_t WS_W2 = 640 * MiB;
constexpr size_t WS_QKV = 662 * MiB;
constexpr size_t WS_OG = 1238 * MiB;
constexpr size_t WS_ATT = 1430 * MiB;
constexpr size_t WS_MW13 = 662 * MiB;
constexpr size_t WS_MW2 = 1014 * MiB;
constexpr size_t WS_H = 1238 * MiB;
constexpr size_t WS_XB1 = 1430 * MiB;
constexpr size_t WS_U = 1190 * MiB;
constexpr size_t WS_MIX = 1254 * MiB;
constexpr size_t WS_HM = 1190 * MiB;
constexpr size_t WS_XG = 516 * MiB;
constexpr size_t WS_YEP = 324 * MiB;
constexpr size_t WS_END = 1564 * MiB;
static_assert(WS_MW2 + (size_t)NE * D * FF * 2 <= WS_U && WS_HM + (size_t)MOE_ROWS * FF * 2 <= WS_END && WS_XG + (size_t)MOE_ROWS * D * 2 <= WS_QKV, "ws map");

constexpr int CW_CNT = 64;
constexpr int CW_DYN = 1024;
constexpr int CW_BAR = 4096;

constexpr int RING_BYTES = 131072;
constexpr int LDSCTL_OFF = RING_BYTES, MISC_OFF = LDSCTL_OFF + 320;
constexpr int LDS_BYTES = 163840;

#define VM_WAIT() asm volatile("s_waitcnt vmcnt(0)" ::: "memory")
__device__ __forceinline__ unsigned cvt_pk_bf16(float lo, float hi) { unsigned r; asm volatile("v_cvt_pk_bf16_f32 %0, %1, %2" : "=v"(r) : "v"(lo), "v"(hi)); return r; }
__device__ __forceinline__ float bf_lo(unsigned w) { return __uint_as_float(w << 16); }
__device__ __forceinline__ float bf_hi(unsigned w) { return __uint_as_float(w & 0xffff0000u); }
__device__ __forceinline__ float wave_sum(float v) {
#pragma unroll
    for (int o = 1; o < 64; o <<= 1) v += __shfl_xor(v, o);
    return v;
}

namespace pg8 {
#define PG8_LAS __attribute__((address_space(3)))
typedef unsigned short bf16_t;
constexpr int BM = 256, BK = 64, HALF = 128, HTB = HALF * BK * 2, STAGE_BYTES = 8 * HTB, NXCD = 8, WGM = 8;

__host__ __device__ __forceinline__ int lds_byte(int r, int c) { const int st = (r >> 4) * 2 + (c >> 5), rr = r & 15, cc = c & 31, ob = rr * 64 + cc * 2; return st * 1024 + (ob ^ (((ob >> 9) & 1) << 5)); }
__host__ __device__ __forceinline__ void stage_rc(int b, int& R, int& C) { const int st = b / 1024, sb = b % 1024, swz = sb ^ (((sb >> 9) & 1) << 5); R = (st >> 1) * 16 + swz / 64; C = (st & 1) * 32 + (swz % 64) / 2; }
__host__ __device__ __forceinline__ int perm32(int rho) { const int n = rho >> 4, i = rho & 15; return 8 * (i >> 2) + 4 * n + (i & 3); }

struct Unit { int pm, pn, e; };
struct Gemm { const bf16_t* A; const bf16_t* Bt; int K, lda, ldb; };

__device__ __forceinline__ void tile_of(int wgid, int nM, int nN, int& pm, int& pn) {
    const int nwg = nM * nN;
    { const int q = nwg / NXCD, r = nwg % NXCD, xcd = wgid % NXCD, off = wgid / NXCD; wgid = (xcd < r ? xcd * (q + 1) : r * (q + 1) + (xcd - r) * q) + off; }
    const int nig = WGM * nN, gid = wgid / nig, fm = gid * WGM, gsz = (nM - fm) < WGM ? (nM - fm) : WGM;
    pm = fm + ((wgid % nig) % gsz); pn = (wgid % nig) / gsz;
}
struct StaticOrder {
    int nM, nN, nwg, G, c; int rs; unsigned* ctr;
    __device__ __forceinline__ void init(int M, int N, int G_, int c_) { nM = M / BM; nN = N / BM; nwg = nM * nN; G = G_; c = c_; rs = 1 << 30; ctr = nullptr; }
    __device__ __forceinline__ void dynamic_tail(unsigned* ctr_, int keep) { const int r = nwg / G; if (r > keep) { rs = r - keep; ctr = ctr_; } }
    __device__ __forceinline__ bool unit_of(long L, Unit& u) const { if (L >= nwg) return false; tile_of((int)L, nM, nN, u.pm, u.pn); u.e = 0; return true; }
    __device__ __forceinline__ bool next(int i, Unit& u) const { return unit_of((long)i * G + c, u); }
    __device__ __forceinline__ const char* a_ptr(const Gemm& g, const Unit& u) const { return (const char*)g.A + (size_t)u.pm * BM * g.lda * 2; }
    __device__ __forceinline__ const char* b_ptr(const Gemm& g, const Unit& u) const { return (const char*)g.Bt + (size_t)u.pn * BM * g.ldb * 2; }
    __device__ __forceinline__ int unit_nt(const Gemm& g, const Unit&) const { return g.K / BK; }
    __device__ __forceinline__ int n_static() const { return rs; }
    __device__ __forceinline__ unsigned* dyn_ctr() const { return ctr; }
    __device__ __forceinline__ bool dyn_unit(unsigned j, Unit& u) const { return unit_of((long)rs * G + (long)j, u); }
    __device__ __forceinline__ int gather_tok(const Unit&, int) const { return 0; }
    __device__ __forceinline__ bool skip_hi(const Unit&) const { return false; }
};
struct BatchOrder {
    int nM, nN, nwg, nb, G, c; size_t sA, sB;
    __device__ __forceinline__ void init(int M, int N, int nb_, size_t sA_, size_t sB_, int G_, int c_) { nM = M / BM; nN = N / BM; nwg = nM * nN; nb = nb_; sA = sA_; sB = sB_; G = G_; c = c_; }
    __device__ __forceinline__ bool next(int i, Unit& u) const {
        const long L = (long)i * G + c; if (L >= (long)nwg * nb) return false;
        u.e = (int)(L / nwg); tile_of((int)(L % nwg), nM, nN, u.pm, u.pn); return true;
    }
    __device__ __forceinline__ const char* a_ptr(const Gemm& g, const Unit& u) const { return (const char*)(g.A + (size_t)u.e * sA) + (size_t)u.pm * BM * g.lda * 2; }
    __device__ __forceinline__ const char* b_ptr(const Gemm& g, const Unit& u) const { return (const char*)(g.Bt + (size_t)u.e * sB) + (size_t)u.pn * BM * g.ldb * 2; }
    __device__ __forceinline__ int unit_nt(const Gemm& g, const Unit&) const { return g.K / BK; }
    __device__ __forceinline__ int n_static() const { return 1 << 30; }
    __device__ __forceinline__ unsigned* dyn_ctr() const { return nullptr; }
    __device__ __forceinline__ bool dyn_unit(unsigned, Unit&) const { return false; }
    __device__ __forceinline__ int gather_tok(const Unit&, int) const { return 0; }
    __device__ __forceinline__ bool skip_hi(const Unit&) const { return false; }
};
struct MoeOrder {
    int nM, nN, nwg, G, c; size_t sB; int tb[9]; bool gather;
    int rs; unsigned* ctr; const int* list; int cnt[8];
    __device__ __forceinline__ bool unit_of(long L, Unit& u) const {
        if (L >= nwg) return false;
        tile_of((int)L, nM, nN, u.pm, u.pn);
        int e = 0;
#pragma unroll
        for (int j = 1; j < 8; ++j) e += (u.pm >= tb[j]) ? 1 : 0;
        int base = 0, ce = 0;
#pragma unroll
        for (int j = 0; j < 8; ++j) if (j == e) { base = tb[j]; ce = cnt[j]; }
        const int valid = ce - (u.pm - base) * 256;
        u.e = e | ((valid <= 128) ? (1 << 16) : 0); return true;
    }
    __device__ __forceinline__ bool next(int i, Unit& u) const { return unit_of((long)i * G + c, u); }
    __device__ __forceinline__ const char* a_ptr(const Gemm& g, const Unit& u) const { return (const char*)g.A + (gather ? (size_t)0 : (size_t)u.pm * BM * g.lda * 2); }
    __device__ __forceinline__ const char* b_ptr(const Gemm& g, const Unit& u) const { return (const char*)(g.Bt + (size_t)(u.e & 255) * sB) + (size_t)u.pn * BM * g.ldb * 2; }
    __device__ __forceinline__ bool skip_hi(const Unit& u) const { return (u.e >> 16) != 0; }
    __device__ __forceinline__ int unit_nt(const Gemm& g, const Unit& u) const { (void)u; return g.K / BK; }
    __device__ __forceinline__ int n_static() const { return rs; }
    __device__ __forceinline__ unsigned* dyn_ctr() const { return ctr; }
    __device__ __forceinline__ bool dyn_unit(unsigned j, Unit& u) const { return unit_of((long)rs * G + (long)j, u); }
    __device__ __forceinline__ int gather_tok(const Unit& u, int row) const {
        int base = 0, ce = 0;
        const int ex = u.e & 255;
#pragma unroll
        for (int j = 0; j < 8; ++j) if (j == ex) { base = tb[j]; ce = cnt[j]; }
        const int sidx = (u.pm - base) * 256 + row; return list[ex * 16384 + (sidx < ce ? sidx : 0)];
    }
};
struct MoeDownOrder {
    int nM, G, c, nfull, kq_elems, kq_nt; size_t sB; int tb[9]; int rs; unsigned* ctr; int cnt[8];
    __device__ __forceinline__ bool unit_of(long L, Unit& u) const {
        int kq1 = 0, uu;
        if (L < nfull) uu = (int)L;
        else { const long L2 = L - nfull; if (L2 >= 4l * (8 * nM - nfull)) return false; uu = nfull + (int)(L2 >> 2); kq1 = (int)(L2 & 3) + 1; }
        u.pm = uu >> 3; u.pn = uu & 7;
        int e = 0;
#pragma unroll
        for (int j = 1; j < 8; ++j) e += (u.pm >= tb[j]) ? 1 : 0;
        int base = 0, ce = 0;
#pragma unroll
        for (int j = 0; j < 8; ++j) if (j == e) { base = tb[j]; ce = cnt[j]; }
        const int valid = ce - (u.pm - base) * 256;
        u.e = e | (kq1 << 8) | ((valid <= 128) ? (1 << 16) : 0); return true;
    }
    __device__ __forceinline__ bool next(int i, Unit& u) const { return unit_of((long)i * G + c, u); }
    __device__ __forceinline__ const char* a_ptr(const Gemm& g, const Unit& u) const { const int kq1 = (u.e >> 8) & 15; return (const char*)g.A + ((size_t)u.pm * BM * g.lda + (size_t)(kq1 ? (kq1 - 1) * kq_elems : 0)) * 2; }
    __device__ __forceinline__ const char* b_ptr(const Gemm& g, const Unit& u) const { const int kq1 = (u.e >> 8) & 15; return (const char*)(g.Bt + (size_t)(u.e & 255) * sB) + ((size_t)u.pn * BM * g.ldb + (size_t)(kq1 ? (kq1 - 1) * kq_elems : 0)) * 2; }
    __device__ __forceinline__ int unit_nt(const Gemm& g, const Unit& u) const { return ((u.e >> 8) & 15) ? kq_nt : g.K / BK; }
    __device__ __forceinline__ int n_static() const { return rs; }
    __device__ __forceinline__ unsigned* dyn_ctr() const { return ctr; }
    __device__ __forceinline__ bool dyn_unit(unsigned j, Unit& u) const { return unit_of((long)rs * G + (long)j, u); }
    __device__ __forceinline__ int gather_tok(const Unit&, int) const { return 0; }
    __device__ __forceinline__ bool skip_hi(const Unit&) const { return false; }
};


struct EpiBf16 {
    static constexpr bool PERM = true;
    bf16_t* O; int ldc; size_t estride; int ecol;
    __device__ __forceinline__ void operator()(const f32x4 (&acc)[2][2][4][2], const Unit& u, int wr, int wc, int fr, int fq) const {
        const int row0 = u.pm * BM + wr * 64 + fr; const int col0 = u.pn * BM + wc * 32 + 8 * fq + u.e * ecol;
        bf16_t* base = O + (size_t)u.e * estride;
#pragma unroll
        for (int ai = 0; ai < 2; ++ai)
#pragma unroll
            for (int m = 0; m < 4; ++m) { bf16_t* rowp = base + (size_t)(row0 + ai * HALF + m * 16) * ldc + col0;
#pragma unroll
                for (int bj = 0; bj < 2; ++bj) { const f32x4 v0 = acc[ai][bj][m][0], v1 = acc[ai][bj][m][1];
                    u32x4 w; w.x = cvt_pk_bf16(v0[0], v0[1]); w.y = cvt_pk_bf16(v0[2], v0[3]); w.z = cvt_pk_bf16(v1[0], v1[1]); w.w = cvt_pk_bf16(v1[2], v1[3]);
                    *(u32x4*)(rowp + bj * HALF) = w; } }
    }
};
struct EpiMoeDown {
    static constexpr bool PERM = true;
    bf16_t* YE; bf16_t* YEP; int pm_split; size_t qstride;
    __device__ __forceinline__ void operator()(const f32x4 (&acc)[2][2][4][2], const Unit& u, int wr, int wc, int fr, int fq) const {
        const int kq1 = (u.e >> 8) & 15; const int col0 = u.pn * BM + wc * 32 + 8 * fq;
        bf16_t* base = kq1 ? YEP + (size_t)(kq1 - 1) * qstride + (size_t)((u.pm - pm_split) * BM) * D : YE + (size_t)(u.pm * BM) * D;
        const int row0 = wr * 64 + fr;
#pragma unroll
        for (int ai = 0; ai < 2; ++ai)
#pragma unroll
            for (int m = 0; m < 4; ++m) { bf16_t* rowp = base + (size_t)(row0 + ai * HALF + m * 16) * D + col0;
#pragma unroll
                for (int bj = 0; bj < 2; ++bj) { const f32x4 v0 = acc[ai][bj][m][0], v1 = acc[ai][bj][m][1];
                    u32x4 w; w.x = cvt_pk_bf16(v0[0], v0[1]); w.y = cvt_pk_bf16(v0[2], v0[3]); w.z = cvt_pk_bf16(v1[0], v1[1]); w.w = cvt_pk_bf16(v1[2], v1[3]);
                    *(u32x4*)(rowp + bj * HALF) = w; } }
    }
};
struct EpiF32 {
    static constexpr bool PERM = true;
    float* Y; int ldc;
    __device__ __forceinline__ void operator()(const f32x4 (&acc)[2][2][4][2], const Unit& u, int wr, int wc, int fr, int fq) const {
        const int row0 = u.pm * BM + wr * 64 + fr, col0 = u.pn * BM + wc * 32 + 8 * fq;
#pragma unroll
        for (int ai = 0; ai < 2; ++ai)
#pragma unroll
            for (int m = 0; m < 4; ++m) { float* rowp = Y + (size_t)(row0 + ai * HALF + m * 16) * ldc + col0;
#pragma unroll
                for (int bj = 0; bj < 2; ++bj) { *(f32x4*)(rowp + bj * HALF) = acc[ai][bj][m][0]; *(f32x4*)(rowp + bj * HALF + 4) = acc[ai][bj][m][1]; } }
    }
};
struct EpiQKV {
    static constexpr bool PERM = true;
    bf16_t* O; const float* rope;
    __device__ __forceinline__ void operator()(const f32x4 (&acc)[2][2][4][2], const Unit& u, int wr, int wc, int fr, int fq) const {
        const int gt = u.pn >> 3, t = gt % 3, dsh = 2 * (gt / 3), head = 2 * (u.pn & 7) + (wc >> 1), idx0 = 32 * (wc & 1) + 8 * fq;
        const int row0 = u.pm * BM + wr * 64 + fr; bf16_t* hb = O + ((size_t)(gt * 16 + head) * MTOK) * 128 + idx0;
#pragma unroll
        for (int ai = 0; ai < 2; ++ai)
#pragma unroll
            for (int m = 0; m < 4; ++m) { const int row = row0 + ai * HALF + m * 16; const int sq = row & (SEQ - 1);
                bf16_t* rowp = hb + (size_t)((row & ~(SEQ - 1)) + (sq & ((1 << dsh) - 1)) * (SEQ >> dsh) + (sq >> dsh)) * 128;
                f32x4 l0 = acc[ai][0][m][0], l1 = acc[ai][0][m][1], h0 = acc[ai][1][m][0], h1 = acc[ai][1][m][1];
                if (t < 2) { const float* cp = rope + (size_t)(row & (SEQ - 1)) * 64 + idx0; const float* sp = cp + SEQ * 64;
                    const f32x4 c0 = *(const f32x4*)cp, c1 = *(const f32x4*)(cp + 4), s0 = *(const f32x4*)sp, s1 = *(const f32x4*)(sp + 4);
                    const f32x4 a0 = l0 * c0 - h0 * s0, a1 = l1 * c1 - h1 * s1, b0 = h0 * c0 + l0 * s0, b1 = h1 * c1 + l1 * s1;
                    l0 = a0; l1 = a1; h0 = b0; h1 = b1; }
                u32x4 w; w.x = cvt_pk_bf16(l0[0], l0[1]); w.y = cvt_pk_bf16(l0[2], l0[3]); w.z = cvt_pk_bf16(l1[0], l1[1]); w.w = cvt_pk_bf16(l1[2], l1[3]);
                *(u32x4*)rowp = w;
                w.x = cvt_pk_bf16(h0[0], h0[1]); w.y = cvt_pk_bf16(h0[2], h0[3]); w.z = cvt_pk_bf16(h1[0], h1[1]); w.w = cvt_pk_bf16(h1[2], h1[3]);
                *(u32x4*)(rowp + 64) = w; }
    }
};
struct EpiSwiGLU {
    static constexpr bool PERM = true;
    bf16_t* O; int ldc;
    __device__ __forceinline__ void operator()(const f32x4 (&acc)[2][2][4][2], const Unit& u, int wr, int wc, int fr, int fq) const {
        const int row0 = u.pm * BM + wr * 64 + fr; const int col0 = u.pn * HALF + wc * 32 + 8 * fq;
#pragma unroll
        for (int ai = 0; ai < 2; ++ai)
#pragma unroll
            for (int m = 0; m < 4; ++m) { bf16_t* rowp = O + (size_t)(row0 + ai * HALF + m * 16) * ldc + col0;
                float r[8];
#pragma unroll
                for (int n = 0; n < 2; ++n)
#pragma unroll
                    for (int j = 0; j < 4; ++j) { const float a = acc[ai][0][m][n][j], b = acc[ai][1][m][n][j];
                        const float sg = __builtin_amdgcn_rcpf(1.0f + __builtin_amdgcn_exp2f(-1.4426950408889634f * a)); r[n * 4 + j] = a * sg * b; }
                u32x4 w; w.x = cvt_pk_bf16(r[0], r[1]); w.y = cvt_pk_bf16(r[2], r[3]); w.z = cvt_pk_bf16(r[4], r[5]); w.w = cvt_pk_bf16(r[6], r[7]);
                *(u32x4*)rowp = w; }
    }
};
template <bool F32OUT> struct EpiRes {
    static constexpr bool PERM = true;
    const bf16_t* res; void* Y; int ldc; float alpha;
    __device__ __forceinline__ void operator()(const f32x4 (&acc)[2][2][4][2], const Unit& u, int wr, int wc, int fr, int fq) const {
        const int row0 = u.pm * BM + wr * 64 + fr, col0 = u.pn * BM + wc * 32 + 8 * fq;
#pragma unroll
        for (int ai = 0; ai < 2; ++ai)
#pragma unroll
            for (int m = 0; m < 4; ++m) { const size_t off = (size_t)(row0 + ai * HALF + m * 16) * ldc + col0;
#pragma unroll
                for (int bj = 0; bj < 2; ++bj) { const u32x4 rw = *(const u32x4*)(res + off + bj * HALF);
                    f32x4 v0 = acc[ai][bj][m][0], v1 = acc[ai][bj][m][1];
                    v0[0] += alpha * bf_lo(rw.x); v0[1] += alpha * bf_hi(rw.x); v0[2] += alpha * bf_lo(rw.y); v0[3] += alpha * bf_hi(rw.y);
                    v1[0] += alpha * bf_lo(rw.z); v1[1] += alpha * bf_hi(rw.z); v1[2] += alpha * bf_lo(rw.w); v1[3] += alpha * bf_hi(rw.w);
                    if constexpr (F32OUT) { float* yp = (float*)Y + off + bj * HALF; *(f32x4*)yp = v0; *(f32x4*)(yp + 4) = v1; }
                    else { u32x4 w; w.x = cvt_pk_bf16(v0[0], v0[1]); w.y = cvt_pk_bf16(v0[2], v0[3]); w.z = cvt_pk_bf16(v1[0], v1[1]); w.w = cvt_pk_bf16(v1[2], v1[3]); *(u32x4*)((bf16_t*)Y + off + bj * HALF) = w; } }
                if (m == 3) asm volatile("" ::: "memory"); }
    }
};
struct EpiPle {
    static constexpr bool PERM = true;
    const bf16_t* x; const bf16_t* pp; const float* bias; float* outF; bf16_t* outB; int ldc;
    __device__ __forceinline__ void operator()(const f32x4 (&acc)[2][2][4][2], const Unit& u, int wr, int wc, int fr, int fq) const {
        const int row0 = u.pm * BM + wr * 64 + fr, col0 = u.pn * BM + wc * 32 + 8 * fq;
        f32x4 bv[2][2];
#pragma unroll
        for (int bj = 0; bj < 2; ++bj)
#pragma unroll
            for (int n = 0; n < 2; ++n) bv[bj][n] = *(const f32x4*)(bias + col0 + bj * HALF + 4 * n);
#pragma unroll
        for (int ai = 0; ai < 2; ++ai)
#pragma unroll
            for (int m = 0; m < 4; ++m) { const size_t off = (size_t)(row0 + ai * HALF + m * 16) * ldc + col0;
#pragma unroll
                for (int bj = 0; bj < 2; ++bj) { const size_t o2 = off + bj * HALF;
                    const u32x4 xw = *(const u32x4*)(x + o2), pw = *(const u32x4*)(pp + o2);
                    float o[8];
#pragma unroll
                    for (int e = 0; e < 4; ++e) { const int n = e >> 1, j = (e & 1) * 2;
                        const float v0 = acc[ai][bj][m][n][j] + bv[bj][n][j], v1 = acc[ai][bj][m][n][j + 1] + bv[bj][n][j + 1];
                        o[2 * e] = bf_lo(xw[e]) + bf_lo(pw[e]) * __builtin_amdgcn_rcpf(1.0f + __builtin_amdgcn_exp2f(-1.4426950408889634f * v0));
                        o[2 * e + 1] = bf_hi(xw[e]) + bf_hi(pw[e]) * __builtin_amdgcn_rcpf(1.0f + __builtin_amdgcn_exp2f(-1.4426950408889634f * v1)); }
                    if (outF) { float* yp = outF + o2; *(f32x4*)yp = (f32x4){o[0], o[1], o[2], o[3]}; *(f32x4*)(yp + 4) = (f32x4){o[4], o[5], o[6], o[7]}; }
                    else { u32x4 w; w.x = cvt_pk_bf16(o[0], o[1]); w.y = cvt_pk_bf16(o[2], o[3]); w.z = cvt_pk_bf16(o[4], o[5]); w.w = cvt_pk_bf16(o[6], o[7]); *(u32x4*)(outB + o2) = w; } }
                if (m & 1) asm volatile("" ::: "memory"); }
    }
};

constexpr int DYN_LDS_OFF = 131072 + 512;
constexpr int IDX_LDS_OFF = 131072 + 1024;
template <class Epi, class Sched, bool ALIGN_EPI = true, bool SP2 = true, bool STAMP = false, bool GATHER = false>
__device__ __forceinline__ void gemm_phase(PG8_LAS unsigned char* lds, const Gemm g, const Sched& S, const Epi& E, unsigned long long* stp = nullptr) {
    const int tid = threadIdx.x, wid = __builtin_amdgcn_readfirstlane(tid >> 6), lane = tid & 63, wr = wid >> 2, wc = wid & 3, fr = lane & 15, fq = lane >> 4;
    unsigned voffA[2], voffB[2]; int gR[2], gC[2];
#pragma unroll
    for (int i = 0; i < 2; ++i) { int R, C; stage_rc(tid * 16 + i * 8192, R, C); const int Rb = Epi::PERM ? ((R & ~31) + perm32(R & 31)) : R; gR[i] = R; gC[i] = C;
        voffA[i] = (unsigned)(R * g.lda + C) * 2u; voffB[i] = (unsigned)(Rb * g.ldb + C) * 2u; }
    const size_t kstep = (size_t)(BK * 2);
    const size_t hstepA = (size_t)HALF * g.lda * 2, hstepB = (size_t)HALF * g.ldb * 2;
    const PG8_LAS unsigned short* gidx = (const PG8_LAS unsigned short*)(lds + IDX_LDS_OFF);
    unsigned cvo[2][2], nvo[2][2];
#define PG8_GOFF(dst, ui_) do { _Pragma("unroll") for (int _h = 0; _h < 2; ++_h) _Pragma("unroll") for (int _i = 0; _i < 2; ++_i) \
        dst[_h][_i] = GATHER ? ((unsigned)gidx[((ui_) % 30) * 256 + _h * HALF + gR[_i]] * (unsigned)(g.lda * 2) + (unsigned)(gC[_i] * 2)) : (voffA[_i] + (unsigned)(_h * hstepA)); } while (0)
    PG8_GOFF(cvo, 0);
#pragma unroll
    for (int _h = 0; _h < 2; ++_h)
#pragma unroll
        for (int _i = 0; _i < 2; ++_i) nvo[_h][_i] = cvo[_h][_i];
    const unsigned ldsw = (unsigned)wid * 1024u;
    const int aoff = lds_byte(wr * 64 + fr, fq * 8), boff = lds_byte(wc * 32 + fr, fq * 8);
#define PG8_SA(b, h) (((b) * 2 + (h)) * HTB)
#define PG8_SB(b, h) ((4 + (b) * 2 + (h)) * HTB)
#define PG8_STAGE(bufoff, gbase, voff) do { _Pragma("unroll") for (int _i = 0; _i < 2; ++_i) \
        __builtin_amdgcn_global_load_lds((const unsigned*)((const char*)(gbase) + (voff)[_i]), (PG8_LAS unsigned*)(lds + (bufoff) + ldsw + _i * 8192), 16, 0, 0); } while (0)
#define PG8_LDA(dst, b, h) do { _Pragma("unroll") for (int m = 0; m < 4; ++m) _Pragma("unroll") for (int k = 0; k < 2; ++k) dst[m][k] = *(const PG8_LAS bf16x8*)(lds + PG8_SA(b, h) + aoff + m * 2048 + k * 1024); } while (0)
#define PG8_LDB(dst, b, h) do { _Pragma("unroll") for (int n = 0; n < 2; ++n) _Pragma("unroll") for (int k = 0; k < 2; ++k) dst[n][k] = *(const PG8_LAS bf16x8*)(lds + PG8_SB(b, h) + boff + n * 2048 + k * 1024); } while (0)
#define PG8_MMA(ai, bj, At, Bt) do { __builtin_amdgcn_s_setprio(1); _Pragma("unroll") for (int m = 0; m < 4; ++m) _Pragma("unroll") for (int n = 0; n < 2; ++n) _Pragma("unroll") for (int k = 0; k < 2; ++k) \
        acc[ai][bj][m][n] = __builtin_amdgcn_mfma_f32_16x16x32_bf16(Bt[n][k], At[m][k], acc[ai][bj][m][n], 0, 0, 0); __builtin_amdgcn_s_setprio(0); } while (0)
#define PG8_WAIT_V(n) asm volatile("s_waitcnt vmcnt(" #n ")" ::: "memory")
#define PG8_WAIT_L(n) asm volatile("s_waitcnt lgkmcnt(" #n ")" ::: "memory")
#define PG8_BAR __builtin_amdgcn_s_barrier()
#define PG8_SCHED __builtin_amdgcn_sched_barrier(0)
    Unit cur, nxt; int ui = 0;
    if (!S.next(0, cur)) return;
    long long st_c0 = 0, st_w0 = 0, st_k = 0, st_e = 0, st_t = 0; if (STAMP) { st_c0 = clock64(); st_w0 = wall_clock64(); }
    f32x4 acc[2][2][4][2];
#pragma unroll
    for (int a = 0; a < 2; ++a)
#pragma unroll
        for (int b = 0; b < 2; ++b)
#pragma unroll
            for (int m = 0; m < 4; ++m)
#pragma unroll
                for (int n = 0; n < 2; ++n) acc[a][b][m][n] = (f32x4){0.f, 0.f, 0.f, 0.f};
    bf16x8 At[4][2], B0[2][2], B1[2][2];
    const char* cA = S.a_ptr(g, cur); const char* cB = S.b_ptr(g, cur);
    if constexpr (SP2) {
        PG8_STAGE(PG8_SB(0, 0), cB, voffB); PG8_STAGE(PG8_SB(0, 1), cB + hstepB, voffB); PG8_STAGE(PG8_SA(0, 0), cA, cvo[0]); PG8_STAGE(PG8_SA(0, 1), cA, cvo[1]);
        if (wr == 1) PG8_BAR;
        PG8_WAIT_V(2); PG8_BAR;
        PG8_STAGE(PG8_SB(1, 0), cB + kstep, voffB); PG8_STAGE(PG8_SA(1, 0), cA + kstep, cvo[0]); PG8_STAGE(PG8_SB(1, 1), cB + hstepB + kstep, voffB);
        PG8_WAIT_V(6); PG8_BAR;
    } else {
        PG8_STAGE(PG8_SB(0, 0), cB, voffB); PG8_STAGE(PG8_SA(0, 0), cA, cvo[0]); PG8_STAGE(PG8_SB(0, 1), cB + hstepB, voffB); PG8_STAGE(PG8_SA(0, 1), cA, cvo[1]);
        if (wr == 1) PG8_BAR;
        PG8_WAIT_V(4); PG8_BAR;
        PG8_STAGE(PG8_SB(1, 0), cB + kstep, voffB); PG8_STAGE(PG8_SA(1, 0), cA + kstep, cvo[0]); PG8_STAGE(PG8_SB(1, 1), cB + hstepB + kstep, voffB);
        PG8_WAIT_V(6); PG8_BAR;
    }
    for (;;) {
        bool has_next;
        if (ui + 1 < S.n_static()) has_next = S.next(ui + 1, nxt);
        else if (S.dyn_ctr() != nullptr) {
            volatile PG8_LAS unsigned* dw = (volatile PG8_LAS unsigned*)(lds + DYN_LDS_OFF);
            if (wid == 0) { unsigned j = 0u; if (lane == 0) j = __hip_atomic_fetch_add(S.dyn_ctr(), 1u, __ATOMIC_RELAXED, __HIP_MEMORY_SCOPE_AGENT);
                j = (unsigned)__builtin_amdgcn_readfirstlane((int)j); if (lane == 0) dw[0] = j; asm volatile("s_waitcnt lgkmcnt(0)" ::: "memory"); }
            asm volatile("" ::: "memory"); PG8_BAR; asm volatile("" ::: "memory");
            const unsigned j = (unsigned)__builtin_amdgcn_readfirstlane((int)dw[0]);
            has_next = S.dyn_unit(j, nxt);
            if (GATHER && has_next) {
                PG8_LAS unsigned short* gw16 = (PG8_LAS unsigned short*)(lds + IDX_LDS_OFF);
                if (tid < 256) gw16[((ui + 1) % 30) * 256 + tid] = (unsigned short)S.gather_tok(nxt, tid);
                asm volatile("s_waitcnt vmcnt(0) lgkmcnt(0)" ::: "memory"); PG8_BAR; asm volatile("" ::: "memory");
            }
        } else has_next = false;
        const char* nA = has_next ? S.a_ptr(g, nxt) : cA; const char* nB = has_next ? S.b_ptr(g, nxt) : cB;
        const int nt = S.unit_nt(g, cur);
        const bool skip_hi = S.skip_hi(cur);
        if (GATHER && has_next) PG8_GOFF(nvo, ui + 1);
        if (STAMP) st_t = clock64();
        for (int t = 0; t < nt; t += 2) {
            const bool last = (t == nt - 2);
            const char* a1 = cA + (size_t)(t + 1) * kstep;
            const char* a2 = last ? nA : cA + (size_t)(t + 2) * kstep; const char* b2 = last ? nB : cB + (size_t)(t + 2) * kstep;
            const char* a3 = a2 + kstep; const char* b3 = b2 + kstep;
            unsigned xvo[2][2];
#pragma unroll
            for (int _h = 0; _h < 2; ++_h)
#pragma unroll
                for (int _i = 0; _i < 2; ++_i) xvo[_h][_i] = (GATHER && last) ? nvo[_h][_i] : cvo[_h][_i];
            if constexpr (SP2) {
            PG8_LDB(B0, 0, 0); PG8_LDB(B1, 0, 1); PG8_SCHED; PG8_LDA(At, 0, 0); PG8_STAGE(PG8_SA(1, 1), a1, cvo[1]);
            PG8_WAIT_V(8); PG8_WAIT_L(0); PG8_BAR; PG8_MMA(0, 0, At, B0); PG8_MMA(0, 1, At, B1); PG8_BAR; PG8_SCHED;
            if (!skip_hi) PG8_LDA(At, 0, 1); PG8_STAGE(PG8_SB(0, 0), b2, voffB); PG8_STAGE(PG8_SB(0, 1), b2 + hstepB, voffB); PG8_STAGE(PG8_SA(0, 0), a2, xvo[0]);
            PG8_WAIT_V(8); PG8_WAIT_L(0); PG8_BAR; if (!skip_hi) { PG8_MMA(1, 0, At, B0); PG8_MMA(1, 1, At, B1); } PG8_BAR; PG8_SCHED;
            PG8_LDB(B0, 1, 0); PG8_LDB(B1, 1, 1); PG8_SCHED; PG8_LDA(At, 1, 0); PG8_STAGE(PG8_SA(0, 1), a2, xvo[1]);
            PG8_WAIT_V(8); PG8_WAIT_L(0); PG8_BAR; PG8_MMA(0, 0, At, B0); PG8_MMA(0, 1, At, B1); PG8_BAR; PG8_SCHED;
            if (!skip_hi) PG8_LDA(At, 1, 1); PG8_STAGE(PG8_SB(1, 0), b3, voffB); PG8_STAGE(PG8_SB(1, 1), b3 + hstepB, voffB); PG8_STAGE(PG8_SA(1, 0), a3, xvo[0]);
            PG8_WAIT_V(8); PG8_WAIT_L(0); PG8_BAR; if (!skip_hi) { PG8_MMA(1, 0, At, B0); PG8_MMA(1, 1, At, B1); } PG8_BAR; PG8_SCHED;
            } else {
            PG8_LDB(B0, 0, 0); PG8_SCHED; PG8_LDA(At, 0, 0); PG8_STAGE(PG8_SA(1, 1), a1, cvo[1]);
            PG8_WAIT_L(8); PG8_BAR; PG8_WAIT_L(0); PG8_MMA(0, 0, At, B0); PG8_BAR; PG8_SCHED;
            PG8_LDB(B1, 0, 1); PG8_STAGE(PG8_SB(0, 0), b2, voffB);
            PG8_BAR; PG8_WAIT_L(0); PG8_MMA(0, 1, At, B1); PG8_BAR;
            PG8_LDA(At, 0, 1); PG8_STAGE(PG8_SA(0, 0), a2, xvo[0]);
            PG8_BAR; PG8_WAIT_L(0); PG8_MMA(1, 0, At, B0); PG8_BAR; PG8_SCHED;
            PG8_STAGE(PG8_SB(0, 1), b2 + hstepB, voffB);
            PG8_WAIT_V(6); PG8_BAR; PG8_MMA(1, 1, At, B1); PG8_BAR;
            PG8_LDB(B0, 1, 0); PG8_SCHED; PG8_LDA(At, 1, 0); PG8_STAGE(PG8_SA(0, 1), a2, xvo[1]);
            PG8_WAIT_L(8); PG8_BAR; PG8_WAIT_L(0); PG8_MMA(0, 0, At, B0); PG8_BAR; PG8_SCHED;
            PG8_LDB(B1, 1, 1); PG8_STAGE(PG8_SB(1, 0), b3, voffB);
            PG8_BAR; PG8_WAIT_L(0); PG8_MMA(0, 1, At, B1); PG8_BAR;
            PG8_LDA(At, 1, 1); PG8_STAGE(PG8_SA(1, 0), a3, xvo[0]);
            PG8_BAR; PG8_WAIT_L(0); PG8_MMA(1, 0, At, B0); PG8_BAR; PG8_SCHED;
            PG8_STAGE(PG8_SB(1, 1), b3 + hstepB, voffB);
            PG8_WAIT_V(6); PG8_BAR; PG8_MMA(1, 1, At, B1); PG8_BAR;
            }
        }
        if (STAMP) { const long long c = clock64(); st_k += c - st_t; st_t = c; }
        if constexpr (ALIGN_EPI) { if (wr == 0) PG8_BAR; }
        E(acc, cur, wr, wc, fr, fq);
        if (STAMP) { const long long c = clock64(); st_e += c - st_t; }
        if (!has_next) break;
#pragma unroll
        for (int a = 0; a < 2; ++a)
#pragma unroll
            for (int b = 0; b < 2; ++b)
#pragma unroll
                for (int m = 0; m < 4; ++m)
#pragma unroll
                    for (int n = 0; n < 2; ++n) acc[a][b][m][n] = (f32x4){0.f, 0.f, 0.f, 0.f};
        cur = nxt; cA = nA; cB = nB; ++ui;
        if (GATHER) {
#pragma unroll
            for (int _h = 0; _h < 2; ++_h)
#pragma unroll
                for (int _i = 0; _i < 2; ++_i) cvo[_h][_i] = nvo[_h][_i]; }
        if constexpr (ALIGN_EPI) { if (wr == 1) PG8_BAR; }
    }
    PG8_WAIT_V(0);
    if constexpr (!ALIGN_EPI) { if (wr == 0) PG8_BAR; }
    PG8_BAR;
    if (STAMP) { if (blockIdx.x == 0 && tid == 0) { const long long c1 = clock64(), w1 = wall_clock64(); stp[0] = (unsigned long long)((c1 - st_c0) * 100 / (w1 - st_w0)); stp[1] = (unsigned long long)(st_k / ((ui + 1) * (g.K / BK))); stp[2] = (unsigned long long)(st_e / (10 * (ui + 1))); } }
#undef PG8_GOFF
#undef PG8_SA
#undef PG8_SB
#undef PG8_STAGE
#undef PG8_LDA
#undef PG8_LDB
#undef PG8_MMA
#undef PG8_WAIT_V
#undef PG8_WAIT_L
#undef PG8_BAR
#undef PG8_SCHED
}
}

#define XB_TMO      128
#define XB_XCNT(j)  (256  + 64 * (j))
#define XB_XSUB(j)  (1280 + 64 * (j))
#define XB_XGEN(j)  (2304 + 64 * (j))
#define XB_TOP      3328
#define XB_TOPGEN   3392
#define XCD_BAR_WORDS 3456
#define XB_SPIN_CAP (1u << 18)

__device__ __forceinline__ unsigned xb_ld(unsigned* p)              { return __hip_atomic_load(p, __ATOMIC_RELAXED, __HIP_MEMORY_SCOPE_AGENT); }
__device__ __forceinline__ unsigned xb_add(unsigned* p, unsigned v) { return __hip_atomic_fetch_add(p, v, __ATOMIC_RELAXED, __HIP_MEMORY_SCOPE_AGENT); }
__device__ __forceinline__ unsigned xb_xcc_id() { return (unsigned)__builtin_amdgcn_s_getreg((3 << 11) | 20) & 0xFu; }
#define XB_SPIN(cond, bar) do { unsigned _sp = 0; while (cond) { __builtin_amdgcn_s_sleep(1); \
    if ((++_sp & 255u) == 0u) { if (xb_ld(&(bar)[XB_TMO])) break; if (_sp > XB_SPIN_CAP) { atomicAdd(&(bar)[XB_TMO], 1u); break; } } } } while (0)

struct XcdBarrier { unsigned* bar; unsigned x; volatile LAS unsigned* st; };

__device__ __forceinline__ XcdBarrier xcd_barrier_post(unsigned* bar, volatile LAS unsigned* st) {
    XcdBarrier b; b.bar = bar; b.x = xb_xcc_id(); b.st = st;
    if (threadIdx.x == 0) (void)xb_add(&bar[XB_XCNT(b.x)], 1u);
    return b;
}
__device__ __forceinline__ void xcd_barrier_complete(unsigned* bar, unsigned x, unsigned& nloc, unsigned& nx) {
    const unsigned G = gridDim.x * gridDim.y * gridDim.z;
    unsigned sum, cnt, mine, sp = 0u;
    for (;;) {
        sum = 0u; cnt = 0u; mine = 0u;
#pragma unroll
        for (unsigned j = 0; j < 16; ++j) { const unsigned c = xb_ld(&bar[XB_XCNT(j)]); sum += c; cnt += (c > 0u) ? 1u : 0u; mine = (j == x) ? c : mine; }
        if (sum == G) break;
        __builtin_amdgcn_s_sleep(1);
        if ((++sp & 255u) == 0u) { if (xb_ld(&bar[XB_TMO])) break; if (sp > XB_SPIN_CAP) { atomicAdd(&bar[XB_TMO], 1u); break; } }
    }
    nloc = mine > 0u ? mine : 1u; nx = cnt > 0u ? cnt : 1u;
}
__device__ __forceinline__ void xcd_barrier(const XcdBarrier& b) {
    asm volatile("s_waitcnt vmcnt(0)" ::: "memory");
    __syncthreads();
    if (threadIdx.x == 0) {
        unsigned* bar = b.bar;
        __builtin_amdgcn_s_waitcnt(0);
        unsigned nloc = b.st[0], nx = b.st[1];
        if (nloc == 0u) { xcd_barrier_complete(bar, b.x, nloc, nx); b.st[0] = nloc; b.st[1] = nx; }
        const unsigned old = xb_add(&bar[XB_XSUB(b.x)], 1u);
        const unsigned gen = old / nloc;
        if (old + 1u == (gen + 1u) * nloc) {
            __builtin_amdgcn_fence(__ATOMIC_RELEASE, "agent");
            asm volatile("s_waitcnt vmcnt(0)" ::: "memory");
            const unsigned og = xb_add(&bar[XB_TOP], 1u);
            const unsigned tg = og / nx;
            if (og + 1u == (tg + 1u) * nx) xb_add(&bar[XB_TOPGEN], 1u);
            else XB_SPIN(xb_ld(&bar[XB_TOPGEN]) == tg, bar);
            __builtin_amdgcn_fence(__ATOMIC_ACQUIRE, "agent");
            xb_add(&bar[XB_XGEN(b.x)], 1u);
            asm volatile("s_waitcnt vmcnt(0)" ::: "memory");
        } else {
            XB_SPIN(xb_ld(&bar[XB_XGEN(b.x)]) == gen, bar);
            __builtin_amdgcn_fence(__ATOMIC_ACQUIRE, "agent");
            asm volatile("s_waitcnt vmcnt(0)" ::: "memory");
        }
    }
    __syncthreads();
}

struct Frame {
    LAS unsigned char* lds;
    int tid, lane, wave, vcu, G;
    unsigned char* ws;
};
struct Args { const float* in[22]; float* out; unsigned char* ws; int ph_lo, ph_hi; };

__device__ __forceinline__ void cvt_tile(const float* W, size_t ldw, int k0, int n0, bf16* WT, size_t ldt, int dst_row0, int lane) {
    const int kb = lane >> 3, nb = lane & 7;
    const float* src = W + (size_t)(k0 + 8 * kb) * ldw + n0 + 4 * nb;
    f32x4 v[8];
#pragma unroll
    for (int j = 0; j < 8; ++j) v[j] = *(const f32x4*)(src + (size_t)j * ldw);
#pragma unroll
    for (int jn = 0; jn < 4; ++jn) { u32x4 o; o.x = cvt_pk_bf16(v[0][jn], v[1][jn]); o.y = cvt_pk_bf16(v[2][jn], v[3][jn]); o.z = cvt_pk_bf16(v[4][jn], v[5][jn]); o.w = cvt_pk_bf16(v[6][jn], v[7][jn]);
        *(u32x4*)(WT + (size_t)(dst_row0 + 4 * nb + jn) * ldt + k0 + 8 * kb) = o; }
}
struct MapId { __device__ __forceinline__ int operator()(int n) const { return n; } };
struct MapQKV { __device__ __forceinline__ int operator()(int n) const { const int gt = n >> 11, head = (n >> 7) & 15, d = n & 127; return (gt * 8 + (head >> 1)) * 256 + 128 * (d >> 6) + 64 * (head & 1) + (d & 63); } };
struct MapGU { int which; __device__ __forceinline__ int operator()(int n) const { return 256 * (n >> 7) + 128 * which + (n & 127); } };
template <class Map> __device__ __forceinline__ void cvt_matrix(const float* W, int K, int N, bf16* WT, size_t ldt, Map map, int& it0, int gw, int NGW, int lane) {
    const int nblk = N / 32, items = (K / 64) * nblk;
    int it = gw - it0; if (it < 0) it += ((-it + NGW - 1) / NGW) * NGW;
    for (; it < items; it += 2 * NGW) { const int it2 = it + NGW; const bool two = it2 < items;
        const int kb = it / nblk, nb = it - kb * nblk, kb2 = two ? it2 / nblk : kb, nb2 = two ? it2 - kb2 * nblk : nb;
        const int q8 = lane >> 3, n8 = lane & 7;
        const float* sa = W + (size_t)(64 * kb + 8 * q8) * N + 32 * nb + 4 * n8; const float* sb = W + (size_t)(64 * kb2 + 8 * q8) * N + 32 * nb2 + 4 * n8;
        f32x4 va[8], vb[8];
#pragma unroll
        for (int j = 0; j < 8; ++j) va[j] = *(const f32x4*)(sa + (size_t)j * N);
#pragma unroll
        for (int j = 0; j < 8; ++j) vb[j] = *(const f32x4*)(sb + (size_t)j * N);
        const int da = map(32 * nb), db = map(32 * nb2);
#pragma unroll
        for (int jn = 0; jn < 4; ++jn) { u32x4 o; o.x = cvt_pk_bf16(va[0][jn], va[1][jn]); o.y = cvt_pk_bf16(va[2][jn], va[3][jn]); o.z = cvt_pk_bf16(va[4][jn], va[5][jn]); o.w = cvt_pk_bf16(va[6][jn], va[7][jn]);
            *(u32x4*)(WT + (size_t)(da + 4 * n8 + jn) * ldt + 64 * kb + 8 * q8) = o; }
        if (two) {
#pragma unroll
            for (int jn = 0; jn < 4; ++jn) { u32x4 o; o.x = cvt_pk_bf16(vb[0][jn], vb[1][jn]); o.y = cvt_pk_bf16(vb[2][jn], vb[3][jn]); o.z = cvt_pk_bf16(vb[4][jn], vb[5][jn]); o.w = cvt_pk_bf16(vb[6][jn], vb[7][jn]);
                *(u32x4*)(WT + (size_t)(db + 4 * n8 + jn) * ldt + 64 * kb2 + 8 * q8) = o; } }
    }
    it0 = (it0 + items) % NGW;
}
__device__ __forceinline__ void cvt_flat(const float* s, bf16* d, size_t n, int gw, int NGW, int lane) {
    for (size_t i = ((size_t)gw * 64 + lane) * 8; i < n; i += (size_t)NGW * 64 * 8) { const f32x4 a = *(const f32x4*)(s + i), b = *(const f32x4*)(s + i + 4);
        u32x4 o; o.x = cvt_pk_bf16(a[0], a[1]); o.y = cvt_pk_bf16(a[2], a[3]); o.z = cvt_pk_bf16(b[0], b[1]); o.w = cvt_pk_bf16(b[2], b[3]); *(u32x4*)(d + i) = o; }
}

__device__ __forceinline__ void p0_prologue(Frame& F, const Args& a) {
    const int gw = F.vcu * 8 + F.wave, NGW = F.G * 8, lane = F.lane; unsigned char* ws = F.ws; int it0 = 0;
    cvt_matrix(a.in[2], D, NQKV, (bf16*)(ws + WS_WQKV), D, MapQKV{}, it0, gw, NGW, lane);
    cvt_matrix(a.in[3], D, D, (bf16*)(ws + WS_WO), D, MapId{}, it0, gw, NGW, lane);
    cvt_matrix(a.in[12], D, FF, (bf16*)(ws + WS_W13), D, MapGU{0}, it0, gw, NGW, lane);
    cvt_matrix(a.in[13], D, FF, (bf16*)(ws + WS_W13), D, MapGU{1}, it0, gw, NGW, lane);
    cvt_matrix(a.in[14], FF, D, (bf16*)(ws + WS_W2), FF, MapId{}, it0, gw, NGW, lane);
    cvt_matrix(a.in[20], D, D, (bf16*)(ws + WS_WGATE), D, MapId{}, it0, gw, NGW, lane);
    cvt_matrix(a.in[20] + (size_t)D * D, D, D, (bf16*)(ws + WS_WGATE) + (size_t)D * D, D, MapId{}, it0, gw, NGW, lane);
    cvt_matrix(a.in[19], PLE, D, (bf16*)(ws + WS_WPROJ), PLE, MapId{}, it0, gw, NGW, lane);
    cvt_matrix(a.in[19] + (size_t)PLE * D, PLE, D, (bf16*)(ws + WS_WPROJ) + (size_t)D * PLE, PLE, MapId{}, it0, gw, NGW, lane);
    cvt_matrix(a.in[4], D, D, (bf16*)(ws + WS_WIN), D, MapId{}, it0, gw, NGW, lane);
    cvt_matrix(a.in[7], D, D, (bf16*)(ws + WS_WO2), D, MapId{}, it0, gw, NGW, lane);
    { const float* wg = a.in[5]; const float* sc = a.in[6]; bf16* o = (bf16*)(ws + WS_WGS);
      for (size_t i = ((size_t)gw * 64 + lane) * 8; i < (size_t)4 * 512 * 512; i += (size_t)NGW * 64 * 8) { const int g = (int)(i >> 18), d = (int)(i & 511);
          const f32x4 x0 = *(const f32x4*)(wg + i), x1 = *(const f32x4*)(wg + i + 4), s0 = *(const f32x4*)(sc + g * 512 + d), s1 = *(const f32x4*)(sc + g * 512 + d + 4);
          const f32x4 y0 = x0 * s0, y1 = x1 * s1; u32x4 w; w.x = cvt_pk_bf16(y0[0], y0[1]); w.y = cvt_pk_bf16(y0[2], y0[3]); w.z = cvt_pk_bf16(y1[0], y1[1]); w.w = cvt_pk_bf16(y1[2], y1[3]); *(u32x4*)(o + i) = w; } }
    cvt_flat(a.in[0], (bf16*)(ws + WS_XB0), (size_t)MTOK * D, gw, NGW, lane);
    cvt_flat(a.in[1], (bf16*)(ws + WS_PB), (size_t)2 * MTOK * PLE, gw, NGW, lane);
    { float* ct = (float*)(ws + WS_ROPE); float* st = ct + SEQ * 64;
      for (int i = gw * 64 + lane; i < SEQ * 64; i += NGW * 64) { const int pos = i >> 6, j = i & 63;
          const double inv = exp2(-(double)j * (13.287712379549449 / 64.0));
          const double ang = (double)pos * inv; ct[i] = (float)cos(ang); st[i] = (float)sin(ang); } }
}

__device__ __forceinline__ void attn_load_block(const bf16* hp, int blk, LAS unsigned char* slot, bool isV, int w, int lane) {
#pragma unroll
    for (int i = 0; i < 4; ++i) {
        const int idx = i * 8 + w, row = idx * 4 + (lane >> 4), cs = lane & 15;
        const int c = cs ^ (isV ? (((row & 3) << 2) | ((row >> 2) & 3)) : (row & 7));
        const bf16* rp = hp + (size_t)(128 * blk + row) * 128 + c * 8;
        __builtin_amdgcn_global_load_lds((const unsigned*)rp, (LAS unsigned*)(slot + idx * 1024), 16, 0, 0);
    }
}
__device__ __forceinline__ void attn_phase(Frame& F) {
    const bf16* QKV = (const bf16*)(F.ws + WS_QKV); bf16* OG = (bf16*)(F.ws + WS_OG); float* LSE = (float*)(F.ws + WS_LSE);
    LAS unsigned char* Kl = F.lds; LAS unsigned char* Vl = F.lds + 98304;
    volatile LAS unsigned* MISCw = (volatile LAS unsigned*)(F.lds + MISC_OFF);
    const unsigned keep0 = MISCw[8], keep1 = MISCw[9];
    const int w = F.wave, lane = F.lane, q16 = lane & 15, g4 = lane >> 4, sw = ((g4 & 1) << 1) | (g4 >> 1);
    const int pi16 = (q16 & 3) | ((q16 & 4) << 1) | ((q16 & 8) >> 1);
    const int qq = q16 >> 2, pp = q16 & 3;
    bf16x8 bqn[4];
#pragma unroll
    for (int ks = 0; ks < 4; ++ks) bqn[ks] = (bf16x8){0, 0, 0, 0, 0, 0, 0, 0};
    __syncthreads();
    for (int i = F.tid; i < LDS_BYTES / 16; i += 512) *(LAS u32x4*)(F.lds + i * 16) = (u32x4){0u, 0u, 0u, 0u};
    for (int p = F.vcu; p < 768; p += F.G) {
        const int b = 3 - p / 192, pr = p % 192, g = pr >> 6, h = (pr & 63) >> 2, qs = pr & 3;
        const int dsh = 2 * g, dil = 1 << dsh, nb = 32 >> dsh;
        const bf16* planeQ = QKV + ((size_t)((g * 3 + 0) * 16 + h) * MTOK) * 128; const bf16* planeK = planeQ + (size_t)16 * MTOK * 128; const bf16* planeV = planeK + (size_t)16 * MTOK * 128;
        for (int u = 0; u < 8; ++u) {
            int r, n;
            if (g == 0) { r = 0; n = qs * 8 + u; } else if (g == 1) { r = qs; n = u; } else { r = qs * 4 + (u >> 1); n = u & 1; }
            const bool first = (u == 0) || (n == 0), cont = (u < 7) && (n + 1 < nb);
            const size_t tok0 = (size_t)b * SEQ + r; const size_t crow = (size_t)b * SEQ + (size_t)r * (SEQ >> dsh);
            const bf16* hQ = planeQ + crow * 128; const bf16* hK = planeK + crow * 128; const bf16* hV = planeV + crow * 128;
            const int par = n & 1, k3 = n % 3, kp3 = (n + 2) % 3, kn3 = (n + 1) % 3;
            const size_t qtok = tok0 + (size_t)(128 * n + 16 * w + q16) * dil;
            bf16x8 bq[4];
            if (first) {
                __syncthreads();
                attn_load_block(hK, n, Kl + k3 * 32768, false, w, lane);
                attn_load_block(hV, n, Vl + par * 32768, true, w, lane);
                if (n > 0) { attn_load_block(hK, n - 1, Kl + kp3 * 32768, false, w, lane);
                             attn_load_block(hV, n - 1, Vl + (par ^ 1) * 32768, true, w, lane); }
#pragma unroll
                for (int ks = 0; ks < 4; ++ks) bq[ks] = *(const bf16x8*)(hQ + (size_t)(128 * n + 16 * w + q16) * 128 + 32 * ks + 8 * g4);
            } else {
#pragma unroll
                for (int ks = 0; ks < 4; ++ks) bq[ks] = bqn[ks];
            }
            if (first) asm volatile("s_waitcnt vmcnt(0)" ::: "memory"); else asm volatile("s_waitcnt vmcnt(4)" ::: "memory");
            __syncthreads();
            if (!first) attn_load_block(hV, n, Vl + par * 32768, true, w, lane);
            if (cont) attn_load_block(hK, n + 1, Kl + kn3 * 32768, false, w, lane);
            f32x4 s[9];
            {
                bf16x8 ka[2][4];
#define ATT_LDK(buf, ti_) do { const int _kt = w + (ti_); const int _row = ((_kt >> 3) ? k3 : kp3) * 128 + (_kt & 7) * 16 + pi16; \
                    _Pragma("unroll") for (int _ks = 0; _ks < 4; ++_ks) ka[buf][_ks] = *(const LAS bf16x8*)(Kl + _row * 256 + (((4 * _ks + g4) ^ (_row & 7)) << 4)); } while (0)
                ATT_LDK(0, 0);
#pragma unroll
                for (int ti = 0; ti < 9; ++ti) {
                    if (ti < 8) ATT_LDK((ti + 1) & 1, ti + 1);
                    __builtin_amdgcn_sched_barrier(0);
                    f32x4 acc = (f32x4){0.f, 0.f, 0.f, 0.f};
#pragma unroll
                    for (int ks = 0; ks < 4; ++ks) acc = __builtin_amdgcn_mfma_f32_16x16x32_bf16(ka[ti & 1][ks], bq[ks], acc, 0, 0, 0);
                    s[ti] = acc;
                }
#undef ATT_LDK
            }
            const float C2 = 0.08838834764831845f * 1.4426950408889634f; const float NEG = -__builtin_inff();
            float mx = NEG;
#pragma unroll
            for (int ti = 0; ti < 9; ++ti) {
                const bool tile_ok = (n > 0 || w + ti >= 8);
#pragma unroll
                for (int i = 0; i < 4; ++i) { const int kk = 4 * sw + i; bool ok = tile_ok;
                    if (ti == 0) ok = ok && (kk >= q16);
                    if (ti == 8) ok = ok && (kk <= q16);
                    const float v = ok ? s[ti][i] * C2 : NEG; s[ti][i] = v; mx = fmaxf(mx, v); }
            }
            mx = fmaxf(mx, __shfl_xor(mx, 16)); mx = fmaxf(mx, __shfl_xor(mx, 32));
            float l = 0.f;
#pragma unroll
            for (int ti = 0; ti < 9; ++ti)
#pragma unroll
                for (int i = 0; i < 4; ++i) { const float pv = __builtin_amdgcn_exp2f(s[ti][i] - mx); s[ti][i] = pv; l += pv; }
            l += __shfl_xor(l, 16); l += __shfl_xor(l, 32);
            bf16x8 pf[5];
#pragma unroll
            for (int uu = 0; uu < 5; ++uu) { u32x4 wv; wv.x = cvt_pk_bf16(s[2 * uu][0], s[2 * uu][1]); wv.y = cvt_pk_bf16(s[2 * uu][2], s[2 * uu][3]);
                if (uu < 4) { wv.z = cvt_pk_bf16(s[2 * uu + 1][0], s[2 * uu + 1][1]); wv.w = cvt_pk_bf16(s[2 * uu + 1][2], s[2 * uu + 1][3]); } else { wv.z = 0u; wv.w = 0u; }
                pf[uu] = __builtin_bit_cast(bf16x8, wv); }
            if (cont) asm volatile("s_waitcnt vmcnt(4)" ::: "memory"); else asm volatile("s_waitcnt vmcnt(0)" ::: "memory");
            __syncthreads();
            if (cont) {
#pragma unroll
                for (int ks = 0; ks < 4; ++ks) bqn[ks] = *(const bf16x8*)(hQ + (size_t)(128 * (n + 1) + 16 * w + q16) * 128 + 32 * ks + 8 * g4);
            }
            const float rl = 1.0f / l;
            const size_t orow = (size_t)g * MTOK * D + qtok * D + h * 128;
            {
                s16x4 va[2][9];
#define ATT_TRV(r_, ch_) __builtin_bit_cast(s16x4, __builtin_amdgcn_ds_read_tr16_b64_v4i16((LAS s16x4*)(Vl + 256 * (r_) + 16 * ((ch_) ^ ((((r_) & 3) << 2) | (((r_) >> 2) & 3))) + 8 * (pp & 1))))
#define ATT_LDV(buf, dt_) do { const int _ch = 2 * (dt_) + (pp >> 1); \
                    _Pragma("unroll") for (int _u = 0; _u < 5; ++_u) { const int _kt0 = w + 2 * _u; const int _r0 = (par ^ 1 ^ (_kt0 >> 3)) * 128 + (_kt0 & 7) * 16 + 4 * sw + qq; va[buf][_u] = ATT_TRV(_r0, _ch); \
                        if (_u < 4) { const int _kt1 = _kt0 + 1; const int _r1 = (par ^ 1 ^ (_kt1 >> 3)) * 128 + (_kt1 & 7) * 16 + 4 * sw + qq; va[buf][5 + _u] = ATT_TRV(_r1, _ch); } } } while (0)
                ATT_LDV(0, 0);
#pragma unroll
                for (int dt = 0; dt < 8; ++dt) {
                    if (dt < 7) ATT_LDV((dt + 1) & 1, dt + 1);
                    __builtin_amdgcn_sched_barrier(0);
                    f32x4 o = (f32x4){0.f, 0.f, 0.f, 0.f};
#pragma unroll
                    for (int uu = 0; uu < 5; ++uu) { const s16x4 lo = va[dt & 1][uu]; const s16x4 hi = (uu < 4) ? va[dt & 1][5 + uu] : (s16x4){0, 0, 0, 0};
                        bf16x8 av; av[0] = lo[0]; av[1] = lo[1]; av[2] = lo[2]; av[3] = lo[3]; av[4] = hi[0]; av[5] = hi[1]; av[6] = hi[2]; av[7] = hi[3];
                        o = __builtin_amdgcn_mfma_f32_16x16x32_bf16(av, pf[uu], o, 0, 0, 0); }
                    o = o * rl;
                    u32x2 wv; wv.x = cvt_pk_bf16(o[0], o[1]); wv.y = cvt_pk_bf16(o[2], o[3]);
                    *(u32x2*)(OG + orow + 16 * dt + 4 * g4) = wv;
                }
#undef ATT_LDV
#undef ATT_TRV
            }
            if (g4 == 0) LSE[((size_t)g * MTOK + qtok) * NH + h] = mx * 0.6931471805599453f + __logf(l);
        }
    }
    __syncthreads();
    if (F.tid == 0) { MISCw[8] = keep0; MISCw[9] = keep1; }
    __syncthreads();
}

__device__ __forceinline__ void combine_phase(Frame& F) {
    const bf16* OG = (const bf16*)(F.ws + WS_OG); const float* LSE = (const float*)(F.ws + WS_LSE); bf16* ATT = (bf16*)(F.ws + WS_ATT);
    const int gw = F.vcu * 8 + F.wave, NGW = F.G * 8, lane = F.lane;
    for (int m = gw; m < MTOK; m += NGW) {
#pragma unroll
        for (int j = 0; j < 4; ++j) { const int c = lane + 64 * j, h = c >> 4;
            const float l0 = LSE[(size_t)m * NH + h], l1 = LSE[((size_t)MTOK + m) * NH + h], l2 = LSE[((size_t)2 * MTOK + m) * NH + h];
            const float mx = fmaxf(l0, fmaxf(l1, l2)); float w0 = __expf(l0 - mx), w1 = __expf(l1 - mx), w2 = __expf(l2 - mx); const float rs = 1.0f / (w0 + w1 + w2); w0 *= rs; w1 *= rs; w2 *= rs;
            const u32x4 a = *(const u32x4*)(OG + (size_t)m * D + c * 8), b = *(const u32x4*)(OG + ((size_t)MTOK + m) * D + c * 8), d = *(const u32x4*)(OG + ((size_t)2 * MTOK + m) * D + c * 8);
            u32x4 o;
#pragma unroll
            for (int e = 0; e < 4; ++e) { const float lo = w0 * bf_lo(a[e]) + w1 * bf_lo(b[e]) + w2 * bf_lo(d[e]), hi = w0 * bf_hi(a[e]) + w1 * bf_hi(b[e]) + w2 * bf_hi(d[e]); o[e] = cvt_pk_bf16(lo, hi); }
            *(u32x4*)(ATT + (size_t)m * D + c * 8) = o; }
    }
}
__device__ __forceinline__ void moe_convert_phase(Frame& F, const Args& a) {
    const int gw = F.vcu * 8 + F.wave, NGW = F.G * 8, lane = F.lane; int it0 = 0;
    bf16* W13 = (bf16*)(F.ws + WS_MW13); bf16* W2 = (bf16*)(F.ws + WS_MW2);
    for (int e = 0; e < NE; ++e) {
        cvt_matrix(a.in[16] + (size_t)e * D * FF, D, FF, W13 + (size_t)e * FF2 * D, D, MapGU{0}, it0, gw, NGW, lane);
        cvt_matrix(a.in[17] + (size_t)e * D * FF, D, FF, W13 + (size_t)e * FF2 * D, D, MapGU{1}, it0, gw, NGW, lane);
        cvt_matrix(a.in[18] + (size_t)e * FF * D, FF, D, W2 + (size_t)e * D * FF, FF, MapId{}, it0, gw, NGW, lane);
    }
}

__device__ __forceinline__ void ln_core(f32x4 (&v)[8], const f32x4 (&gg)[8], const f32x4 (&bb)[8]) {
    float s = 0.f;
#pragma unroll
    for (int j = 0; j < 8; ++j) s += (v[j][0] + v[j][1]) + (v[j][2] + v[j][3]);
    const float mean = wave_sum(s) * (1.f / D); float s2 = 0.f;
#pragma unroll
    for (int j = 0; j < 8; ++j) { v[j] = v[j] - mean; s2 += (v[j][0] * v[j][0] + v[j][1] * v[j][1]) + (v[j][2] * v[j][2] + v[j][3] * v[j][3]); }
    const float rstd = 1.0f / sqrtf(wave_sum(s2) * (1.f / D) + LN_EPS);
#pragma unroll
    for (int j = 0; j < 8; ++j) v[j] = v[j] * rstd * gg[j] + bb[j];
}
__device__ __forceinline__ void ln_store(const f32x4 (&v)[8], bf16* xb, int lane) {
#pragma unroll
    for (int j = 0; j < 8; ++j) { u32x2 w; w.x = cvt_pk_bf16(v[j][0], v[j][1]); w.y = cvt_pk_bf16(v[j][2], v[j][3]); *(u32x2*)(xb + 4 * lane + 256 * j) = w; }
}
__device__ __forceinline__ void ln_load_gb8(const float* gam, const float* bet, f32x4 (&gg)[8], f32x4 (&bb)[8], int lane) {
#pragma unroll
    for (int j = 0; j < 4; ++j) { const int c = (lane + 64 * j) * 8; gg[2 * j] = *(const f32x4*)(gam + c); gg[2 * j + 1] = *(const f32x4*)(gam + c + 4); bb[2 * j] = *(const f32x4*)(bet + c); bb[2 * j + 1] = *(const f32x4*)(bet + c + 4); }
}
__device__ __forceinline__ void ln_store8(const f32x4 (&v)[8], bf16* xb, int lane) {
#pragma unroll
    for (int j = 0; j < 4; ++j) { u32x4 w; w.x = cvt_pk_bf16(v[2 * j][0], v[2 * j][1]); w.y = cvt_pk_bf16(v[2 * j][2], v[2 * j][3]); w.z = cvt_pk_bf16(v[2 * j + 1][0], v[2 * j + 1][1]); w.w = cvt_pk_bf16(v[2 * j + 1][2], v[2 * j + 1][3]);
        *(u32x4*)(xb + (lane + 64 * j) * 8) = w; }
}
__device__ __forceinline__ void ln_unpack8(const u32x4 (&w)[4], f32x4 (&v)[8]) {
#pragma unroll
    for (int j = 0; j < 4; ++j) { v[2 * j] = (f32x4){bf_lo(w[j].x), bf_hi(w[j].x), bf_lo(w[j].y), bf_hi(w[j].y)}; v[2 * j + 1] = (f32x4){bf_lo(w[j].z), bf_hi(w[j].z), bf_lo(w[j].w), bf_hi(w[j].w)}; }
}
__device__ __forceinline__ void ln_phase(Frame& F, const bf16* YB, const bf16* RES, const float* gam, const float* bet, bf16* XB) {
    const int gw = F.vcu * 8 + F.wave, NGW = F.G * 8, lane = F.lane;
    f32x4 gg[8], bb[8]; ln_load_gb8(gam, bet, gg, bb, lane);
    for (int m = gw; m < MTOK; m += 2 * NGW) {
        const int m2 = m + NGW; const bool has2 = m2 < MTOK; const int mb = has2 ? m2 : m;
        u32x4 wa[4], wb[4], ra[4], rb[4];
#pragma unroll
        for (int j = 0; j < 4; ++j) { wa[j] = *(const u32x4*)(YB + (size_t)m * D + (lane + 64 * j) * 8); ra[j] = *(const u32x4*)(RES + (size_t)m * D + (lane + 64 * j) * 8); }
#pragma unroll
        for (int j = 0; j < 4; ++j) { wb[j] = *(const u32x4*)(YB + (size_t)mb * D + (lane + 64 * j) * 8); rb[j] = *(const u32x4*)(RES + (size_t)mb * D + (lane + 64 * j) * 8); }
        f32x4 v[8], r[8];
        ln_unpack8(wa, v); ln_unpack8(ra, r);
#pragma unroll
        for (int j = 0; j < 8; ++j) v[j] = r[j] * DN_ALPHA + v[j];
        ln_core(v, gg, bb); ln_store8(v, XB + (size_t)m * D, lane);
        if (has2) { ln_unpack8(wb, v); ln_unpack8(rb, r);
#pragma unroll
            for (int j = 0; j < 8; ++j) v[j] = r[j] * DN_ALPHA + v[j];
            ln_core(v, gg, bb); ln_store8(v, XB + (size_t)m2 * D, lane); }
    }
}
template <int J> __device__ __forceinline__ void pool_chunk8(const bf16* U, bf16* MIX, int m0, int t0, int lane) {
    constexpr int W = 2 << J, NR = W + 7;
    const int c = lane + 64 * J;
    u32x4 x[NR];
#pragma unroll
    for (int i = 0; i < NR; ++i) { const int dt = i - (W - 1); x[i] = *(const u32x4*)(U + (size_t)(m0 + ((t0 + dt >= 0) ? dt : 0)) * D + c * 8); }
    float sum[8];
#pragma unroll
    for (int e = 0; e < 8; ++e) sum[e] = 0.f;
#pragma unroll
    for (int i = 0; i < W - 1; ++i) { const float k = (t0 + i - (W - 1) >= 0) ? 1.f : 0.f;
#pragma unroll
        for (int e = 0; e < 4; ++e) { sum[2 * e] += k * bf_lo(x[i][e]); sum[2 * e + 1] += k * bf_hi(x[i][e]); } }
#pragma unroll
    for (int rr = 0; rr < 8; ++rr) {
        const int t = t0 + rr; const u32x4 cur = x[W - 1 + rr];
#pragma unroll
        for (int e = 0; e < 4; ++e) { sum[2 * e] += bf_lo(cur[e]); sum[2 * e + 1] += bf_hi(cur[e]); }
        const int cnt = (t + 1 < W) ? t + 1 : W; const float rc = 1.0f / (float)cnt; u32x4 o;
#pragma unroll
        for (int e = 0; e < 4; ++e) o[e] = cvt_pk_bf16(sum[2 * e] * rc - bf_lo(cur[e]), sum[2 * e + 1] * rc - bf_hi(cur[e]));
        *(u32x4*)(MIX + (size_t)(m0 + rr) * D + c * 8) = o;
        const float k = (t - (W - 1) >= 0) ? 1.f : 0.f;
#pragma unroll
        for (int e = 0; e < 4; ++e) { sum[2 * e] -= k * bf_lo(x[rr][e]); sum[2 * e + 1] -= k * bf_hi(x[rr][e]); }
    }
}
__device__ __forceinline__ void pool_phase(Frame& F) {
    const bf16* U = (const bf16*)(F.ws + WS_U); bf16* MIX = (bf16*)(F.ws + WS_MIX);
    const int gw = F.vcu * 8 + F.wave, NGW = F.G * 8, lane = F.lane;
    for (int m0 = gw * 8; m0 < MTOK; m0 += NGW * 8) { const int t0 = m0 & (SEQ - 1);
        pool_chunk8<0>(U, MIX, m0, t0, lane); pool_chunk8<1>(U, MIX, m0, t0, lane); pool_chunk8<2>(U, MIX, m0, t0, lane); pool_chunk8<3>(U, MIX, m0, t0, lane); }
}
__device__ __forceinline__ void ln_router_phase(Frame& F, const bf16* Y, const bf16* RES, const float* gam, const float* bet, const float* wrt, bf16* XB) {
    const int gw = F.vcu * 8 + F.wave, NGW = F.G * 8, lane = F.lane, tid = F.tid;
    LAS float* WR = (LAS float*)F.lds;
    LAS int* cntl = (LAS int*)(F.lds + 65536);
    LAS int* info = (LAS int*)(F.lds + 65536 + 64);
    int* LIST = (int*)(F.ws + WS_LIST); int* TOK = (int*)(F.ws + WS_TOK); unsigned* gcnt = (unsigned*)(F.ws + WS_CTL) + CW_CNT;
    __syncthreads();
    for (int i = tid; i < D * NE; i += 512) { const int c = i >> 3, e = i & 7; WR[e * D + c] = wrt[i]; }
    if (tid < 16) cntl[tid] = 0;
    __syncthreads();
    f32x4 gg[8], bb[8];
#pragma unroll
    for (int j = 0; j < 8; ++j) { gg[j] = *(const f32x4*)(gam + 4 * lane + 256 * j); bb[j] = *(const f32x4*)(bet + 4 * lane + 256 * j); }
    int k = 0;
    u32x2 vn[8], rn[8];
#pragma unroll
    for (int j = 0; j < 8; ++j) { vn[j] = *(const u32x2*)(Y + (size_t)(gw < MTOK ? gw : 0) * D + 4 * lane + 256 * j); rn[j] = *(const u32x2*)(RES + (size_t)(gw < MTOK ? gw : 0) * D + 4 * lane + 256 * j); }
    for (int m = gw; m < MTOK; m += NGW, ++k) {
        f32x4 v[8];
#pragma unroll
        for (int j = 0; j < 8; ++j) { v[j][0] = DN_ALPHA * bf_lo(rn[j].x) + bf_lo(vn[j].x); v[j][1] = DN_ALPHA * bf_hi(rn[j].x) + bf_hi(vn[j].x); v[j][2] = DN_ALPHA * bf_lo(rn[j].y) + bf_lo(vn[j].y); v[j][3] = DN_ALPHA * bf_hi(rn[j].y) + bf_hi(vn[j].y); }
        { const int mn = (m + NGW < MTOK) ? m + NGW : m;
#pragma unroll
          for (int j = 0; j < 8; ++j) { vn[j] = *(const u32x2*)(Y + (size_t)mn * D + 4 * lane + 256 * j); rn[j] = *(const u32x2*)(RES + (size_t)mn * D + 4 * lane + 256 * j); } }
        ln_core(v, gg, bb); ln_store(v, XB + (size_t)m * D, lane);
        float lg[8];
#pragma unroll
        for (int e = 0; e < 8; ++e) { float s = 0.f;
#pragma unroll
            for (int j = 0; j < 8; ++j) { const f32x4 wv = *(const LAS f32x4*)(WR + e * D + 4 * lane + 256 * j); s += (v[j][0] * wv[0] + v[j][1] * wv[1]) + (v[j][2] * wv[2] + v[j][3] * wv[3]); }
            lg[e] = wave_sum(s); }
        int e1 = 0; float v1 = lg[0];
#pragma unroll
        for (int e = 1; e < 8; ++e) if (lg[e] > v1) { v1 = lg[e]; e1 = e; }
        int e2 = -1; float v2 = -__builtin_inff();
#pragma unroll
        for (int e = 0; e < 8; ++e) if (e != e1 && lg[e] > v2) { v2 = lg[e]; e2 = e; }
        if (lane == 0 && k < 8) { const float ex = __expf(v2 - v1), g1 = 1.0f / (1.0f + ex), g2 = ex * g1;
            const int ls1 = atomicAdd((int*)&cntl[e1], 1), ls2 = atomicAdd((int*)&cntl[e2], 1);
            LAS int* q = info + (F.wave * 8 + k) * 8; q[0] = m; q[1] = e1; q[2] = e2; q[3] = ls1; q[4] = ls2; q[5] = __float_as_int(g1); q[6] = __float_as_int(g2); }
    }
    const int nrows = k < 8 ? k : 8;
    if (lane == 0) info[512 + F.wave] = nrows;
    __syncthreads();
    if (tid < 8) cntl[8 + tid] = (int)__hip_atomic_fetch_add(gcnt + 64 * tid, (unsigned)cntl[tid], __ATOMIC_RELAXED, __HIP_MEMORY_SCOPE_AGENT);
    __syncthreads();
    if (tid < 64) { const int wv = tid >> 3, kk = tid & 7;
        if (kk < info[512 + wv]) { const LAS int* q = info + tid * 8; const int m = q[0], e1 = q[1], e2 = q[2], s1 = cntl[8 + e1] + q[3], s2 = cntl[8 + e2] + q[4];
            LIST[e1 * MTOK + s1] = m; LIST[e2 * MTOK + s2] = m;
            int* t = TOK + (size_t)m * 8; t[0] = e1; t[1] = s1; t[2] = q[5]; t[3] = e2; t[4] = s2; t[5] = q[6]; } }
    __syncthreads();
}
__device__ __forceinline__ void moe_prefix(Frame& F, int (&tb)[9], int (&cnt)[8]) {
    const unsigned* gcnt = (const unsigned*)(F.ws + WS_CTL) + CW_CNT; tb[0] = 0;
#pragma unroll
    for (int e = 0; e < 8; ++e) { cnt[e] = (int)__builtin_amdgcn_readfirstlane(gcnt[64 * e]); tb[e + 1] = tb[e] + ((cnt[e] + 255) >> 8); }
}
__device__ __forceinline__ void moe_fill_idx(Frame& F, const pg8::MoeOrder& S, const int (&tb)[9], const int (&cnt)[8]) {
    LAS unsigned short* idx = (LAS unsigned short*)(F.lds + pg8::IDX_LDS_OFF); const int* LIST = (const int*)(F.ws + WS_LIST);
    const int row = F.tid & 255, sub = F.tid >> 8;
    for (int ui = 0; ui < 30 && ui < S.rs; ui += 2) {
        pg8::Unit u0; if (!S.next(ui, u0)) break;
        pg8::Unit u; const int uu = ui + sub;
        if (uu < S.rs && S.next(uu, u)) { int base = 0, ce = 0;
#pragma unroll
            for (int j = 0; j < 8; ++j) if (j == (u.e & 255)) { base = tb[j]; ce = cnt[j]; }
            const int sidx = (u.pm - base) * 256 + row; const int tok = LIST[(u.e & 255) * MTOK + (sidx < ce ? sidx : 0)];
            idx[uu * 256 + row] = (unsigned short)tok; }
    }
    __syncthreads();
}
__device__ __forceinline__ int gather_src(const int (&tb)[9], const int (&cnt)[8], const int* LIST, int rr) {
    const int tile = rr >> 8; int e = 0;
#pragma unroll
    for (int j = 1; j < 8; ++j) e += (tile >= tb[j]) ? 1 : 0;
    int base = 0, ce = 0;
#pragma unroll
    for (int j = 0; j < 8; ++j) if (j == e) { base = tb[j] * 256; ce = cnt[j]; }
    const int sidx = rr - base; return (sidx < ce) ? LIST[e * MTOK + sidx] : -1;
}
__device__ __forceinline__ void gather_phase(Frame& F) {
    const int gw = F.vcu * 8 + F.wave, NGW = F.G * 8, lane = F.lane;
    int tb[9], cnt[8]; moe_prefix(F, tb, cnt);
    const int* LIST = (const int*)(F.ws + WS_LIST); const bf16* XB = (const bf16*)(F.ws + WS_XB0); bf16* XG = (bf16*)(F.ws + WS_XG);
    const int rows = tb[8] * 256;
    for (int rr = gw; rr < rows; rr += 4 * NGW) {
        int tk[4];
#pragma unroll
        for (int k = 0; k < 4; ++k) { const int r = rr + k * NGW; tk[k] = (r < rows) ? gather_src(tb, cnt, LIST, r) : -2; }
        u32x4 v[4][4];
#pragma unroll
        for (int k = 0; k < 4; ++k)
#pragma unroll
            for (int j = 0; j < 4; ++j) v[k][j] = (tk[k] >= 0) ? *(const u32x4*)(XB + (size_t)tk[k] * D + (lane + 64 * j) * 8) : (u32x4){0u, 0u, 0u, 0u};
#pragma unroll
        for (int k = 0; k < 4; ++k) if (tk[k] != -2) {
#pragma unroll
            for (int j = 0; j < 4; ++j) *(u32x4*)(XG + (size_t)(rr + k * NGW) * D + (lane + 64 * j) * 8) = v[k][j]; }
    }
}
struct MoeRow { int r1, r2; float g1, g2; };
__device__ __forceinline__ MoeRow moe_row_info(const int* TOK, const int (&tb)[9], int m) {
    const int* t = TOK + (size_t)m * 8; const int e1 = t[0], s1 = t[1], e2 = t[3], s2 = t[4]; MoeRow r; r.g1 = __int_as_float(t[2]); r.g2 = __int_as_float(t[5]);
    int b1 = 0, b2 = 0;
#pragma unroll
    for (int j = 0; j < 8; ++j) { if (j == e1) b1 = tb[j] * 256; if (j == e2) b2 = tb[j] * 256; }
    r.r1 = b1 + s1; r.r2 = b2 + s2; return r;
}
__device__ __forceinline__ void ln_moe_phase(Frame& F, const bf16* X4, const float* gam, const float* bet, bf16* XB) {
    const int gw = F.vcu * 8 + F.wave, NGW = F.G * 8, lane = F.lane;
    int tb[9], cnt[8]; moe_prefix(F, tb, cnt);
    const int* TOK = (const int*)(F.ws + WS_TOK); const bf16* YE = (const bf16*)(F.ws + WS_XG); const bf16* YEP = (const bf16*)(F.ws + WS_YEP); constexpr size_t QSTR = (size_t)8 * 256 * D;
    const int split0 = (((8 * tb[8]) / F.G) * F.G >> 3) * 256;
    f32x4 gg[8], bb[8]; ln_load_gb8(gam, bet, gg, bb, lane);
    for (int m0 = gw; m0 < MTOK; m0 += 2 * NGW) {
        const bool has2 = (m0 + NGW) < MTOK; const int mm[2] = {m0, has2 ? m0 + NGW : m0};
        MoeRow ri[2]; ri[0] = moe_row_info(TOK, tb, mm[0]); ri[1] = moe_row_info(TOK, tb, mm[1]);
        u32x4 xw[2][4], aw[2][4], bw[2][4]; const bf16* y1[2]; const bf16* y2[2]; bool p1[2], p2[2];
#pragma unroll
        for (int q = 0; q < 2; ++q) { p1[q] = ri[q].r1 >= split0; p2[q] = ri[q].r2 >= split0;
            y1[q] = p1[q] ? YEP + (size_t)(ri[q].r1 - split0) * D : YE + (size_t)ri[q].r1 * D; y2[q] = p2[q] ? YEP + (size_t)(ri[q].r2 - split0) * D : YE + (size_t)ri[q].r2 * D;
#pragma unroll
            for (int j = 0; j < 4; ++j) { const int c = (lane + 64 * j) * 8; xw[q][j] = *(const u32x4*)(X4 + (size_t)mm[q] * D + c); aw[q][j] = *(const u32x4*)(y1[q] + c); bw[q][j] = *(const u32x4*)(y2[q] + c); } }
#pragma unroll
        for (int q = 0; q < 2; ++q) { if (q == 1 && !has2) break;
            const float g1 = ri[q].g1, g2 = ri[q].g2; f32x4 v[8];
#pragma unroll
            for (int j = 0; j < 4; ++j) { const int c = (lane + 64 * j) * 8; const u32x4 x = xw[q][j], a = aw[q][j], b = bw[q][j];
                float fa[8], fb[8];
#pragma unroll
                for (int e = 0; e < 4; ++e) { fa[2 * e] = bf_lo(a[e]); fa[2 * e + 1] = bf_hi(a[e]); fb[2 * e] = bf_lo(b[e]); fb[2 * e + 1] = bf_hi(b[e]); }
                if (p1[q]) {
#pragma unroll
                    for (int kq = 1; kq < 4; ++kq) { const u32x4 t4 = *(const u32x4*)(y1[q] + (size_t)kq * QSTR + c);
#pragma unroll
                        for (int e = 0; e < 4; ++e) { fa[2 * e] += bf_lo(t4[e]); fa[2 * e + 1] += bf_hi(t4[e]); } } }
                if (p2[q]) {
#pragma unroll
                    for (int kq = 1; kq < 4; ++kq) { const u32x4 t4 = *(const u32x4*)(y2[q] + (size_t)kq * QSTR + c);
#pragma unroll
                        for (int e = 0; e < 4; ++e) { fb[2 * e] += bf_lo(t4[e]); fb[2 * e + 1] += bf_hi(t4[e]); } } }
#pragma unroll
                for (int e = 0; e < 4; ++e) { const float lo = DN_ALPHA * bf_lo(x[e]) + g1 * fa[2 * e] + g2 * fb[2 * e], hi = DN_ALPHA * bf_hi(x[e]) + g1 * fa[2 * e + 1] + g2 * fb[2 * e + 1];
                    v[2 * j + (e >> 1)][(e & 1) * 2] = lo; v[2 * j + (e >> 1)][(e & 1) * 2 + 1] = hi; } }
            ln_core(v, gg, bb); ln_store8(v, XB + (size_t)mm[q] * D, lane);
        }
    }
}

constexpr int NPHASE = 19;
__global__ void __launch_bounds__(512, 2) fwd_kernel(Args args) {
    extern __shared__ __attribute__((aligned(16))) unsigned char lds[];
    Frame F; F.lds = (LAS unsigned char*)lds; F.tid = threadIdx.x; F.lane = F.tid & 63; F.wave = __builtin_amdgcn_readfirstlane(F.tid >> 6);
    F.G = gridDim.x; { const int bx = blockIdx.x; F.vcu = (F.G % 8 == 0) ? (bx % 8) * (F.G / 8) + bx / 8 : bx; }
    F.ws = args.ws; unsigned char* ws = args.ws;
    volatile LAS unsigned* MISC = (volatile LAS unsigned*)(F.lds + MISC_OFF);
    for (int u = F.tid; u < (LDS_BYTES - LDSCTL_OFF) / 4; u += 512) ((LAS unsigned*)(F.lds + LDSCTL_OFF))[u] = 0u;
    __syncthreads();
    XcdBarrier bar; bar.bar = (unsigned*)(ws + WS_CTL) + CW_BAR; bar.x = 0; bar.st = nullptr;
    if (args.ph_hi - args.ph_lo > 1) bar = xcd_barrier_post((unsigned*)(ws + WS_CTL) + CW_BAR, MISC + 8);
    const int lo = args.ph_lo, hi = args.ph_hi;
#define IN(k) (lo <= (k) && (k) < hi)
    long long pht0 = 0, pht1 = 0; if (PHT_SEL == 0) pht0 = wall_clock64();
#define SEAM(k) do { if (IN(k) && IN((k) + 1)) xcd_barrier(bar); if (PHT_SEL == (k) + 1) pht0 = wall_clock64(); if (PHT_SEL == (k)) pht1 = wall_clock64(); } while (0)
    LAS unsigned char* ring = F.lds;
    const int bx = (int)blockIdx.x;
    bf16* XB0 = (bf16*)(ws + WS_XB0); bf16* XB1 = (bf16*)(ws + WS_XB1); bf16* YB = (bf16*)(ws + WS_YB); float* Y = args.out;

    if (IN(0)) { p0_prologue(F, args); }
    if constexpr ((DUP_MASK >> 0) & 1u) { if (IN(0)) { p0_prologue(F, args); } }
    SEAM(0);
    if (IN(1)) {
        { pg8::Gemm g{XB0, (const bf16*)(ws + WS_WQKV), D, D, D}; pg8::StaticOrder S; S.init(MTOK, NQKV, F.G, bx);
          pg8::EpiQKV E{(bf16*)(ws + WS_QKV), (const float*)(ws + WS_ROPE)}; pg8::gemm_phase(ring, g, S, E); }
        { pg8::Gemm g{(const bf16*)(ws + WS_PB), (const bf16*)(ws + WS_WPROJ), PLE, PLE, PLE}; pg8::BatchOrder S; S.init(MTOK, D, 2, (size_t)MTOK * PLE, (size_t)D * PLE, F.G, bx);
          pg8::EpiBf16 E{(bf16*)(ws + WS_PPROJ), D, (size_t)MTOK * D, 0}; pg8::gemm_phase(ring, g, S, E); }
        {
          pg8::Gemm g{(const bf16*)(ws + WS_WO2), (const bf16*)(ws + WS_WGS), 512, D, 512}; pg8::BatchOrder S; S.init(D, 512, 4, (size_t)512, (size_t)512 * 512, F.G, bx);
          pg8::EpiBf16 E{(bf16*)(ws + WS_WCOMB), D, (size_t)0, 512}; pg8::gemm_phase(ring, g, S, E); }
    }
    if constexpr ((DUP_MASK >> 1) & 1u) { if (IN(1)) {
        { pg8::Gemm g{XB0, (const bf16*)(ws + WS_WQKV), D, D, D}; pg8::StaticOrder S; S.init(MTOK, NQKV, F.G, bx);
          pg8::EpiQKV E{(bf16*)(ws + WS_QKV), (const float*)(ws + WS_ROPE)}; pg8::gemm_phase(ring, g, S, E); }
        { pg8::Gemm g{(const bf16*)(ws + WS_PB), (const bf16*)(ws + WS_WPROJ), PLE, PLE, PLE}; pg8::BatchOrder S; S.init(MTOK, D, 2, (size_t)MTOK * PLE, (size_t)D * PLE, F.G, bx);
          pg8::EpiBf16 E{(bf16*)(ws + WS_PPROJ), D, (size_t)MTOK * D, 0}; pg8::gemm_phase(ring, g, S, E); }
        {
          pg8::Gemm g{(const bf16*)(ws + WS_WO2), (const bf16*)(ws + WS_WGS), 512, D, 512}; pg8::BatchOrder S; S.init(D, 512, 4, (size_t)512, (size_t)512 * 512, F.G, bx);
          pg8::EpiBf16 E{(bf16*)(ws + WS_WCOMB), D, (size_t)0, 512}; pg8::gemm_phase(ring, g, S, E); }
    } }
    SEAM(1);
    if (IN(2)) { attn_phase(F); }
    if constexpr ((DUP_MASK >> 2) & 1u) { if (IN(2)) { attn_phase(F); } }
    SEAM(2);
    if (IN(3)) { combine_phase(F); moe_convert_phase(F, args); }
    if constexpr ((DUP_MASK >> 3) & 1u) { if (IN(3)) { combine_phase(F); moe_convert_phase(F, args); } }
    SEAM(3);
    if (IN(4)) { pg8::Gemm g{(const bf16*)(ws + WS_ATT), (const bf16*)(ws + WS_WO), D, D, D}; pg8::StaticOrder S; S.init(MTOK, D, F.G, bx);
        pg8::EpiBf16 E{YB, D, (size_t)0, 0}; pg8::gemm_phase(ring, g, S, E); }
    if constexpr ((DUP_MASK >> 4) & 1u) { if (IN(4)) { pg8::Gemm g{(const bf16*)(ws + WS_ATT), (const bf16*)(ws + WS_WO), D, D, D}; pg8::StaticOrder S; S.init(MTOK, D, F.G, bx);
        pg8::EpiBf16 E{YB, D, (size_t)0, 0}; pg8::gemm_phase(ring, g, S, E); } }
    SEAM(4);
    if (IN(5)) { ln_phase(F, YB, XB0, args.in[8], args.in[9], XB0); }
    if constexpr ((DUP_MASK >> 5) & 1u) { if (IN(5)) { ln_phase(F, YB, XB0, args.in[8], args.in[9], XB0); } }
    SEAM(5);
    if (IN(6)) { pg8::Gemm g{XB0, (const bf16*)(ws + WS_W13), D, D, D}; pg8::StaticOrder S; S.init(MTOK, FF2, F.G, bx);
        pg8::EpiSwiGLU E{(bf16*)(ws + WS_H), FF}; pg8::gemm_phase<pg8::EpiSwiGLU, pg8::StaticOrder, true, true, (STAMP_SEL != 0)>(ring, g, S, E, (unsigned long long*)(ws + WS_CTL + 512 * 1024)); }
    if constexpr ((DUP_MASK >> 6) & 1u) { if (IN(6)) { pg8::Gemm g{XB0, (const bf16*)(ws + WS_W13), D, D, D}; pg8::StaticOrder S; S.init(MTOK, FF2, F.G, bx);
        pg8::EpiSwiGLU E{(bf16*)(ws + WS_H), FF}; pg8::gemm_phase(ring, g, S, E); } }
    SEAM(6);
    if (IN(7)) { pg8::Gemm g{(const bf16*)(ws + WS_H), (const bf16*)(ws + WS_W2), FF, FF, FF}; pg8::StaticOrder S; S.init(MTOK, D, F.G, bx);
        pg8::EpiBf16 E{YB, D, (size_t)0, 0}; pg8::gemm_phase(ring, g, S, E); }
    if constexpr ((DUP_MASK >> 7) & 1u) { if (IN(7)) { pg8::Gemm g{(const bf16*)(ws + WS_H), (const bf16*)(ws + WS_W2), FF, FF, FF}; pg8::StaticOrder S; S.init(MTOK, D, F.G, bx);
        pg8::EpiBf16 E{YB, D, (size_t)0, 0}; pg8::gemm_phase(ring, g, S, E); } }
    SEAM(7);
    if (IN(8)) { ln_phase(F, YB, XB0, args.in[10], args.in[11], XB0); }
    if constexpr ((DUP_MASK >> 8) & 1u) { if (IN(8)) { ln_phase(F, YB, XB0, args.in[10], args.in[11], XB0); } }
    SEAM(8);
    if (IN(9)) { pg8::Gemm g{XB0, (const bf16*)(ws + WS_WGATE), D, D, D}; pg8::StaticOrder S; S.init(MTOK, D, F.G, bx);
        pg8::EpiPle E{XB0, (const bf16*)(ws + WS_PPROJ), args.in[21], nullptr, XB1, D}; pg8::gemm_phase(ring, g, S, E); }
    if constexpr ((DUP_MASK >> 9) & 1u) { if (IN(9)) { pg8::Gemm g{XB0, (const bf16*)(ws + WS_WGATE), D, D, D}; pg8::StaticOrder S; S.init(MTOK, D, F.G, bx);
        pg8::EpiPle E{XB0, (const bf16*)(ws + WS_PPROJ), args.in[21], nullptr, XB1, D}; pg8::gemm_phase(ring, g, S, E); } }
    SEAM(9);
    if (IN(10)) { pg8::Gemm g{XB1, (const bf16*)(ws + WS_WIN), D, D, D}; pg8::StaticOrder S; S.init(MTOK, D, F.G, bx);
        pg8::EpiBf16 E{(bf16*)(ws + WS_U), D, (size_t)0, 0}; pg8::gemm_phase(ring, g, S, E); }
    if constexpr ((DUP_MASK >> 10) & 1u) { if (IN(10)) { pg8::Gemm g{XB1, (const bf16*)(ws + WS_WIN), D, D, D}; pg8::StaticOrder S; S.init(MTOK, D, F.G, bx);
        pg8::EpiBf16 E{(bf16*)(ws + WS_U), D, (size_t)0, 0}; pg8::gemm_phase(ring, g, S, E); } }
    SEAM(10);
    if (IN(11)) { pool_phase(F); }
    if constexpr ((DUP_MASK >> 11) & 1u) { if (IN(11)) { pool_phase(F); } }
    SEAM(11);
    if (IN(12)) { pg8::Gemm g{(const bf16*)(ws + WS_MIX), (const bf16*)(ws + WS_WCOMB), D, D, D}; pg8::StaticOrder S; S.init(MTOK, D, F.G, bx);
        pg8::EpiBf16 E{YB, D, (size_t)0, 0}; pg8::gemm_phase(ring, g, S, E); }
    if constexpr ((DUP_MASK >> 12) & 1u) { if (IN(12)) { pg8::Gemm g{(const bf16*)(ws + WS_MIX), (const bf16*)(ws + WS_WCOMB), D, D, D}; pg8::StaticOrder S; S.init(MTOK, D, F.G, bx);
        pg8::EpiBf16 E{YB, D, (size_t)0, 0}; pg8::gemm_phase(ring, g, S, E); } }
    SEAM(12);
    if (IN(13)) { ln_router_phase(F, YB, XB1, args.in[8] + D, args.in[9] + D, args.in[15], XB0); }
    if constexpr ((DUP_MASK >> 13) & 1u) { if (IN(13)) { ln_router_phase(F, YB, XB1, args.in[8] + D, args.in[9] + D, args.in[15], XB0); } }
    SEAM(13);
    if (PHT_SEL == 15) pht0 = wall_clock64();
    if (IN(15)) { int tb[9], cnt[8]; moe_prefix(F, tb, cnt);
        pg8::Gemm g{XB0, (const bf16*)(ws + WS_MW13), D, D, D}; pg8::MoeOrder S; S.nM = tb[8]; S.nN = FF2 / 256; S.nwg = S.nM * S.nN; S.G = F.G; S.c = bx; S.sB = (size_t)FF2 * D; S.gather = true; S.rs = (S.nwg / F.G > 3) ? S.nwg / F.G - 2 : 1; S.ctr = (unsigned*)(ws + WS_CTL) + CW_DYN; S.list = (const int*)(ws + WS_LIST);
#pragma unroll
        for (int j = 0; j < 8; ++j) S.cnt[j] = cnt[j];
#pragma unroll
        for (int j = 0; j < 9; ++j) S.tb[j] = tb[j];
        const long long spw0 = SPREAD_SEL ? wall_clock64() : 0;
        moe_fill_idx(F, S, tb, cnt);
        pg8::EpiSwiGLU E{(bf16*)(ws + WS_HM), FF}; pg8::gemm_phase<pg8::EpiSwiGLU, pg8::MoeOrder, true, true, false, true>(ring, g, S, E);
        if (SPREAD_SEL && F.tid == 0 && (F.vcu >> 5) == SPREAD_XCD) { const unsigned d = (unsigned)(wall_clock64() - spw0); atomicMax((unsigned*)(ws + WS_CTL) + 2048, d); atomicMax((unsigned*)(ws + WS_CTL) + 2112, 0xFFFFFFFFu - d); } }
    if constexpr ((DUP_MASK >> 15) & 1u) { if (IN(15)) { int tb[9], cnt[8]; moe_prefix(F, tb, cnt);
        pg8::Gemm g{XB0, (const bf16*)(ws + WS_MW13), D, D, D}; pg8::MoeOrder S; S.nM = tb[8]; S.nN = FF2 / 256; S.nwg = S.nM * S.nN; S.G = F.G; S.c = bx; S.sB = (size_t)FF2 * D; S.gather = true; S.rs = (S.nwg / F.G > 3) ? S.nwg / F.G - 2 : 1; S.ctr = (unsigned*)(ws + WS_CTL) + CW_DYN; S.list = (const int*)(ws + WS_LIST);
#pragma unroll
        for (int j = 0; j < 8; ++j) S.cnt[j] = cnt[j];
#pragma unroll
        for (int j = 0; j < 9; ++j) S.tb[j] = tb[j];
        moe_fill_idx(F, S, tb, cnt);
        pg8::EpiSwiGLU E{(bf16*)(ws + WS_HM), FF}; pg8::gemm_phase<pg8::EpiSwiGLU, pg8::MoeOrder, true, true, false, true>(ring, g, S, E); } }
    SEAM(15);
    if (IN(16)) { int tb[9], cnt[8]; moe_prefix(F, tb, cnt);
        pg8::Gemm g{(const bf16*)(ws + WS_HM), (const bf16*)(ws + WS_MW2), FF, FF, FF}; pg8::MoeDownOrder S; S.nM = tb[8]; S.G = F.G; S.c = F.vcu; S.nfull = ((8 * tb[8]) / F.G) * F.G; S.kq_elems = FF / 4; S.kq_nt = FF / 4 / 64; S.sB = (size_t)D * FF; S.rs = 1 << 30; S.ctr = nullptr; S.rs = (S.nfull / F.G > 1) ? S.nfull / F.G - 1 : 1; S.ctr = (unsigned*)(ws + WS_CTL) + CW_DYN + 192;
#pragma unroll
        for (int j = 0; j < 9; ++j) S.tb[j] = tb[j];
#pragma unroll
        for (int j = 0; j < 8; ++j) S.cnt[j] = cnt[j];
        pg8::EpiMoeDown E{(bf16*)(ws + WS_XG), (bf16*)(ws + WS_YEP), S.nfull >> 3, (size_t)8 * 256 * D}; pg8::gemm_phase(ring, g, S, E); }
    if constexpr ((DUP_MASK >> 16) & 1u) { if (IN(16)) { int tb[9], cnt[8]; moe_prefix(F, tb, cnt);
        pg8::Gemm g{(const bf16*)(ws + WS_HM), (const bf16*)(ws + WS_MW2), FF, FF, FF}; pg8::MoeDownOrder S; S.nM = tb[8]; S.G = F.G; S.c = F.vcu; S.nfull = ((8 * tb[8]) / F.G) * F.G; S.kq_elems = FF / 4; S.kq_nt = FF / 4 / 64; S.sB = (size_t)D * FF;
#pragma unroll
        for (int j = 0; j < 9; ++j) S.tb[j] = tb[j];
#pragma unroll
        for (int j = 0; j < 8; ++j) S.cnt[j] = cnt[j];
        pg8::EpiMoeDown E{(bf16*)(ws + WS_XG), (bf16*)(ws + WS_YEP), S.nfull >> 3, (size_t)8 * 256 * D}; pg8::gemm_phase(ring, g, S, E); } }
    SEAM(16);
    if (IN(17)) { ln_moe_phase(F, XB0, args.in[10] + D, args.in[11] + D, XB1); }
    if constexpr ((DUP_MASK >> 17) & 1u) { if (IN(17)) { ln_moe_phase(F, XB0, args.in[10] + D, args.in[11] + D, XB1); } }
    SEAM(17);
    if (IN(18)) { pg8::Gemm g{XB1, (const bf16*)(ws + WS_WGATE) + (size_t)D * D, D, D, D}; pg8::StaticOrder S; S.init(MTOK, D, F.G, bx);
        pg8::EpiPle E{XB1, (const bf16*)(ws + WS_PPROJ) + (size_t)MTOK * D, args.in[21] + D, args.out, nullptr, D}; pg8::gemm_phase(ring, g, S, E); }
    if constexpr ((DUP_MASK >> 18) & 1u) { if (IN(18)) { pg8::Gemm g{XB1, (const bf16*)(ws + WS_WGATE) + (size_t)D * D, D, D, D}; pg8::StaticOrder S; S.init(MTOK, D, F.G, bx);
        pg8::EpiPle E{XB1, (const bf16*)(ws + WS_PPROJ) + (size_t)MTOK * D, args.in[21] + D, args.out, nullptr, D}; pg8::gemm_phase(ring, g, S, E); } }
    if (STAMP_SEL != 0 && blockIdx.x == 0 && F.tid == 0 && hi == NPHASE) { const unsigned long long us = ((volatile unsigned long long*)(ws + WS_CTL + 512 * 1024))[STAMP_SEL - 1]; const long long w0 = wall_clock64(); while ((unsigned long long)(wall_clock64() - w0) < us * 100ull) __builtin_amdgcn_s_sleep(32); }
    if (PHT_SEL >= 0 && blockIdx.x == 0 && F.tid == 0 && hi == NPHASE) { if (PHT_SEL == NPHASE - 1) pht1 = wall_clock64(); const long long w0 = wall_clock64(); while (wall_clock64() - w0 < PHT_MULT * (pht1 - pht0)) __builtin_amdgcn_s_sleep(32); }
    if (SPREAD_SEL != 0 && blockIdx.x == 0 && F.tid == 0 && hi == NPHASE) { const unsigned mx = ((volatile unsigned*)(ws + WS_CTL))[2048], mn = 0xFFFFFFFFu - ((volatile unsigned*)(ws + WS_CTL))[2112]; const long long ticks = (SPREAD_SEL == 1) ? 16ll * (mx - mn) : 4ll * mx; const long long w0 = wall_clock64(); while (wall_clock64() - w0 < ticks) __builtin_amdgcn_s_sleep(32); }
#undef IN
#undef SEAM
}

extern "C" void kernel_launch(void* const* d_in, const int* in_sizes, int n_in, void* d_out, int out_size, void* d_ws, size_t ws_size, hipStream_t stream) {
    static int grid = 0; static bool one_launch = true;
    if (grid == 0) {
        if (n_in != 22 || out_size != MTOK * D || ws_size < WS_END) { fprintf(stderr, "kernel_launch: unexpected shapes (n_in %d, out %d, ws %zu < %zu)\n", n_in, out_size, ws_size, (size_t)WS_END); grid = -1; return; }
        int dev = 0, cus = 0, per_cu = 0;
        if (hipGetDevice(&dev) != hipSuccess || hipDeviceGetAttribute(&cus, hipDeviceAttributeMultiprocessorCount, dev) != hipSuccess) { grid = -1; return; }
        if (hipFuncSetAttribute((const void*)fwd_kernel, hipFuncAttributeMaxDynamicSharedMemorySize, LDS_BYTES) != hipSuccess) { fprintf(stderr, "kernel_launch: hipFuncSetAttribute failed\n"); grid = -1; return; }
        if (hipOccupancyMaxActiveBlocksPerMultiprocessor(&per_cu, (const void*)fwd_kernel, 512, LDS_BYTES) != hipSuccess || per_cu < 1) { fprintf(stderr, "kernel_launch: occupancy query says %d blocks per CU\n", per_cu); }
        (void)hipGetLastError();
        grid = 256;
        one_launch = (cus >= 256);
    }
    if (grid < 0) return;
    (void)hipMemsetAsync((char*)d_ws + WS_CTL, 0, CTL_ZERO_BYTES, stream);
    Args a{};
    for (int i = 0; i < 22; ++i) a.in[i] = (const float*)d_in[i];
    a.out = (float*)d_out; a.ws = (unsigned char*)d_ws;
    if (MK_PER_PHASE || !one_launch) { for (int p = 0; p < NPHASE; ++p) { a.ph_lo = p; a.ph_hi = p + 1; hipLaunchKernelGGL(fwd_kernel, dim3(grid), dim3(512), LDS_BYTES, stream, a); } }
    else { a.ph_lo = 0; a.ph_hi = NPHASE; hipLaunchKernelGGL(fwd_kernel, dim3(grid), dim3(512), LDS_BYTES, stream, a); }
}
```
